# Optimizing an MI355X kernel written in HIP

```python
import jax, jax.numpy as jnp
from jax import lax
import numpy as np

D_MODEL = 4096
BATCH = 2
SEQ = 8192
DEPTH = 1

N_META = 16
MIX_WIDTH = D_MODEL
POOL_WINDOWS = (2, 4, 8, 16)
POOL_WIDTH = D_MODEL // 4
POOL_GROUP = POOL_WIDTH // len(POOL_WINDOWS)
QK_NOPE_DIM = 128
QK_ROPE_DIM = 64
QK_HEAD_DIM = QK_NOPE_DIM + QK_ROPE_DIM
V_HEAD_DIM = 128
MLA_WIDTH = MIX_WIDTH - POOL_WIDTH
MLA_HEADS = MLA_WIDTH // V_HEAD_DIM
Q_LORA_RANK = D_MODEL // 4
KV_LORA_RANK = 512
IN_COLS = POOL_WIDTH + Q_LORA_RANK + KV_LORA_RANK + QK_ROPE_DIM
ROPE_THETA = 10000.0
Q_BLOCK = 128
N_GROUPS = 8
EXPERTS_PER_GROUP = 8
N_EXPERTS = N_GROUPS * EXPERTS_PER_GROUP
TOP_K_INNER = 2
D_EXPERT = 512
MOE_BLOCK = 128
EPS = 1e-6

kernel_name = "hymba_pool_mla_hier_moe_block"


def rms_norm(x, g):
    xf = x.astype(jnp.float32)
    y = xf * lax.rsqrt(jnp.mean(xf * xf, axis=-1, keepdims=True) + EPS)
    return (y * g.astype(jnp.float32)).astype(x.dtype)


def rope_tables(length):
    inv = 1.0 / (ROPE_THETA ** (jnp.arange(0, QK_ROPE_DIM, 2, dtype=jnp.float32) / QK_ROPE_DIM))
    ang = jnp.arange(length, dtype=jnp.float32)[:, None] * inv[None, :]
    return jnp.cos(ang), jnp.sin(ang)


def apply_rope(x, cos, sin):
    xf = x.astype(jnp.float32)
    x1, x2 = jnp.split(xf, 2, axis=-1)
    c = cos[None, :, None, :]
    s = sin[None, :, None, :]
    return jnp.concatenate([x1 * c - x2 * s, x1 * s + x2 * c], axis=-1).astype(x.dtype)


def pool_mixer(u, w_pool, pool_scale):
    L = u.shape[1]
    count = jnp.arange(1, L + 1, dtype=jnp.float32)[None, :, None]
    outs = []
    for gi, w in enumerate(POOL_WINDOWS):
        ug = u[..., gi * POOL_GROUP:(gi + 1) * POOL_GROUP].astype(jnp.float32)
        cs = jnp.cumsum(ug, axis=1)
        lag = jnp.pad(cs, ((0, 0), (w, 0), (0, 0)))[:, :L]
        diff = ((cs - lag) / jnp.minimum(count, float(w)) - ug).astype(u.dtype)
        outs.append(diff @ w_pool[gi])
    return jnp.concatenate(outs, axis=-1) * pool_scale


def attend(qb, k, v, q_pos):
    s = jnp.einsum('bqhd,bkhd->bhqk', qb, k).astype(jnp.float32)
    key_pos = jnp.arange(k.shape[1])
    mask = key_pos[None, :] <= q_pos[:, None]
    s = jnp.where(mask[None, None], s, -jnp.inf)
    p = jax.nn.softmax(s, axis=-1).astype(v.dtype)
    return jnp.einsum('bhqk,bkhd->bqhd', p, v)


def mla_mixer(q_lat, kv_lat, k_rope, q_lat_norm_g, w_uq, kv_lat_norm_g, w_ukv, q_head_norm_g, k_head_norm_g, cos, sin):
    B, L, _ = q_lat.shape
    q = (rms_norm(q_lat, q_lat_norm_g) @ w_uq).reshape(B, L, MLA_HEADS, QK_HEAD_DIM)
    kv = (rms_norm(kv_lat, kv_lat_norm_g) @ w_ukv).reshape(B, L, MLA_HEADS, QK_NOPE_DIM + V_HEAD_DIM)
    k_nope = kv[..., :QK_NOPE_DIM]
    v = kv[..., QK_NOPE_DIM:]
    k_pe = jnp.broadcast_to(k_rope[:, :, None, :], (B, L, MLA_HEADS, QK_ROPE_DIM))
    k = jnp.concatenate([k_nope, k_pe], axis=-1)
    q = rms_norm(q, q_head_norm_g)
    k = rms_norm(k, k_head_norm_g)
    q = jnp.concatenate([q[..., :QK_NOPE_DIM], apply_rope(q[..., QK_NOPE_DIM:], cos, sin)], axis=-1)
    k = jnp.concatenate([k[..., :QK_NOPE_DIM], apply_rope(k[..., QK_NOPE_DIM:], cos, sin)], axis=-1)
    q = q * (QK_HEAD_DIM ** -0.5)
    o_meta = attend(q[:, :N_META], k[:, :N_META], v[:, :N_META], jnp.arange(N_META))
    n_real = L - N_META
    n_blk = n_real // Q_BLOCK
    q_real = q[:, N_META:].reshape(B, n_blk, Q_BLOCK, MLA_HEADS, QK_HEAD_DIM).transpose(1, 0, 2, 3, 4)
    pos = (N_META + jnp.arange(n_real)).reshape(n_blk, Q_BLOCK)
    o_real = lax.map(lambda a: attend(a[0], k, v, a[1]), (q_real, pos))
    o_real = o_real.transpose(1, 0, 2, 3, 4).reshape(B, n_real, MLA_HEADS, V_HEAD_DIM)
    o = jnp.concatenate([o_meta, o_real], axis=1)
    return o.reshape(B, L, MLA_WIDTH)


def hier_moe(h, w_group, b_group, w_expert, b_expert, w_gate, w_up, w_down):
    B, L, D = h.shape
    N = B * L
    xt = h.reshape(N, D)
    xf = xt.astype(jnp.float32)
    group_probs = jax.nn.softmax(xf @ w_group.astype(jnp.float32) + b_group.astype(jnp.float32), axis=-1)
    g_idx = jnp.argmax(group_probs, axis=-1)
    g_p = jnp.take_along_axis(group_probs, g_idx[:, None], axis=-1)
    e_logits = (xf @ w_expert.astype(jnp.float32) + b_expert.astype(jnp.float32)).reshape(N, N_GROUPS, EXPERTS_PER_GROUP)
    in_group = jnp.take_along_axis(e_logits, g_idx[:, None, None], axis=1)[:, 0]
    top_l, top_i = lax.top_k(in_group, TOP_K_INNER)
    gate = g_p * jax.nn.softmax(top_l, axis=-1)
    expert_id = g_idx[:, None] * EXPERTS_PER_GROUP + top_i
    A = N * TOP_K_INNER
    e_flat = expert_id.reshape(A).astype(jnp.int32)
    tok_flat = jnp.repeat(jnp.arange(N, dtype=jnp.int32), TOP_K_INNER)
    w_flat = gate.reshape(A)
    order = jnp.argsort(e_flat)
    e_s = e_flat[order]
    tok_s = tok_flat[order]
    w_s = w_flat[order]
    counts = jnp.bincount(e_flat, length=N_EXPERTS)
    padded = (counts + MOE_BLOCK - 1) // MOE_BLOCK * MOE_BLOCK
    start = jnp.cumsum(counts) - counts
    pend = jnp.cumsum(padded)
    pstart = pend - padded
    dest = pstart[e_s] + jnp.arange(A, dtype=jnp.int32) - start[e_s]
    n_blocks = (A + N_EXPERTS * (MOE_BLOCK - 1) + MOE_BLOCK - 1) // MOE_BLOCK
    P = n_blocks * MOE_BLOCK
    tok_buf = jnp.zeros((P,), jnp.int32).at[dest].set(tok_s)
    w_buf = jnp.zeros((P,), jnp.float32).at[dest].set(w_s)
    blk_start = jnp.arange(n_blocks, dtype=jnp.int32) * MOE_BLOCK
    blk_expert = jnp.minimum(jnp.searchsorted(pend, blk_start, side='right'), N_EXPERTS - 1)

    def run_block(args):
        tok, wt, e = args
        xb = xt[tok]
        hb = jax.nn.silu(xb @ w_gate[e]) * (xb @ w_up[e])
        return (hb @ w_down[e]) * wt[:, None].astype(xb.dtype)

    ys = lax.map(run_block, (tok_buf.reshape(n_blocks, MOE_BLOCK), w_buf.reshape(n_blocks, MOE_BLOCK), blk_expert))
    out = jax.ops.segment_sum(ys.reshape(P, D), tok_buf, num_segments=N)
    return out.reshape(B, L, D)


def setup_inputs(seed: int = 0) -> dict:
    key = jax.random.key(seed)
    ks = jax.random.split(key, 24)

    def nrm(k, shape, fan):
        return jax.random.normal(k, shape, jnp.float32) * (fan ** -0.5)

    def gain(k, shape):
        return 1.0 + 0.02 * jax.random.normal(k, shape, jnp.float32)

    return {
        "x": jax.random.normal(ks[0], (BATCH, SEQ, D_MODEL), jnp.float32),
        "meta_tokens": jax.random.normal(ks[1], (N_META, D_MODEL), jnp.float32),
        "mix_norm_g": gain(ks[2], (DEPTH, D_MODEL)),
        "w_in": nrm(ks[3], (DEPTH, D_MODEL, IN_COLS), D_MODEL),
        "q_lat_norm_g": gain(ks[4], (DEPTH, Q_LORA_RANK)),
        "w_uq": nrm(ks[5], (DEPTH, Q_LORA_RANK, MLA_HEADS * QK_HEAD_DIM), Q_LORA_RANK),
        "kv_lat_norm_g": gain(ks[6], (DEPTH, KV_LORA_RANK)),
        "w_ukv": nrm(ks[7], (DEPTH, KV_LORA_RANK, MLA_HEADS * (QK_NOPE_DIM + V_HEAD_DIM)), KV_LORA_RANK),
        "q_head_norm_g": gain(ks[8], (DEPTH, QK_HEAD_DIM)),
        "k_head_norm_g": gain(ks[9], (DEPTH, QK_HEAD_DIM)),
        "w_pool": nrm(ks[10], (DEPTH, len(POOL_WINDOWS), POOL_GROUP, POOL_GROUP), POOL_GROUP),
        "pool_scale": gain(ks[11], (DEPTH, POOL_WIDTH)),
        "w_out": nrm(ks[12], (DEPTH, MIX_WIDTH, D_MODEL), MIX_WIDTH),
        "ffn_norm_g": gain(ks[13], (DEPTH, D_MODEL)),
        "w_group": nrm(ks[14], (DEPTH, D_MODEL, N_GROUPS), D_MODEL),
        "b_group": 0.01 * jax.random.normal(ks[15], (DEPTH, N_GROUPS), jnp.float32),
        "w_expert": nrm(ks[16], (DEPTH, D_MODEL, N_EXPERTS), D_MODEL),
        "b_expert": 0.01 * jax.random.normal(ks[17], (DEPTH, N_EXPERTS), jnp.float32),
        "w_gate": nrm(ks[18], (DEPTH, N_EXPERTS, D_MODEL, D_EXPERT), D_MODEL),
        "w_up": nrm(ks[19], (DEPTH, N_EXPERTS, D_MODEL, D_EXPERT), D_MODEL),
        "w_down": nrm(ks[20], (DEPTH, N_EXPERTS, D_EXPERT, D_MODEL), D_EXPERT),
    }


def reference(x, meta_tokens, mix_norm_g, w_in, q_lat_norm_g, w_uq, kv_lat_norm_g, w_ukv, q_head_norm_g, k_head_norm_g, w_pool, pool_scale, w_out, ffn_norm_g, w_group, b_group, w_expert, b_expert, w_gate, w_up, w_down):
    B = x.shape[0]
    meta = jnp.broadcast_to(meta_tokens[None].astype(x.dtype), (B, N_META, D_MODEL))
    h = jnp.concatenate([meta, x], axis=1)
    L = h.shape[1]
    cos, sin = rope_tables(L)
    splits = [POOL_WIDTH, POOL_WIDTH + Q_LORA_RANK, POOL_WIDTH + Q_LORA_RANK + KV_LORA_RANK]
    for l in range(DEPTH):
        n = rms_norm(h, mix_norm_g[l])
        proj = n @ w_in[l]
        u, q_lat, kv_lat, k_rope = jnp.split(proj, splits, axis=-1)
        y_pool = pool_mixer(u, w_pool[l], pool_scale[l])
        y_mla = mla_mixer(q_lat, kv_lat, k_rope, q_lat_norm_g[l], w_uq[l], kv_lat_norm_g[l], w_ukv[l],
                          q_head_norm_g[l], k_head_norm_g[l], cos, sin)
        h = h + jnp.concatenate([y_pool, y_mla], axis=-1) @ w_out[l]
        h = h + hier_moe(rms_norm(h, ffn_norm_g[l]), w_group[l], b_group[l], w_expert[l], b_expert[l],
                         w_gate[l], w_up[l], w_down[l])
    return h[:, N_META:]
```

```cpp
#include <hip/hip_runtime.h>
#include <hip/hip_bf16.h>
#include <cstdio>
#include <cstdint>

#define LAS __attribute__((address_space(3)))
#define GAS __attribute__((address_space(1)))
typedef unsigned short bf16_t;
typedef short bf16x8 __attribute__((ext_vector_type(8)));
typedef short s16x4 __attribute__((ext_vector_type(4)));
typedef float f32x4 __attribute__((ext_vector_type(4)));
typedef float f32x2 __attribute__((ext_vector_type(2)));
typedef float f32x16 __attribute__((ext_vector_type(16)));
typedef unsigned u32x4 __attribute__((ext_vector_type(4)));
typedef unsigned u32x2 __attribute__((ext_vector_type(2)));

constexpr int DM = 4096, NB = 2, SEQ = 8192, NMETA = 16, LSEQ = SEQ + NMETA  , NTOK = NB * LSEQ  , NREAL = NB * SEQ  ;
constexpr int MPAD = 16640;
constexpr int POOLW = 1024, QLR = 1024, KVLR = 512, ROPE = 64, INC = 2624, INCP = 2816;
constexpr int NH = 24, DQK = 192, DNOPE = 128, DV = 128, QW = NH * DQK  , KVW = NH * 256  ;
constexpr int NG = 8, NE = 64, DE = 512;
constexpr int NSLOT = 49152;
constexpr float EPS = 1e-6f;
constexpr float QSCALE = 0.07216878364870322f * 1.4426950408889634f;

constexpr size_t MiB = 1u << 20;
constexpr size_t WS_CTL = 0, CTL_ZERO_BYTES = 1 * MiB;
constexpr size_t WS_WIN = 1 * MiB;
constexpr size_t WS_WUQ = 23 * MiB;
constexpr size_t WS_WUKV = 32 * MiB;
constexpr size_t WS_WP = 38 * MiB;
constexpr size_t WS_WRT = 38 * MiB + 512 * 1024;
constexpr size_t WS_WO = 40 * MiB;
constexpr size_t WS_WGU = 72 * MiB;
constexpr size_t WS_WD = 584 * MiB;
constexpr size_t WS_ROPE = 840 * MiB;
constexpr size_t WS_SMALL = 843 * MiB;
constexpr size_t WS_XB = 846 * MiB;
constexpr size_t WS_PROJ = 976 * MiB;
constexpr size_t WS_DIFF = 1066 * MiB;
constexpr size_t WS_Q = 1099 * MiB;
constexpr size_t WS_KV = 1243 * MiB;
constexpr size_t WS_KF = 1438 * MiB;
constexpr size_t WS_MIX = 1585 * MiB;
constexpr size_t WS_END = 1715 * MiB;
constexpr size_t WS_H1HI = 846 * MiB;
constexpr size_t WS_H1LO = 974 * MiB;
constexpr size_t WS_SSQ2 = 1102 * MiB;
constexpr size_t WS_HID = 1106 * MiB;
constexpr size_t WS_Y = 1154 * MiB;
constexpr size_t SM_RSTD1 = 0, SM_RSTDQ = 128 * 1024, SM_RSTDKV = 256 * 1024, SM_RSTD2 = 384 * 1024, SM_ETOK = 512 * 1024, SM_RANK = 640 * 1024, SM_GTOK = 768 * 1024, SM_SLOT = 896 * 1024;
constexpr int CW_TMO = 0, CW_BAR = 4096, CW_CNT = 8192, CW_TOKSLOT = 16384, CW_GATESLOT = 65536;
static_assert((CW_GATESLOT + NSLOT) * 4 <= (int)CTL_ZERO_BYTES, "CTL");

constexpr int RING_BYTES = 131072;
constexpr int MISC_OFF = RING_BYTES;
constexpr int LDS_BYTES = 147456;

#define RLX_AGENT __ATOMIC_RELAXED, __HIP_MEMORY_SCOPE_AGENT
#define LDS_WAIT() asm volatile("s_waitcnt lgkmcnt(0)" ::: "memory")
#define VM_WAIT() asm volatile("s_waitcnt vmcnt(0)" ::: "memory")

__device__ __forceinline__ unsigned cvt_pk_bf16(float lo, float hi) { unsigned r; asm volatile("v_cvt_pk_bf16_f32 %0, %1, %2" : "=v"(r) : "v"(lo), "v"(hi)); return r; }
__device__ __forceinline__ float bf_lo(unsigned w) { return __uint_as_float(w << 16); }
__device__ __forceinline__ float bf_hi(unsigned w) { return __uint_as_float(w & 0xffff0000u); }
__device__ __forceinline__ float wave_sum(float v) {
#pragma unroll
    for (int o = 1; o < 64; o <<= 1) v += __shfl_xor(v, o);
    return v;
}

#define XB_TMO      128
#define XB_XCNT(j)  (256  + 64 * (j))
#define XB_XSUB(j)  (1280 + 64 * (j))
#define XB_XGEN(j)  (2304 + 64 * (j))
#define XB_TOP      3328
#define XB_TOPGEN   3392
#define XCD_BAR_WORDS 3456
#define XB_SPIN_CAP (1u << 18)
__device__ __forceinline__ unsigned xb_ld(unsigned* p)              { return __hip_atomic_load(p, __ATOMIC_RELAXED, __HIP_MEMORY_SCOPE_AGENT); }
__device__ __forceinline__ unsigned xb_add(unsigned* p, unsigned v) { return __hip_atomic_fetch_add(p, v, __ATOMIC_RELAXED, __HIP_MEMORY_SCOPE_AGENT); }
__device__ __forceinline__ unsigned xb_xcc_id() { return (unsigned)__builtin_amdgcn_s_getreg((3 << 11) | 20) & 0xFu; }
#define XB_SPIN(cond, bar) do { unsigned _sp = 0; while (cond) { __builtin_amdgcn_s_sleep(1); \
    if ((++_sp & 255u) == 0u) { if (xb_ld(&(bar)[XB_TMO])) break; if (_sp > XB_SPIN_CAP) { atomicAdd(&(bar)[XB_TMO], 1u); break; } } } } while (0)
struct XcdBarrier { unsigned* bar; unsigned x; volatile LAS unsigned* st; };
__device__ __forceinline__ XcdBarrier xcd_barrier_post(unsigned* bar, volatile LAS unsigned* st) {
    XcdBarrier b; b.bar = bar; b.x = xb_xcc_id(); b.st = st;
    if (threadIdx.x == 0) (void)xb_add(&bar[XB_XCNT(b.x)], 1u);
    return b;
}
__device__ __forceinline__ void xcd_barrier_complete(unsigned* bar, unsigned x, unsigned& nloc, unsigned& nx) {
    const unsigned G = gridDim.x * gridDim.y * gridDim.z;
    unsigned sum, cnt, mine, sp = 0u;
    for (;;) {
        sum = 0u; cnt = 0u; mine = 0u;
#pragma unroll
        for (unsigned j = 0; j < 16; ++j) { const unsigned c = xb_ld(&bar[XB_XCNT(j)]); sum += c; cnt += (c > 0u) ? 1u : 0u; mine = (j == x) ? c : mine; }
        if (sum == G) break;
        __builtin_amdgcn_s_sleep(1);
        if ((++sp & 255u) == 0u) { if (xb_ld(&bar[XB_TMO])) break; if (sp > XB_SPIN_CAP) { atomicAdd(&bar[XB_TMO], 1u); break; } }
    }
    nloc = mine > 0u ? mine : 1u; nx = cnt > 0u ? cnt : 1u;
}
__device__ __forceinline__ void xcd_barrier(const XcdBarrier& b) {
    asm volatile("s_waitcnt vmcnt(0)" ::: "memory");
    __syncthreads();
    if (threadIdx.x == 0) {
        unsigned* bar = b.bar;
        __builtin_amdgcn_s_waitcnt(0);
        unsigned nloc = b.st[0], nx = b.st[1];
        if (nloc == 0u) { xcd_barrier_complete(bar, b.x, nloc, nx); b.st[0] = nloc; b.st[1] = nx; }
        const unsigned old = xb_add(&bar[XB_XSUB(b.x)], 1u);
        const unsigned gen = old / nloc;
        if (old + 1u == (gen + 1u) * nloc) {
            __builtin_amdgcn_fence(__ATOMIC_RELEASE, "agent");
            asm volatile("s_waitcnt vmcnt(0)" ::: "memory");
            const unsigned og = xb_add(&bar[XB_TOP], 1u);
            const unsigned tg = og / nx;
            if (og + 1u == (tg + 1u) * nx) xb_add(&bar[XB_TOPGEN], 1u);
            else XB_SPIN(xb_ld(&bar[XB_TOPGEN]) == tg, bar);
            __builtin_amdgcn_fence(__ATOMIC_ACQUIRE, "agent");
            xb_add(&bar[XB_XGEN(b.x)], 1u);
            asm volatile("s_waitcnt vmcnt(0)" ::: "memory");
        } else {
            XB_SPIN(xb_ld(&bar[XB_XGEN(b.x)]) == gen, bar);
            __builtin_amdgcn_fence(__ATOMIC_ACQUIRE, "agent");
            asm volatile("s_waitcnt vmcnt(0)" ::: "memory");
        }
    }
    __syncthreads();
}

namespace pg8 {
constexpr int BM = 256, BK = 64, HALF = 128, HTB = HALF * BK * 2, STAGE_BYTES = 8 * HTB, NXCD = 8, WGM = 8;
__host__ __device__ __forceinline__ int lds_byte(int r, int c) { const int st = (r >> 4) * 2 + (c >> 5), rr = r & 15, cc = c & 31, ob = rr * 64 + cc * 2; return st * 1024 + (ob ^ (((ob >> 9) & 1) << 5)); }
__host__ __device__ __forceinline__ void stage_rc(int b, int& R, int& C) { const int st = b / 1024, sb = b % 1024, swz = sb ^ (((sb >> 9) & 1) << 5); R = (st >> 1) * 16 + swz / 64; C = (st & 1) * 32 + (swz % 64) / 2; }
__host__ __device__ __forceinline__ int perm32(int rho) { const int n = rho >> 4, i = rho & 15; return 8 * (i >> 2) + 4 * n + (i & 3); }

__device__ __forceinline__ void tile_of(int L, int nM, int nN, int& pm, int& pn) {
    const int nwg = nM * nN; int wgid = L;
    { const int q = nwg / NXCD, r = nwg % NXCD, xcd = wgid % NXCD, off = wgid / NXCD; wgid = (xcd < r ? xcd * (q + 1) : r * (q + 1) + (xcd - r) * q) + off; }
    const int nig = WGM * nN, gid = wgid / nig, fm = gid * WGM, gsz = (nM - fm) < WGM ? (nM - fm) : WGM;
    pm = fm + ((wgid % nig) % gsz); pn = (wgid % nig) / gsz;
}

struct GUnit {
    const char* A;
    const char* B;
    unsigned lda, ldb;
    int nk;
    const int* gather;
    char* C; unsigned ldc;
    const float* rs;
    int i0, i1;
};

struct EpiScaleBf16 {
    static constexpr bool PERM = true;
    __device__ __forceinline__ void operator()(const f32x4 (&acc)[2][2][4][2], const GUnit& u, int wr, int wc, int fr, int fq) const {
#pragma unroll
        for (int ai = 0; ai < 2; ++ai)
#pragma unroll
            for (int m = 0; m < 4; ++m) { const int r = ai * HALF + wr * 64 + m * 16 + fr; const float s = u.rs ? u.rs[r] : 1.f;
                char* rowp = u.C + (size_t)r * u.ldc + (wc * 32 + 8 * fq) * 2;
#pragma unroll
                for (int bj = 0; bj < 2; ++bj) { const f32x4 v0 = acc[ai][bj][m][0] * s, v1 = acc[ai][bj][m][1] * s;
                    u32x4 w; w.x = cvt_pk_bf16(v0[0], v0[1]); w.y = cvt_pk_bf16(v0[2], v0[3]); w.z = cvt_pk_bf16(v1[0], v1[1]); w.w = cvt_pk_bf16(v1[2], v1[3]);
                    *(u32x4*)(rowp + bj * HALF * 2) = w; } }
    }
};
struct EpiWout {
    static constexpr bool PERM = true;
    const float* x; bf16_t* hi; bf16_t* lo; float* ssq;
    __device__ __forceinline__ void operator()(const f32x4 (&acc)[2][2][4][2], const GUnit& u, int wr, int wc, int fr, int fq) const {
#pragma unroll
        for (int ai = 0; ai < 2; ++ai)
#pragma unroll
            for (int m = 0; m < 4; ++m) { const size_t row = (size_t)u.i0 + ai * HALF + wr * 64 + m * 16 + fr; const int c0 = u.i1 * BM + wc * 32 + 8 * fq; float sq = 0.f;
#pragma unroll
                for (int bj = 0; bj < 2; ++bj) { const size_t off = row * DM + c0 + bj * HALF;
                    const f32x4 v0 = acc[ai][bj][m][0] + *(const f32x4*)(x + off), v1 = acc[ai][bj][m][1] + *(const f32x4*)(x + off + 4);
                    sq += (v0[0] * v0[0] + v0[1] * v0[1]) + (v0[2] * v0[2] + v0[3] * v0[3]) + (v1[0] * v1[0] + v1[1] * v1[1]) + (v1[2] * v1[2] + v1[3] * v1[3]);
                    u32x4 w; w.x = cvt_pk_bf16(v0[0], v0[1]); w.y = cvt_pk_bf16(v0[2], v0[3]); w.z = cvt_pk_bf16(v1[0], v1[1]); w.w = cvt_pk_bf16(v1[2], v1[3]);
                    *(u32x4*)(hi + off) = w;
                    u32x4 l; l.x = cvt_pk_bf16(v0[0] - bf_lo(w.x), v0[1] - bf_hi(w.x)); l.y = cvt_pk_bf16(v0[2] - bf_lo(w.y), v0[3] - bf_hi(w.y));
                    l.z = cvt_pk_bf16(v1[0] - bf_lo(w.z), v1[1] - bf_hi(w.z)); l.w = cvt_pk_bf16(v1[2] - bf_lo(w.w), v1[3] - bf_hi(w.w));
                    *(u32x4*)(lo + off) = l; }
                sq += __shfl_xor(sq, 16); sq += __shfl_xor(sq, 32);
                if (fq == 0) ssq[row * 64 + u.i1 * 4 + wc] = sq; }
    }
};
struct EpiMoe1 {
    static constexpr bool PERM = true;
    const float* rstd2;
    __device__ __forceinline__ void operator()(const f32x4 (&acc)[2][2][4][2], const GUnit& u, int wr, int wc, int fr, int fq) const {
#pragma unroll
        for (int ai = 0; ai < 2; ++ai)
#pragma unroll
            for (int m = 0; m < 4; ++m) { const int r = ai * HALF + wr * 64 + m * 16 + fr; const float s = rstd2[u.gather[r]];
                float h[8];
#pragma unroll
                for (int n = 0; n < 2; ++n)
#pragma unroll
                    for (int j = 0; j < 4; ++j) { const float g = acc[ai][0][m][n][j] * s, up = acc[ai][1][m][n][j] * s;
                        h[n * 4 + j] = g * __builtin_amdgcn_rcpf(1.f + __builtin_amdgcn_exp2f(-1.4426950408889634f * g)) * up; }
                u32x4 w; w.x = cvt_pk_bf16(h[0], h[1]); w.y = cvt_pk_bf16(h[2], h[3]); w.z = cvt_pk_bf16(h[4], h[5]); w.w = cvt_pk_bf16(h[6], h[7]);
                *(u32x4*)(u.C + (size_t)r * u.ldc + (wc * 32 + 8 * fq) * 2) = w; }
    }
};

template <class Epi, class Sched>
__device__ __forceinline__ void gemm_phase(LAS unsigned char* lds, const Sched& S, const Epi& E) {
    const int tid = threadIdx.x, wid = __builtin_amdgcn_readfirstlane(tid >> 6), lane = tid & 63, wr = wid >> 2, wc = wid & 3, fr = lane & 15, fq = lane >> 4;
    const unsigned ldsw = (unsigned)wid * 1024u;
    const int aoff = lds_byte(wr * 64 + fr, fq * 8), boff = lds_byte(wc * 32 + fr, fq * 8);
#define PG8_SA(b, h) (((b) * 2 + (h)) * HTB)
#define PG8_SB(b, h) ((4 + (b) * 2 + (h)) * HTB)
#define PG8_STAGE(bufoff, gbase, voff) do { _Pragma("unroll") for (int _i = 0; _i < 2; ++_i) \
        __builtin_amdgcn_global_load_lds((const unsigned*)((const char*)(gbase) + (voff)[_i]), (LAS unsigned*)(lds + (bufoff) + ldsw + _i * 8192), 16, 0, 0); } while (0)
#define PG8_LDA(dst, b, h) do { _Pragma("unroll") for (int m = 0; m < 4; ++m) _Pragma("unroll") for (int k = 0; k < 2; ++k) dst[m][k] = *(const LAS bf16x8*)(lds + PG8_SA(b, h) + aoff + m * 2048 + k * 1024); } while (0)
#define PG8_LDB(dst, b, h) do { _Pragma("unroll") for (int n = 0; n < 2; ++n) _Pragma("unroll") for (int k = 0; k < 2; ++k) dst[n][k] = *(const LAS bf16x8*)(lds + PG8_SB(b, h) + boff + n * 2048 + k * 1024); } while (0)
#define PG8_MMA(ai, bj, At, Bt) do { __builtin_amdgcn_s_setprio(1); _Pragma("unroll") for (int m = 0; m < 4; ++m) _Pragma("unroll") for (int n = 0; n < 2; ++n) _Pragma("unroll") for (int k = 0; k < 2; ++k) \
        acc[ai][bj][m][n] = __builtin_amdgcn_mfma_f32_16x16x32_bf16(Bt[n][k], At[m][k], acc[ai][bj][m][n], 0, 0, 0); __builtin_amdgcn_s_setprio(0); } while (0)
#define PG8_WAIT_V(n) asm volatile("s_waitcnt vmcnt(" #n ")" ::: "memory")
#define PG8_WAIT_L(n) asm volatile("s_waitcnt lgkmcnt(" #n ")" ::: "memory")
#define PG8_BAR __builtin_amdgcn_s_barrier()
#define PG8_SCHED __builtin_amdgcn_sched_barrier(0)
#define PG8_OFFS(u, gi0, gi1) do { _Pragma("unroll") for (int _i = 0; _i < 2; ++_i) { int R_, C_; stage_rc(tid * 16 + _i * 8192, R_, C_); \
        const int Rb_ = Epi::PERM ? ((R_ & ~31) + perm32(R_ & 31)) : R_; int r0_ = R_, r1_ = HALF + R_; if (Sched::GATHER) { r0_ = gi0[_i]; r1_ = gi1[_i]; } \
        vA0[_i] = (unsigned)r0_ * (u).lda + (unsigned)C_ * 2u; vA1[_i] = (unsigned)r1_ * (u).lda + (unsigned)C_ * 2u; \
        vB[_i] = (unsigned)Rb_ * (u).ldb + (unsigned)C_ * 2u; } hsB = (unsigned)HALF * (u).ldb; } while (0)
#define PG8_GIDX(u, gi0, gi1) do { if (Sched::GATHER) { _Pragma("unroll") for (int _i = 0; _i < 2; ++_i) { int R_, C_; stage_rc(tid * 16 + _i * 8192, R_, C_); gi0[_i] = (u).gather[R_]; gi1[_i] = (u).gather[HALF + R_]; } } } while (0)
    GUnit cur, nxt; int ui = 0;
    if (!S.next(0, cur)) return;
    f32x4 acc[2][2][4][2];
#pragma unroll
    for (int a = 0; a < 2; ++a)
#pragma unroll
        for (int b = 0; b < 2; ++b)
#pragma unroll
            for (int m = 0; m < 4; ++m)
#pragma unroll
                for (int n = 0; n < 2; ++n) acc[a][b][m][n] = (f32x4){0.f, 0.f, 0.f, 0.f};
    bf16x8 At[4][2], B0[2][2], B1[2][2];
    unsigned vA0[2], vA1[2], vB[2]; unsigned hsB; int gi0[2] = {0, 0}, gi1[2] = {0, 0};
    PG8_GIDX(cur, gi0, gi1); PG8_OFFS(cur, gi0, gi1);
    const char* cA = cur.A; const char* cB = cur.B;
    const size_t kstep = (size_t)(BK * 2);
    PG8_STAGE(PG8_SB(0, 0), cB, vB); PG8_STAGE(PG8_SB(0, 1), cB + hsB, vB); PG8_STAGE(PG8_SA(0, 0), cA, vA0); PG8_STAGE(PG8_SA(0, 1), cA, vA1);
    if (wr == 1) PG8_BAR;
    PG8_WAIT_V(2); PG8_BAR;
    PG8_STAGE(PG8_SB(1, 0), cB + kstep, vB); PG8_STAGE(PG8_SA(1, 0), cA + kstep, vA0); PG8_STAGE(PG8_SB(1, 1), cB + hsB + kstep, vB);
    PG8_WAIT_V(6); PG8_BAR;
    for (;;) {
        const bool has_next = S.next(ui + 1, nxt);
        const char* nA = cA; const char* nBp = cB;
        if (has_next) { nA = nxt.A; nBp = nxt.B; PG8_GIDX(nxt, gi0, gi1); }
        const int nt = cur.nk;
        for (int t = 0; t < nt; t += 2) {
            const bool last = (t == nt - 2);
            const char* a1 = cA + (size_t)(t + 1) * kstep;
            const char* a2 = last ? nA : cA + (size_t)(t + 2) * kstep; const char* b2 = last ? nBp : cB + (size_t)(t + 2) * kstep;
            const char* a3 = a2 + kstep; const char* b3 = b2 + kstep;
            PG8_LDB(B0, 0, 0); PG8_LDB(B1, 0, 1); PG8_SCHED; PG8_LDA(At, 0, 0); PG8_STAGE(PG8_SA(1, 1), a1, vA1);
            if (last && has_next) { PG8_OFFS(nxt, gi0, gi1); }
            PG8_WAIT_V(8); PG8_WAIT_L(0); PG8_BAR; PG8_MMA(0, 0, At, B0); PG8_MMA(0, 1, At, B1); PG8_BAR; PG8_SCHED;
            PG8_LDA(At, 0, 1); PG8_STAGE(PG8_SB(0, 0), b2, vB); PG8_STAGE(PG8_SB(0, 1), b2 + hsB, vB); PG8_STAGE(PG8_SA(0, 0), a2, vA0);
            PG8_WAIT_V(8); PG8_WAIT_L(0); PG8_BAR; PG8_MMA(1, 0, At, B0); PG8_MMA(1, 1, At, B1); PG8_BAR; PG8_SCHED;
            PG8_LDB(B0, 1, 0); PG8_LDB(B1, 1, 1); PG8_SCHED; PG8_LDA(At, 1, 0); PG8_STAGE(PG8_SA(0, 1), a2, vA1);
            PG8_WAIT_V(8); PG8_WAIT_L(0); PG8_BAR; PG8_MMA(0, 0, At, B0); PG8_MMA(0, 1, At, B1); PG8_BAR; PG8_SCHED;
            PG8_LDA(At, 1, 1); PG8_STAGE(PG8_SB(1, 0), b3, vB); PG8_STAGE(PG8_SB(1, 1), b3 + hsB, vB); PG8_STAGE(PG8_SA(1, 0), a3, vA0);
            PG8_WAIT_V(8); PG8_WAIT_L(0); PG8_BAR; PG8_MMA(1, 0, At, B0); PG8_MMA(1, 1, At, B1); PG8_BAR; PG8_SCHED;
        }
        if (wr == 0) PG8_BAR;
        { int fr_ = fr, fq_ = fq; asm volatile("" : "+v"(fr_), "+v"(fq_)); E(acc, cur, wr, wc, fr_, fq_); }
        if (!has_next) break;
#pragma unroll
        for (int a = 0; a < 2; ++a)
#pragma unroll
            for (int b = 0; b < 2; ++b)
#pragma unroll
                for (int m = 0; m < 4; ++m)
#pragma unroll
                    for (int n = 0; n < 2; ++n) acc[a][b][m][n] = (f32x4){0.f, 0.f, 0.f, 0.f};
        cur = nxt; cA = nA; cB = nBp; ++ui;
        if (wr == 1) PG8_BAR;
    }
    PG8_WAIT_V(0);
    PG8_BAR;
#undef PG8_SA
#undef PG8_SB
#undef PG8_STAGE
#undef PG8_LDA
#undef PG8_LDB
#undef PG8_MMA
#undef PG8_WAIT_V
#undef PG8_WAIT_L
#undef PG8_BAR
#undef PG8_SCHED
#undef PG8_OFFS
#undef PG8_GIDX
}
}
namespace att {
constexpr int NW = 8, QBLK = 32, KVBLK = 64, QB = 256;
constexpr int KT_BYTES = 64 * 384, VT_BYTES = 64 * 256;
constexpr int LDS_K = 0, LDS_V = 3 * KT_BYTES, LDS_WS = LDS_V + 3 * VT_BYTES, LDS_TOTAL = LDS_WS + NW * 256;
constexpr unsigned KROW = QW * 2, VROW = KVW * 2;
constexpr float THR = 8.f;
#define SBAR() __builtin_amdgcn_sched_barrier(0)
__device__ __forceinline__ int crow(int r, int hi) { return (r & 3) + 8 * (r >> 2) + 4 * hi; }
__device__ __forceinline__ void glds16(const void* gsrc, unsigned lds_dst) { unsigned keep;
    asm volatile("s_mov_b32 %0, m0\n\ts_mov_b32 m0, %2\n\ts_nop 0\n\tglobal_load_lds_dwordx4 %1, off\n\ts_mov_b32 m0, %0" : "=&s"(keep) : "v"(gsrc), "s"(lds_dst) : "memory"); }
#define WAIT_BAR(N) asm volatile("s_waitcnt vmcnt(" #N ") lgkmcnt(0)\n\ts_barrier" ::: "memory")
__device__ __forceinline__ int v_rd_base(int lane) { return ((lane & 3) << 3) | (((lane >> 2) & 3) << 6) | (((lane >> 4) & 1) << 5) | (((lane >> 5) & 1) << 8); }
constexpr int v_rd_off(int d0, int ks, int half) { return d0 * 512 + ks * 4096 + half * 2048; }

__device__ __forceinline__ void mask_tile(f32x16& p0, f32x16& p1, int dq) {
    const float NEG = -__builtin_inff();
#pragma unroll
    for (int r = 0; r < 16; ++r) { const int c = (r & 3) + 8 * (r >> 2);
        if (dq - c < 0) p0[r] = NEG;
        if (dq - c - 32 < 0) p1[r] = NEG; }
}
__device__ __forceinline__ void partialSM(f32x16& p0, f32x16& p1, float& m_reg, float& mn, float& alpha) {
    float pmax = p0[0];
#pragma unroll
    for (int r = 1; r < 16; ++r) pmax = fmaxf(pmax, p0[r]);
#pragma unroll
    for (int r = 0; r < 16; ++r) pmax = fmaxf(pmax, p1[r]);
    { auto rr = __builtin_amdgcn_permlane32_swap(__float_as_uint(pmax), __float_as_uint(pmax), false, false);
      pmax = fmaxf(__uint_as_float(rr[0]), __uint_as_float(rr[1])); }
    if (__builtin_expect(__all(pmax - m_reg <= THR), 1)) { mn = m_reg; alpha = 1.f; }
    else { mn = fmaxf(m_reg, pmax); alpha = __builtin_amdgcn_exp2f(m_reg - mn); m_reg = mn; }
#pragma unroll
    for (int r = 0; r < 16; ++r) { p0[r] = p0[r] - mn; p1[r] = p1[r] - mn; }
#pragma unroll
    for (int r = 0; r < 16; ++r) p0[r] = __builtin_amdgcn_exp2f(p0[r]);
}
__device__ __forceinline__ void finishSM(f32x16& p0, f32x16& p1, float alpha, float& l_reg, bf16x8& pa0, bf16x8& pa1, bf16x8& pa2, bf16x8& pa3) {
#pragma unroll
    for (int r = 0; r < 16; ++r) p1[r] = __builtin_amdgcn_exp2f(p1[r]);
    float ps = 0;
#pragma unroll
    for (int r = 0; r < 16; ++r) ps += p0[r];
#pragma unroll
    for (int r = 0; r < 16; ++r) ps += p1[r];
    { auto rr = __builtin_amdgcn_permlane32_swap(__float_as_uint(ps), __float_as_uint(ps), false, false);
      ps = __uint_as_float(rr[0]) + __uint_as_float(rr[1]); }
    l_reg = l_reg * alpha + ps;
#define PK4(P, B_, OUT) do { unsigned a0 = cvt_pk_bf16(P[B_+0], P[B_+1]), a1 = cvt_pk_bf16(P[B_+2], P[B_+3]);                          \
        unsigned b0 = cvt_pk_bf16(P[B_+4], P[B_+5]), b1 = cvt_pk_bf16(P[B_+6], P[B_+7]);                                             \
        auto r0 = __builtin_amdgcn_permlane32_swap(a0, b0, false, false); auto r1 = __builtin_amdgcn_permlane32_swap(a1, b1, false, false); \
        u32x4 w = {r0[0], r1[0], r0[1], r1[1]}; OUT = __builtin_bit_cast(bf16x8, w); } while (0)
    PK4(p0, 0, pa0); PK4(p0, 8, pa1); PK4(p1, 0, pa2); PK4(p1, 8, pa3);
#undef PK4
}
__device__ __forceinline__ void qkt(f32x16& p0, f32x16& p1, const LAS char* const (&kb)[4], const bf16x8 (&qr)[12]) {
    p0 = f32x16{}; p1 = f32x16{};
#pragma unroll
    for (int d0 = 0; d0 < 12; ++d0) { const LAS char* a = kb[d0 & 3] + (d0 >> 2) * 128;
        const bf16x8 b0 = *(const LAS bf16x8*)(a);
        const bf16x8 b1 = *(const LAS bf16x8*)(a + 32 * 384);
        p0 = __builtin_amdgcn_mfma_f32_32x32x16_bf16(b0, qr[d0], p0, 0, 0, 0);
        p1 = __builtin_amdgcn_mfma_f32_32x32x16_bf16(b1, qr[d0], p1, 0, 0, 0); }
}
__device__ __forceinline__ void pv_tile(f32x16* o, int vb0, bf16x8 pa0, bf16x8 pa1, bf16x8 pa2, bf16x8 pa3) {
#define TRRD(dst, off) asm volatile("ds_read_b64_tr_b16 %0, %1 offset:%2" : "=&v"(dst) : "v"(vb0), "i"(off) : "memory")
#define PV_D0(d0) do { s16x4 l0, l1, l2, l3, h0, h1, h2, h3; constexpr int b_ = v_rd_off(d0, 0, 0); \
        TRRD(l0, b_); TRRD(h0, b_ + 2048); TRRD(l1, b_ + 4096); TRRD(h1, b_ + 6144); TRRD(l2, b_ + 8192); TRRD(h2, b_ + 10240); TRRD(l3, b_ + 12288); TRRD(h3, b_ + 14336); \
        asm volatile("s_waitcnt lgkmcnt(0)" ::: "memory"); SBAR(); \
        o[d0] = __builtin_amdgcn_mfma_f32_32x32x16_bf16(pa0, (bf16x8){l0[0], l0[1], l0[2], l0[3], h0[0], h0[1], h0[2], h0[3]}, o[d0], 0, 0, 0);   \
        o[d0] = __builtin_amdgcn_mfma_f32_32x32x16_bf16(pa1, (bf16x8){l1[0], l1[1], l1[2], l1[3], h1[0], h1[1], h1[2], h1[3]}, o[d0], 0, 0, 0);   \
        o[d0] = __builtin_amdgcn_mfma_f32_32x32x16_bf16(pa2, (bf16x8){l2[0], l2[1], l2[2], l2[3], h2[0], h2[1], h2[2], h2[3]}, o[d0], 0, 0, 0);   \
        o[d0] = __builtin_amdgcn_mfma_f32_32x32x16_bf16(pa3, (bf16x8){l3[0], l3[1], l3[2], l3[3], h3[0], h3[1], h3[2], h3[3]}, o[d0], 0, 0, 0); } while (0)
    PV_D0(0); PV_D0(1); PV_D0(2); PV_D0(3);
#undef PV_D0
#undef TRRD
}

__device__ __forceinline__ void attn_unit(int b, int h, int qb, const bf16_t* Q, const bf16_t* KF, const bf16_t* KV, bf16_t* MIX, LAS char* shm) {
    const int tid = threadIdx.x, lane = tid & 63, r32 = lane & 31, hi = lane >> 5; const int wid = __builtin_amdgcn_readfirstlane(tid >> 6);
    const int NT = 4 * qb + 5;
    const char* Kg = (const char*)KF + ((size_t)(b * LSEQ) * QW + h * DQK) * 2;
    const char* Vg = (const char*)KV + ((size_t)(b * LSEQ) * KVW + h * 256 + 128) * 2;
    const char* Qg = (const char*)Q + ((size_t)(b * SEQ + qb * QB + wid * QBLK + r32) * QW + h * DQK) * 2;
    const unsigned lds0 = (unsigned)(uintptr_t)shm;
    bf16x8 qr[12];
#pragma unroll
    for (int d0 = 0; d0 < 12; ++d0) qr[d0] = *(const bf16x8*)(Qg + (d0 * 16 + hi * 8) * 2);
    unsigned kof[3], vof[2];
#pragma unroll
    for (int j = 0; j < 3; ++j) { const int q = (wid * 3 + j) * 64 + lane, row = q / 24, chp = q - row * 24; const int ch = (chp & ~7) | ((chp & 7) ^ ((row >> 1) & 7));
        kof[j] = (unsigned)row * KROW + (unsigned)ch * 16u; }
#pragma unroll
    for (int j = 0; j < 2; ++j) { const int q = (wid * 2 + j) * 64 + lane, s = q >> 5; const int kk = (s >> 2) * 8 + ((q & 31) >> 2), c = (s & 3) * 32 + (q & 3) * 8;
        const int k = (kk & ~0xC) | ((kk & 4) << 1) | ((kk & 8) >> 1);
        vof[j] = (unsigned)k * VROW + (unsigned)c * 2u; }
    const unsigned kdst = lds0 + LDS_K + wid * 3072, vdst = lds0 + LDS_V + wid * 2048;
#define DMA_K(t, slot) do { const char* g_ = Kg + (size_t)(t) * (KVBLK * KROW); _Pragma("unroll") for (int j_ = 0; j_ < 3; ++j_) glds16(g_ + kof[j_], (unsigned)__builtin_amdgcn_readfirstlane(kdst + (slot) * KT_BYTES + j_ * 1024)); } while (0)
#define DMA_V(t, slot) do { const char* g_ = Vg + (size_t)(t) * (KVBLK * VROW); _Pragma("unroll") for (int j_ = 0; j_ < 2; ++j_) glds16(g_ + vof[j_], (unsigned)__builtin_amdgcn_readfirstlane(vdst + (slot) * VT_BYTES + j_ * 1024)); } while (0)
    DMA_K(0, 0); DMA_V(0, 0); DMA_K(1, 1);
    const LAS char* shm3 = (const LAS char*)shm;
    const int key7 = (r32 >> 1) & 7;
    const LAS char* kb0[4];
#pragma unroll
    for (int dd = 0; dd < 4; ++dd) kb0[dd] = shm3 + LDS_K + r32 * 384 + 16 * ((2 * dd + hi) ^ key7);
    const int vb0 = (int)(lds0 + LDS_V) + v_rd_base(lane);
    LAS float* ws = (LAS float*)(shm + LDS_WS) + wid * 64; LAS float* li_l = ws; LAS float* al_l = ws + 32;
    float m_reg = -1e30f, l_reg = 0.f; f32x16 o[4] = {};
    const int qlo = NMETA + qb * QB + wid * QBLK;
    const int qm = qlo + r32 - 4 * hi;
#define RESC(a) do { if (__any((a) < 1.f)) { if (hi == 0) al_l[r32] = (a); asm volatile("s_waitcnt lgkmcnt(0)" ::: "memory");              \
                     _Pragma("unroll") for (int d_ = 0; d_ < 4; ++d_) _Pragma("unroll") for (int r = 0; r < 16; ++r) o[d_][r] *= al_l[crow(r, hi)]; } } while (0)
#define MASKT(P0_, P1_, t) do { const int kb_ = (t) * KVBLK; if (kb_ + KVBLK - 1 > qlo) mask_tile(P0_, P1_, qm - kb_); } while (0)
    f32x16 pA0, pA1, pB0, pB1; float mnA, mnB, alA, alB; bf16x8 pa0, pa1, pa2, pa3;
    int sK = 0, sKn = 1, sKnn = 2;
    int sVp = 2, sV = 0, sVn = 1;
#define ROT() do { int t_ = sK; sK = sKn; sKn = sKnn; sKnn = t_; t_ = sVp; sVp = sV; sV = sVn; sVn = t_; } while (0)
    WAIT_BAR(0);
    DMA_K(2, sKnn); DMA_V(1, sVn);
    { const LAS char* kb[4] = {kb0[0] + sK * KT_BYTES, kb0[1] + sK * KT_BYTES, kb0[2] + sK * KT_BYTES, kb0[3] + sK * KT_BYTES};
      qkt(pA0, pA1, kb, qr); }
    MASKT(pA0, pA1, 0); partialSM(pA0, pA1, m_reg, mnA, alA);
    RESC(alA);
    WAIT_BAR(5);
    ROT();
#define STEP(PX0, PX1, mnX, alX, PY0, PY1, alY, t) do {                                                                        \
        const bool gk_ = (t) + 2 < NT, gv_ = (t) + 1 < NT;                                                                   \
        if (gk_) DMA_K((t) + 2, sKnn); if (gv_) DMA_V((t) + 1, sVn);                                                        \
        { const LAS char* kb[4] = {kb0[0] + sK * KT_BYTES, kb0[1] + sK * KT_BYTES, kb0[2] + sK * KT_BYTES, kb0[3] + sK * KT_BYTES}; \
          SBAR(); qkt(PX0, PX1, kb, qr); }                                                                                   \
        finishSM(PY0, PY1, alY, l_reg, pa0, pa1, pa2, pa3); SBAR();                                                          \
        pv_tile(o, vb0 + sVp * VT_BYTES, pa0, pa1, pa2, pa3); MASKT(PX0, PX1, (t)); partialSM(PX0, PX1, m_reg, mnX, alX);   \
        RESC(alX);                                                                                                            \
        if (gk_) { WAIT_BAR(5); } else if (gv_) { WAIT_BAR(2); } else { WAIT_BAR(0); }                                        \
        ROT(); } while (0)
    for (int t = 1; t + 1 < NT; t += 2) {
        STEP(pB0, pB1, mnB, alB, pA0, pA1, alA, t);
        STEP(pA0, pA1, mnA, alA, pB0, pB1, alB, t + 1);
    }
    finishSM(pA0, pA1, alA, l_reg, pa0, pa1, pa2, pa3); SBAR();
    pv_tile(o, vb0 + sVp * VT_BYTES, pa0, pa1, pa2, pa3);
    if (hi == 0) li_l[r32] = l_reg; asm volatile("s_waitcnt lgkmcnt(0)" ::: "memory");
    float rli[16];
#pragma unroll
    for (int r = 0; r < 16; ++r) rli[r] = __builtin_amdgcn_rcpf(li_l[crow(r, hi)]);
    bf16_t* Ow = MIX + (size_t)(b * LSEQ + NMETA + qb * QB + wid * QBLK) * DM + POOLW + h * DV;
#pragma unroll
    for (int r = 0; r < 16; ++r) { const int orow = crow(r, hi);
#pragma unroll
        for (int d0 = 0; d0 < 4; ++d0) { const float v = o[d0][r] * rli[r]; const float vn = __shfl_xor(v, 1);
            if ((r32 & 1) == 0) *(unsigned*)(Ow + (size_t)orow * DM + d0 * 32 + r32) = cvt_pk_bf16(v, vn); } }
    asm volatile("s_waitcnt lgkmcnt(0)\n\ts_barrier" ::: "memory");
#undef DMA_K
#undef DMA_V
#undef RESC
#undef MASKT
#undef ROT
#undef STEP
}
#undef SBAR
#undef WAIT_BAR
}
constexpr int NWAVES = 8;
struct Frame {
    LAS unsigned char* lds;
    volatile LAS unsigned* MISC;
    unsigned* ctl;
    int tid, lane, wave, vcu, G;
    const float* in[21]; float* out; unsigned char* ws;
};
enum { IN_X = 0, IN_META, IN_MIXG, IN_WIN, IN_QLG, IN_WUQ, IN_KVLG, IN_WUKV, IN_QHG, IN_KHG, IN_WPOOL, IN_PSCALE, IN_WOUT, IN_FFNG, IN_WGROUP, IN_BGROUP, IN_WEXP, IN_BEXP, IN_WGATE, IN_WUP, IN_WDOWN };
#define WSP(T, off) ((T*)(F.ws + (off)))

__device__ __forceinline__ void tr_item(const float* W, int ldw, int k0, int n0, bf16_t* WT, size_t dst_row0, int ldt, const float* sk, const float* sn, LAS float* scr, int lane) {
#pragma unroll 8
    for (int i = 0; i < 32; ++i) { const int kk = 2 * i + (lane >> 5); float v = W[(size_t)(k0 + kk) * ldw + n0 + (lane & 31)]; if (sk) v *= sk[k0 + kk]; scr[kk * 33 + (lane & 31)] = v; }
    LDS_WAIT(); asm volatile("" ::: "memory");
    const int c = lane & 7;
#pragma unroll
    for (int j = 0; j < 4; ++j) { const int n = (lane >> 3) + 8 * j; const LAS float* s = scr + (8 * c) * 33 + n; const float g = sn ? sn[n0 + n] : 1.f;
        u32x4 o; o.x = cvt_pk_bf16(s[0 * 33] * g, s[1 * 33] * g); o.y = cvt_pk_bf16(s[2 * 33] * g, s[3 * 33] * g); o.z = cvt_pk_bf16(s[4 * 33] * g, s[5 * 33] * g); o.w = cvt_pk_bf16(s[6 * 33] * g, s[7 * 33] * g);
        *(u32x4*)(WT + (dst_row0 + n) * ldt + k0 + 8 * c) = o; }
    LDS_WAIT(); asm volatile("" ::: "memory");
}
__device__ __forceinline__ void p0_prologue(Frame& F) {
    LAS float* scr = (LAS float*)(F.lds + F.wave * 16384);
    const int gw = F.vcu * NWAVES + F.wave, NGW = F.G * NWAVES, lane = F.lane;
    const int gt = gw * 64 + lane, NGT = NGW * 64;
    constexpr int I_IN = 64 * 82, I_UQ = 16 * 144, I_UKV = 8 * 192, I_P = 4 * 4 * 8, I_O = 64 * 128, I_G = 64 * 64 * 16, I_U = I_G, I_D = 64 * 8 * 128;
    constexpr int NITEMS = I_IN + I_UQ + I_UKV + I_P + I_O + I_G + I_U + I_D;
    for (int it = gw; it < NITEMS; it += NGW) {
        int r = it;
        if (r < I_IN) { const int kb = r / 82, nb = r % 82; tr_item(F.in[IN_WIN], INC, 64 * kb, 32 * nb, WSP(bf16_t, WS_WIN), 32 * nb, DM, F.in[IN_MIXG], nullptr, scr, lane); continue; } r -= I_IN;
        if (r < I_UQ) { const int kb = r / 144, nb = r % 144; tr_item(F.in[IN_WUQ], QW, 64 * kb, 32 * nb, WSP(bf16_t, WS_WUQ), 32 * nb, QLR, F.in[IN_QLG], nullptr, scr, lane); continue; } r -= I_UQ;
        if (r < I_UKV) { const int kb = r / 192, nb = r % 192; tr_item(F.in[IN_WUKV], KVW, 64 * kb, 32 * nb, WSP(bf16_t, WS_WUKV), 32 * nb, KVLR, F.in[IN_KVLG], nullptr, scr, lane); continue; } r -= I_UKV;
        if (r < I_P) { const int g = r / 32, q = r % 32, kb = q / 8, nb = q % 8;
            tr_item(F.in[IN_WPOOL] + (size_t)g * 65536, 256, 64 * kb, 32 * nb, WSP(bf16_t, WS_WP) + (size_t)g * 65536, 32 * nb, 256, nullptr, F.in[IN_PSCALE] + g * 256, scr, lane); continue; } r -= I_P;
        if (r < I_O) { const int kb = r / 128, nb = r % 128; tr_item(F.in[IN_WOUT], DM, 64 * kb, 32 * nb, WSP(bf16_t, WS_WO), 32 * nb, DM, nullptr, nullptr, scr, lane); continue; } r -= I_O;
        if (r < I_G + I_U) { const bool up = r >= I_G; if (up) r -= I_G; const int e = r / 1024, q = r % 1024, kb = q / 16, nb = q % 16; const int n0 = 32 * nb;
            tr_item(F.in[up ? IN_WUP : IN_WGATE] + (size_t)e * DM * DE, DE, 64 * kb, n0, WSP(bf16_t, WS_WGU) + (size_t)e * 1024 * DM, (size_t)((n0 >> 7) * 256 + (up ? 128 : 0) + (n0 & 127)), DM, F.in[IN_FFNG], nullptr, scr, lane); continue; } r -= I_G + I_U;
        { const int e = r / 1024, q = r % 1024, kb = q / 128, nb = q % 128;
            tr_item(F.in[IN_WDOWN] + (size_t)e * DE * DM, DM, 64 * kb, 32 * nb, WSP(bf16_t, WS_WD) + (size_t)e * DM * DE, 32 * nb, DE, nullptr, nullptr, scr, lane); }
    }
    { bf16_t* hi = WSP(bf16_t, WS_WRT); bf16_t* lo = hi + 96 * DM;
      for (int i = gt; i < 96 * DM; i += NGT) { const int j = i / DM, k = i % DM; float v = 0.f;
          if (j < 8) v = F.in[IN_WGROUP][(size_t)k * NG + j] * F.in[IN_FFNG][k]; else if (j < 72) v = F.in[IN_WEXP][(size_t)k * NE + (j - 8)] * F.in[IN_FFNG][k];
          const unsigned h = cvt_pk_bf16(v, 0.f) & 0xffffu; hi[i] = (bf16_t)h; lo[i] = (bf16_t)(cvt_pk_bf16(v - bf_lo(h), 0.f) & 0xffffu); } }
    { float* rt = WSP(float, WS_ROPE);
      for (int i = gt; i < LSEQ * 32; i += NGT) { const int t = i >> 5, f = i & 31; const float inv = 1.0f / powf(10000.0f, (float)(2 * f) / (float)ROPE); const float ang = (float)t * inv;
          rt[t * 64 + f] = cosf(ang); rt[t * 64 + 32 + f] = sinf(ang); } }
    { float* rstd1 = WSP(float, WS_SMALL + SM_RSTD1); bf16_t* XB = WSP(bf16_t, WS_XB);
      for (int row = gw; row < MPAD; row += NGW) {
          unsigned long long* o8 = (unsigned long long*)(XB + (size_t)row * DM) + lane;
          if (row >= NTOK) {
#pragma unroll
              for (int j = 0; j < 16; ++j) o8[64 * j] = 0ull;
              if (lane == 0) rstd1[row] = 0.f; continue; }
          const int b = row / LSEQ, t = row % LSEQ;
          const float* h = t < NMETA ? F.in[IN_META] + (size_t)t * DM : F.in[IN_X] + ((size_t)b * SEQ + (t - NMETA)) * DM;
          const f32x4* xr = (const f32x4*)h + lane; f32x4 v[16]; float s = 0.f;
#pragma unroll
          for (int j = 0; j < 16; ++j) { v[j] = xr[64 * j]; s += (v[j].x * v[j].x + v[j].y * v[j].y) + (v[j].z * v[j].z + v[j].w * v[j].w); }
          s = wave_sum(s);
          if (lane == 0) rstd1[row] = rsqrtf(s * (1.f / DM) + EPS);
#pragma unroll
          for (int j = 0; j < 16; ++j) o8[64 * j] = (unsigned long long)cvt_pk_bf16(v[j].x, v[j].y) | ((unsigned long long)cvt_pk_bf16(v[j].z, v[j].w) << 32);
      } }
}

template <int W> __device__ __forceinline__ void pool_cols(const bf16_t* PROJ, bf16_t* DIFF, int row0, int t0, int c) {
    float v0[31], v1[31];
#pragma unroll
    for (int i = 0; i < 31; ++i) { const int dt = i - 15; unsigned w = 0u; if (t0 + dt >= 0) w = *(const unsigned*)(PROJ + (size_t)(row0 + dt) * INCP + c); v0[i] = bf_lo(w); v1[i] = bf_hi(w); }
#pragma unroll
    for (int i = 0; i < 16; ++i) { float s0 = 0.f, s1 = 0.f;
#pragma unroll
        for (int j = 0; j < W; ++j) { s0 += v0[15 + i - j]; s1 += v1[15 + i - j]; }
        const int t = t0 + i; const float inv = 1.f / (float)((t + 1 < W) ? t + 1 : W);
        *(unsigned*)(DIFF + (size_t)(row0 + i) * POOLW + c) = cvt_pk_bf16(s0 * inv - v0[15 + i], s1 * inv - v1[15 + i]); }
}
__device__ __forceinline__ void s2_phase(Frame& F) {
    const bf16_t* PROJ = WSP(bf16_t, WS_PROJ); bf16_t* DIFF = WSP(bf16_t, WS_DIFF);
    float* rstdq = WSP(float, WS_SMALL + SM_RSTDQ); float* rstdkv = WSP(float, WS_SMALL + SM_RSTDKV);
    for (int tile = F.vcu; tile < MPAD / 16; tile += F.G) {
        const int row0 = tile * 16, t0 = row0 % LSEQ;
        const int c = 2 * F.tid, gi = F.wave >> 1;
        if (gi == 0) pool_cols<2>(PROJ, DIFF, row0, t0, c); else if (gi == 1) pool_cols<4>(PROJ, DIFF, row0, t0, c); else if (gi == 2) pool_cols<8>(PROJ, DIFF, row0, t0, c); else pool_cols<16>(PROJ, DIFF, row0, t0, c);
#pragma unroll
        for (int rr = 0; rr < 2; ++rr) { const int row = row0 + 2 * F.wave + rr; const bf16_t* p = PROJ + (size_t)row * INCP;
            const u32x4 a = *(const u32x4*)(p + POOLW + 8 * F.lane), b = *(const u32x4*)(p + POOLW + 512 + 8 * F.lane), k = *(const u32x4*)(p + POOLW + QLR + 8 * F.lane);
            float sq = 0.f, sk = 0.f;
#pragma unroll
            for (int j = 0; j < 4; ++j) { float x;
                x = bf_lo(a[j]); sq += x * x; x = bf_hi(a[j]); sq += x * x; x = bf_lo(b[j]); sq += x * x; x = bf_hi(b[j]); sq += x * x;
                x = bf_lo(k[j]); sk += x * x; x = bf_hi(k[j]); sk += x * x; }
            sq = wave_sum(sq); sk = wave_sum(sk);
            if (F.lane == 0) { rstdq[row] = rsqrtf(sq * (1.f / QLR) + EPS); rstdkv[row] = rsqrtf(sk * (1.f / KVLR) + EPS); } }
    }
}

__device__ __forceinline__ void s4_phase(Frame& F) {
    const int gw = F.vcu * NWAVES + F.wave, NGW = F.G * NWAVES, lane = F.lane, hh = lane >> 5, c = lane & 31;
    const bool act = c < 24; const int cc = act ? c : 0;
    const float* rope = WSP(float, WS_ROPE); const bf16_t* PROJ = WSP(bf16_t, WS_PROJ); const bf16_t* KV = WSP(bf16_t, WS_KV); bf16_t* Q = WSP(bf16_t, WS_Q); bf16_t* KF = WSP(bf16_t, WS_KF);
    float gq[8], gk[8];
#pragma unroll
    for (int j = 0; j < 8; ++j) { gq[j] = F.in[IN_QHG][8 * cc + j]; gk[j] = F.in[IN_KHG][8 * cc + j]; }
    const bool isrope = c >= 16 && c < 24; const bool second = c >= 20;
    const int f0 = isrope ? 8 * ((c - 16) & 3) : 0;
    for (int item = gw; item < NREAL + NTOK; item += NGW) {
        const bool isq = item < NREAL;
        int row, t;
        if (isq) { row = item; t = NMETA + (item % SEQ); } else { row = item - NREAL; t = row % LSEQ; }
        float cs[8], sn[8];
#pragma unroll
        for (int j = 0; j < 8; ++j) { cs[j] = rope[t * 64 + f0 + j]; sn[j] = rope[t * 64 + 32 + f0 + j]; }
        u32x4 kpe = {0u, 0u, 0u, 0u};
        if (!isq && isrope) kpe = *(const u32x4*)(PROJ + (size_t)row * INCP + POOLW + QLR + KVLR + 8 * (c - 16));
        for (int hp = 0; hp < 12; ++hp) { const int h = 2 * hp + hh;
            u32x4 w = {0u, 0u, 0u, 0u};
            if (isq) { if (act) w = *(const u32x4*)(Q + (size_t)row * QW + h * DQK + 8 * c); }
            else { if (c < 16) w = *(const u32x4*)(KV + (size_t)row * KVW + h * 256 + 8 * c); else w = kpe; }
            float v[8];
#pragma unroll
            for (int j = 0; j < 4; ++j) { v[2 * j] = bf_lo(w[j]); v[2 * j + 1] = bf_hi(w[j]); }
            float s = 0.f;
#pragma unroll
            for (int j = 0; j < 8; ++j) s += v[j] * v[j];
#pragma unroll
            for (int o = 1; o < 32; o <<= 1) s += __shfl_xor(s, o);
            const float r = rsqrtf(s * (1.f / DQK) + EPS);
#pragma unroll
            for (int j = 0; j < 8; ++j) v[j] = v[j] * r * (isq ? gq[j] : gk[j]);
            float out[8];
#pragma unroll
            for (int j = 0; j < 8; ++j) { const float other = __shfl_xor(v[j], 4);
                out[j] = !isrope ? v[j] : (second ? other * sn[j] + v[j] * cs[j] : v[j] * cs[j] - other * sn[j]); }
            if (isq) {
#pragma unroll
                for (int j = 0; j < 8; ++j) out[j] *= QSCALE; }
            u32x4 ow; ow.x = cvt_pk_bf16(out[0], out[1]); ow.y = cvt_pk_bf16(out[2], out[3]); ow.z = cvt_pk_bf16(out[4], out[5]); ow.w = cvt_pk_bf16(out[6], out[7]);
            if (act) { if (isq) *(u32x4*)(Q + (size_t)row * QW + h * DQK + 8 * c) = ow; else *(u32x4*)(KF + (size_t)row * QW + h * DQK + 8 * c) = ow; }
        }
    }
}

__device__ __forceinline__ void s7_route(Frame& F) {
    const bf16_t* H1HI = WSP(bf16_t, WS_H1HI); const bf16_t* H1LO = WSP(bf16_t, WS_H1LO); const bf16_t* WHI = WSP(bf16_t, WS_WRT); const bf16_t* WLO = WHI + 96 * DM;
    const float* SSQ2 = WSP(float, WS_SSQ2); float* RSTD2 = WSP(float, WS_SMALL + SM_RSTD2);
    int* ETOK = WSP(int, WS_SMALL + SM_ETOK); int* RANK = WSP(int, WS_SMALL + SM_RANK); float* GTOK = WSP(float, WS_SMALL + SM_GTOK);
    LAS float* red = (LAS float*)F.lds;
    LAS int* cntl = (LAS int*)(F.lds + 4 * 64 * 97 * 4);
    const int lane = F.lane, r32 = lane & 31, hi = lane >> 5, rh = F.wave & 1, kq = F.wave >> 1;
    for (int u = F.vcu; u < NREAL / 64; u += F.G) {
        const int t0 = u * 64;
        if (F.tid < 128) cntl[F.tid] = 0;
        f32x16 acc[3] = {};
        const bf16_t* ah = H1HI + (size_t)(t0 + 32 * rh + r32) * DM + kq * 1024 + 8 * hi; const bf16_t* al = H1LO + (size_t)(t0 + 32 * rh + r32) * DM + kq * 1024 + 8 * hi;
        const bf16_t* bh = WHI + (size_t)r32 * DM + kq * 1024 + 8 * hi; const bf16_t* bl = WLO + (size_t)r32 * DM + kq * 1024 + 8 * hi;
#pragma unroll 2
        for (int ks = 0; ks < 64; ++ks) {
            const bf16x8 a_h = *(const bf16x8*)(ah + 16 * ks), a_l = *(const bf16x8*)(al + 16 * ks);
#pragma unroll
            for (int c = 0; c < 3; ++c) { const bf16x8 b_h = *(const bf16x8*)(bh + (size_t)c * 32 * DM + 16 * ks), b_l = *(const bf16x8*)(bl + (size_t)c * 32 * DM + 16 * ks);
                acc[c] = __builtin_amdgcn_mfma_f32_32x32x16_bf16(a_h, b_h, acc[c], 0, 0, 0);
                acc[c] = __builtin_amdgcn_mfma_f32_32x32x16_bf16(a_l, b_h, acc[c], 0, 0, 0);
                acc[c] = __builtin_amdgcn_mfma_f32_32x32x16_bf16(a_h, b_l, acc[c], 0, 0, 0); }
        }
#pragma unroll
        for (int c = 0; c < 3; ++c)
#pragma unroll
            for (int r = 0; r < 16; ++r) red[(kq * 64 + 32 * rh + att::crow(r, hi)) * 97 + 32 * c + r32] = acc[c][r];
        __syncthreads();
        int e0 = 0, e1 = 0, lr0 = 0, lr1 = 0; float g0 = 0.f, g1 = 0.f;
        if (F.tid < 64) {
            const int tt = F.tid, t = t0 + tt; float sq = 0.f;
            for (int j = 0; j < 64; ++j) sq += SSQ2[(size_t)t * 64 + j];
            const float rs = rsqrtf(sq * (1.f / DM) + EPS); RSTD2[t] = rs;
            LAS float* lg = red + tt * 97;
            for (int j = 0; j < 72; ++j) { const float v = (red[(0 * 64 + tt) * 97 + j] + red[(1 * 64 + tt) * 97 + j]) + (red[(2 * 64 + tt) * 97 + j] + red[(3 * 64 + tt) * 97 + j]);
                lg[j] = v * rs + (j < 8 ? F.in[IN_BGROUP][j] : F.in[IN_BEXP][j - 8]); }
            int gi = 0; float gm = lg[0];
            for (int j = 1; j < 8; ++j) { const float v = lg[j]; if (v > gm) { gm = v; gi = j; } }
            float den = 0.f; for (int j = 0; j < 8; ++j) den += __expf(lg[j] - gm);
            const float gp = 1.f / den;
            const LAS float* el = lg + 8 + gi * 8;
            int i0 = 0; float m0 = el[0];
            for (int j = 1; j < 8; ++j) { const float v = el[j]; if (v > m0) { m0 = v; i0 = j; } }
            int i1 = -1; float m1 = -__builtin_inff();
            for (int j = 0; j < 8; ++j) { const float v = el[j]; if (j != i0 && v > m1) { m1 = v; i1 = j; } }
            const float w1 = 1.f / (1.f + __expf(m0 - m1)), w0 = 1.f - w1;
            e0 = gi * 8 + i0; e1 = gi * 8 + i1; g0 = gp * w0; g1 = gp * w1;
            lr0 = __hip_atomic_fetch_add(cntl + e0, 1, __ATOMIC_RELAXED, __HIP_MEMORY_SCOPE_WORKGROUP); lr1 = __hip_atomic_fetch_add(cntl + e1, 1, __ATOMIC_RELAXED, __HIP_MEMORY_SCOPE_WORKGROUP);
        }
        __syncthreads();
        if (F.tid < 64) { const int n = cntl[F.tid]; cntl[64 + F.tid] = n > 0 ? (int)__hip_atomic_fetch_add(F.ctl + CW_CNT + F.tid, (unsigned)n, RLX_AGENT) : 0; }
        __syncthreads();
        if (F.tid < 64) { const int t = t0 + F.tid;
            ETOK[2 * t] = e0; ETOK[2 * t + 1] = e1; RANK[2 * t] = cntl[64 + e0] + lr0; RANK[2 * t + 1] = cntl[64 + e1] + lr1; GTOK[2 * t] = g0; GTOK[2 * t + 1] = g1; }
        __syncthreads();
    }
}
__device__ __forceinline__ void moe_tables(Frame& F) {
    __syncthreads();
    if (F.tid == 0) { unsigned a = 0;
        for (int e = 0; e < NE; ++e) { F.MISC[64 + e] = a; a += (__hip_atomic_load(F.ctl + CW_CNT + e, RLX_AGENT) + 255u) >> 8; }
        F.MISC[128] = a; }
    __syncthreads();
}
__device__ __forceinline__ void s7c_slots(Frame& F) {
    const int* ETOK = WSP(int, WS_SMALL + SM_ETOK); const int* RANK = WSP(int, WS_SMALL + SM_RANK); const float* GTOK = WSP(float, WS_SMALL + SM_GTOK); int* SLOT = WSP(int, WS_SMALL + SM_SLOT);
    moe_tables(F);
    for (int u = F.vcu; u < NREAL / 64; u += F.G) {
        if (F.tid < 128) { const int i = 2 * (u * 64) + F.tid; const int e = ETOK[i]; const int slot = (int)F.MISC[64 + e] * 256 + RANK[i];
            F.ctl[CW_TOKSLOT + slot] = (unsigned)(i >> 1); ((float*)F.ctl)[CW_GATESLOT + slot] = GTOK[i]; SLOT[i] = slot; }
    }
}
__device__ __forceinline__ void s10_combine(Frame& F) {
    int lane = __builtin_amdgcn_mbcnt_hi(~0u, __builtin_amdgcn_mbcnt_lo(~0u, 0u)); const int gw = F.vcu * NWAVES + F.wave, NGW = F.G * NWAVES;
    const bf16_t* H1HI = WSP(bf16_t, WS_H1HI); const bf16_t* H1LO = WSP(bf16_t, WS_H1LO); const bf16_t* Y = WSP(bf16_t, WS_Y); const int* SLOT = WSP(int, WS_SMALL + SM_SLOT);
    for (int t = gw; t < NREAL; t += NGW) {
        const int s0 = SLOT[2 * t], s1 = SLOT[2 * t + 1];
#pragma unroll 2
        for (int j = 0; j < 8; ++j) { const int col = (j * 64 + lane) * 8;
            const u32x4 a = *(const u32x4*)(H1HI + (size_t)t * DM + col), b = *(const u32x4*)(H1LO + (size_t)t * DM + col), y0 = *(const u32x4*)(Y + (size_t)s0 * DM + col), y1 = *(const u32x4*)(Y + (size_t)s1 * DM + col);
            f32x4 o0, o1;
#pragma unroll
            for (int q = 0; q < 2; ++q) { o0[2 * q] = (bf_lo(a[q]) + bf_lo(b[q])) + bf_lo(y0[q]) + bf_lo(y1[q]); o0[2 * q + 1] = (bf_hi(a[q]) + bf_hi(b[q])) + bf_hi(y0[q]) + bf_hi(y1[q]);
                o1[2 * q] = (bf_lo(a[2 + q]) + bf_lo(b[2 + q])) + bf_lo(y0[2 + q]) + bf_lo(y1[2 + q]); o1[2 * q + 1] = (bf_hi(a[2 + q]) + bf_hi(b[2 + q])) + bf_hi(y0[2 + q]) + bf_hi(y1[2 + q]); }
            *(f32x4*)(F.out + (size_t)t * DM + col) = o0; *(f32x4*)(F.out + (size_t)t * DM + col + 4) = o1; }
    }
}

struct FV { unsigned char* ws; unsigned* ctl; volatile LAS unsigned* MISC; int G, vcu; };
struct SchedS1 {
    static constexpr bool GATHER = false; FV f;
    __device__ __forceinline__ bool next(int i, pg8::GUnit& u) const {
        const int L = i * f.G + (int)blockIdx.x; if (L >= 65 * 11) return false;
        int pm, pn; pg8::tile_of(L, 65, 11, pm, pn);
        u.A = (const char*)(f.ws + WS_XB) + (size_t)pm * 256 * DM * 2; u.lda = DM * 2; u.B = (const char*)(f.ws + WS_WIN) + (size_t)pn * 256 * DM * 2; u.ldb = DM * 2; u.nk = DM / 64; u.gather = nullptr;
        u.C = (char*)(f.ws + WS_PROJ) + ((size_t)pm * 256 * INCP + pn * 256) * 2; u.ldc = INCP * 2; u.rs = (const float*)(f.ws + WS_SMALL + SM_RSTD1) + pm * 256; u.i0 = 0; u.i1 = 0; return true; }
};
struct SchedS3 {
    static constexpr bool GATHER = false; FV f;
    __device__ __forceinline__ bool next(int i, pg8::GUnit& u) const {
        int L = i * f.G + (int)blockIdx.x; int pm, pn; u.gather = nullptr; u.i0 = 0; u.i1 = 0;
        if (L < 64 * 18) { pg8::tile_of(L, 64, 18, pm, pn); const int b = pm >> 5, r0 = b * LSEQ + NMETA + (pm & 31) * 256;
            u.A = (const char*)(f.ws + WS_PROJ) + ((size_t)r0 * INCP + POOLW) * 2; u.lda = INCP * 2; u.B = (const char*)(f.ws + WS_WUQ) + (size_t)pn * 256 * QLR * 2; u.ldb = QLR * 2; u.nk = QLR / 64;
            u.C = (char*)(f.ws + WS_Q) + ((size_t)pm * 256 * QW + pn * 256) * 2; u.ldc = QW * 2; u.rs = (const float*)(f.ws + WS_SMALL + SM_RSTDQ) + r0; return true; }
        L -= 64 * 18;
        if (L < 65 * 24) { pg8::tile_of(L, 65, 24, pm, pn);
            u.A = (const char*)(f.ws + WS_PROJ) + ((size_t)pm * 256 * INCP + POOLW + QLR) * 2; u.lda = INCP * 2; u.B = (const char*)(f.ws + WS_WUKV) + (size_t)pn * 256 * KVLR * 2; u.ldb = KVLR * 2; u.nk = KVLR / 64;
            u.C = (char*)(f.ws + WS_KV) + ((size_t)pm * 256 * KVW + pn * 256) * 2; u.ldc = KVW * 2; u.rs = (const float*)(f.ws + WS_SMALL + SM_RSTDKV) + pm * 256; return true; }
        L -= 65 * 24;
        if (L < 65 * 4) { pm = L >> 2; pn = L & 3;
            u.A = (const char*)(f.ws + WS_DIFF) + ((size_t)pm * 256 * POOLW + pn * 256) * 2; u.lda = POOLW * 2; u.B = (const char*)(f.ws + WS_WP) + (size_t)pn * 65536 * 2; u.ldb = 256 * 2; u.nk = 4;
            u.C = (char*)(f.ws + WS_MIX) + ((size_t)pm * 256 * DM + pn * 256) * 2; u.ldc = DM * 2; u.rs = nullptr; return true; }
        return false; }
};
struct SchedS6 {
    static constexpr bool GATHER = false; FV f;
    __device__ __forceinline__ bool next(int i, pg8::GUnit& u) const {
        const int L = i * f.G + (int)blockIdx.x; if (L >= 64 * 16) return false;
        int pm, pn; pg8::tile_of(L, 64, 16, pm, pn); const int b = pm >> 5, r0 = b * LSEQ + NMETA + (pm & 31) * 256;
        u.A = (const char*)(f.ws + WS_MIX) + (size_t)r0 * DM * 2; u.lda = DM * 2; u.B = (const char*)(f.ws + WS_WO) + (size_t)pn * 256 * DM * 2; u.ldb = DM * 2; u.nk = DM / 64; u.gather = nullptr;
        u.C = nullptr; u.ldc = 0; u.rs = nullptr; u.i0 = pm * 256; u.i1 = pn; return true; }
};
__device__ __forceinline__ int expert_of_tile(const FV& f, int g) {
    int e = 0;
#pragma unroll
    for (int s = 32; s > 0; s >>= 1) { const int c = e + s; if ((int)f.MISC[64 + c] <= g) e = c; }
    return e;
}
struct SchedS8 {
    static constexpr bool GATHER = true; FV f;
    __device__ __forceinline__ bool next(int i, pg8::GUnit& u) const {
        const int L = i * f.G + f.vcu; const int nrt = (int)f.MISC[128]; if (L >= nrt * 4) return false;
        const int g = L >> 2, ct = L & 3, e = expert_of_tile(f, g);
        u.A = (const char*)(f.ws + WS_H1HI); u.lda = DM * 2; u.gather = (const int*)(f.ctl + CW_TOKSLOT) + g * 256;
        u.B = (const char*)(f.ws + WS_WGU) + ((size_t)e * 1024 + ct * 256) * DM * 2; u.ldb = DM * 2; u.nk = DM / 64;
        u.C = (char*)(f.ws + WS_HID) + ((size_t)g * 256 * DE + ct * 128) * 2; u.ldc = DE * 2; u.rs = nullptr; u.i0 = 0; u.i1 = 0; return true; }
};
struct SchedS9 {
    static constexpr bool GATHER = false; FV f;
    __device__ __forceinline__ bool next(int i, pg8::GUnit& u) const {
        const int L = i * f.G + f.vcu; const int nrt = (int)f.MISC[128]; if (L >= nrt * 16) return false;
        const int g = L >> 4, ct = L & 15, e = expert_of_tile(f, g);
        u.A = (const char*)(f.ws + WS_HID) + (size_t)g * 256 * DE * 2; u.lda = DE * 2; u.gather = nullptr;
        u.B = (const char*)(f.ws + WS_WD) + ((size_t)e * DM + ct * 256) * DE * 2; u.ldb = DE * 2; u.nk = DE / 64;
        u.C = (char*)(f.ws + WS_Y) + ((size_t)g * 256 * DM + ct * 256) * 2; u.ldc = DM * 2; u.rs = (const float*)(f.ctl + CW_GATESLOT) + g * 256; u.i0 = 0; u.i1 = 0; return true; }
};

struct Args { const float* in[21]; float* out; unsigned char* ws; int ph_lo, ph_hi, li, pad; };
constexpr int N_PHASES = 12;
__global__ void __launch_bounds__(NWAVES * 64, 2) mk_fwd(Args args) {
    extern __shared__ __attribute__((aligned(16))) unsigned char lds_raw[];
    Frame F;
    F.lds = (LAS unsigned char*)lds_raw;
    F.MISC = (volatile LAS unsigned*)(F.lds + MISC_OFF);
    F.tid = threadIdx.x; F.lane = F.tid & 63; F.wave = __builtin_amdgcn_readfirstlane(F.tid >> 6);
    F.G = gridDim.x; { const int bx = blockIdx.x; F.vcu = (F.G % 8 == 0) ? (bx % 8) * (F.G / 8) + bx / 8 : bx; }
    F.ws = args.ws; F.ctl = (unsigned*)(args.ws + WS_CTL); F.out = args.out;
#pragma unroll
    for (int i = 0; i < 21; ++i) F.in[i] = args.in[i];
    for (int u = F.tid; u < 512; u += NWAVES * 64) ((LAS unsigned*)(F.lds + MISC_OFF))[u] = 0u;
    __syncthreads();
    XcdBarrier bar = xcd_barrier_post((unsigned*)(F.ctl + CW_BAR) + args.li * XCD_BAR_WORDS, F.MISC + 8);
    const int lo = args.ph_lo, hi = args.ph_hi;
    const FV fv{F.ws, F.ctl, F.MISC, F.G, F.vcu};
#ifdef ONLY_PHASE
#define IN(k) ((k) == ONLY_PHASE)
#else
#define IN(k) (lo <= (k) && (k) < hi)
#endif
#define SEAM(k) do { if (IN(k) && IN((k) + 1)) xcd_barrier(bar); } while (0)
    if (IN(0)) { p0_prologue(F); } SEAM(0);
    if (IN(1)) { SchedS1 S{fv}; pg8::EpiScaleBf16 E; pg8::gemm_phase(F.lds, S, E); } SEAM(1);
    if (IN(2)) { s2_phase(F); } SEAM(2);
    if (IN(3)) { SchedS3 S{fv}; pg8::EpiScaleBf16 E; pg8::gemm_phase(F.lds, S, E); } SEAM(3);
    if (IN(4)) { s4_phase(F); } SEAM(4);
    if (IN(5)) {
        const bf16_t* Q = WSP(bf16_t, WS_Q); const bf16_t* KF = WSP(bf16_t, WS_KF); const bf16_t* KV = WSP(bf16_t, WS_KV); bf16_t* MIX = WSP(bf16_t, WS_MIX);
        for (int it = F.vcu; it < 768; it += F.G) { const int bh = it >> 4, s = it & 15;
            att::attn_unit(bh / NH, bh % NH, 31 - s, Q, KF, KV, MIX, (LAS char*)F.lds);
            att::attn_unit(bh / NH, bh % NH, s, Q, KF, KV, MIX, (LAS char*)F.lds); }
    } SEAM(5);
    if (IN(6)) { SchedS6 S{fv}; pg8::EpiWout E{F.in[IN_X], WSP(bf16_t, WS_H1HI), WSP(bf16_t, WS_H1LO), WSP(float, WS_SSQ2)}; pg8::gemm_phase(F.lds, S, E); } SEAM(6);
    if (IN(7)) { s7_route(F); } SEAM(7);
    if (IN(8)) { s7c_slots(F); } SEAM(8);
    if (IN(9)) { moe_tables(F); SchedS8 S{fv}; pg8::EpiMoe1 E{WSP(float, WS_SMALL + SM_RSTD2)}; pg8::gemm_phase(F.lds, S, E); } SEAM(9);
    if (IN(10)) { moe_tables(F); SchedS9 S{fv}; pg8::EpiScaleBf16 E; pg8::gemm_phase(F.lds, S, E); } SEAM(10);
    if (IN(11)) { s10_combine(F); }
#undef IN
#undef SEAM
}

extern "C" void kernel_launch(void* const* d_in, const int* in_sizes, int n_in, void* d_out, int out_size, void* d_ws, size_t ws_size, hipStream_t stream) {
    static int grid = 0;
    if (grid == 0) {
        if (n_in != 21 || out_size != NREAL * DM || ws_size < WS_END) { fprintf(stderr, "kernel_launch: unexpected shapes (n_in %d out %d ws %zu)\n", n_in, out_size, ws_size); grid = -1; return; }
        int dev = 0, cus = 0, per_cu = 0;
        if (hipGetDevice(&dev) != hipSuccess || hipDeviceGetAttribute(&cus, hipDeviceAttributeMultiprocessorCount, dev) != hipSuccess) { grid = -1; return; }
        if (hipFuncSetAttribute((const void*)mk_fwd, hipFuncAttributeMaxDynamicSharedMemorySize, LDS_BYTES) != hipSuccess) { fprintf(stderr, "kernel_launch: hipFuncSetAttribute failed\n"); grid = -1; return; }
        if (hipOccupancyMaxActiveBlocksPerMultiprocessor(&per_cu, (const void*)mk_fwd, NWAVES * 64, LDS_BYTES) != hipSuccess || per_cu < 1) fprintf(stderr, "kernel_launch: occupancy query says %d\n", per_cu);
        (void)hipGetLastError();
        grid = cus;
    }
    if (grid < 0) return;
    (void)hipMemsetAsync((char*)d_ws + WS_CTL, 0, CTL_ZERO_BYTES, stream);
    Args a{};
    for (int i = 0; i < 21; ++i) a.in[i] = (const float*)d_in[i];
    a.out = (float*)d_out; a.ws = (unsigned char*)d_ws; a.ph_lo = 0; a.ph_hi = N_PHASES; a.li = 0; a.pad = 0;
    hipLaunchKernelGGL(mk_fwd, dim3(grid), dim3(NWAVES * 64), LDS_BYTES, stream, a);
}
```

```cpp
#include <hip/hip_runtime.h>
#include <hip/hip_bf16.h>
#include <cstdio>
#include <cstdint>

#define LAS __attribute__((address_space(3)))
#define GAS __attribute__((address_space(1)))
typedef unsigned short bf16_t;
typedef short bf16x8 __attribute__((ext_vector_type(8)));
typedef short s16x4 __attribute__((ext_vector_type(4)));
typedef float f32x4 __attribute__((ext_vector_type(4)));
typedef float f32x2 __attribute__((ext_vector_type(2)));
typedef float f32x16 __attribute__((ext_vector_type(16)));
typedef unsigned u32x4 __attribute__((ext_vector_type(4)));
typedef unsigned u32x2 __attribute__((ext_vector_type(2)));

constexpr int DM = 4096, NB = 2, SEQ = 8192, NMETA = 16, LSEQ = SEQ + NMETA  , NTOK = NB * LSEQ  , NREAL = NB * SEQ  ;
constexpr int MPAD = 16640;
constexpr int POOLW = 1024, QLR = 1024, KVLR = 512, ROPE = 64, INC = 2624, INCP = 2816;
constexpr int NH = 24, DQK = 192, DNOPE = 128, DV = 128, QW = NH * DQK  , KVW = NH * 256  ;
constexpr int NG = 8, NE = 64, DE = 512;
constexpr int NSLOT = 49152;
constexpr float EPS = 1e-6f;
constexpr float QSCALE = 0.07216878364870322f * 1.4426950408889634f;

constexpr size_t MiB = 1u << 20;
constexpr size_t WS_CTL = 0, CTL_ZERO_BYTES = 1 * MiB;
constexpr size_t WS_WIN = 1 * MiB;
constexpr size_t WS_WUQ = 23 * MiB;
constexpr size_t WS_WUKV = 32 * MiB;
constexpr size_t WS_WP = 38 * MiB;
constexpr size_t WS_WRT = 38 * MiB + 512 * 1024;
constexpr size_t WS_WO = 40 * MiB;
constexpr size_t WS_WGU = 72 * MiB;
constexpr size_t WS_WD = 584 * MiB;
constexpr size_t WS_ROPE = 840 * MiB;
constexpr size_t WS_SMALL = 843 * MiB;
constexpr size_t WS_XB = 846 * MiB;
constexpr size_t WS_PROJ = 976 * MiB;
constexpr size_t WS_DIFF = 1066 * MiB;
constexpr size_t WS_Q = 1099 * MiB;
constexpr size_t WS_KV = 1243 * MiB;
constexpr size_t WS_KF = 1438 * MiB;
constexpr size_t WS_MIX = 1585 * MiB;
constexpr size_t WS_VB = 1715 * MiB;
constexpr size_t WS_KR = 1813 * MiB;
constexpr size_t WS_END = 1818 * MiB;
constexpr size_t WS_H1HI = 846 * MiB;
constexpr size_t WS_H1LO = 974 * MiB;
constexpr size_t WS_SSQ2 = 1102 * MiB;
constexpr size_t WS_HID = 1106 * MiB;
constexpr size_t WS_Y = 1154 * MiB;
constexpr size_t SM_RSTD1 = 0, SM_RSTDQ = 128 * 1024, SM_RSTDKV = 256 * 1024, SM_RSTD2 = 384 * 1024, SM_ETOK = 512 * 1024, SM_RANK = 640 * 1024, SM_GTOK = 768 * 1024, SM_SLOT = 896 * 1024, SM_SSQPE = 1024 * 1024;
constexpr int CW_TMO = 0, CW_BAR = 4096, CW_CNT = 8192, CW_TOKSLOT = 16384, CW_GATESLOT = 65536;
static_assert((CW_GATESLOT + NSLOT) * 4 <= (int)CTL_ZERO_BYTES, "CTL");

constexpr int RING_BYTES = 131072;
constexpr int PTAB_OFF = 133120;
constexpr int CONV_OFF = 108544;
constexpr int MISC_OFF = 157696;
constexpr int LDS_BYTES = 159744;

#define RLX_AGENT __ATOMIC_RELAXED, __HIP_MEMORY_SCOPE_AGENT
#define LDS_WAIT() asm volatile("s_waitcnt lgkmcnt(0)" ::: "memory")
#define VM_WAIT() asm volatile("s_waitcnt vmcnt(0)" ::: "memory")

__device__ __forceinline__ unsigned cvt_pk_bf16(float lo, float hi) { unsigned r; asm volatile("v_cvt_pk_bf16_f32 %0, %1, %2" : "=v"(r) : "v"(lo), "v"(hi)); return r; }
__device__ __forceinline__ float bf_lo(unsigned w) { return __uint_as_float(w << 16); }
__device__ __forceinline__ float bf_hi(unsigned w) { return __uint_as_float(w & 0xffff0000u); }
__device__ __forceinline__ float wave_sum(float v) {
#pragma unroll
    for (int o = 1; o < 64; o <<= 1) v += __shfl_xor(v, o);
    return v;
}

#define XB_TMO      128
#define XB_XCNT(j)  (256  + 64 * (j))
#define XB_XSUB(j)  (1280 + 64 * (j))
#define XB_XGEN(j)  (2304 + 64 * (j))
#define XB_TOP      3328
#define XB_TOPGEN   3392
#define XCD_BAR_WORDS 3456
#define XB_SPIN_CAP (1u << 18)
__device__ __forceinline__ unsigned xb_ld(unsigned* p)              { return __hip_atomic_load(p, __ATOMIC_RELAXED, __HIP_MEMORY_SCOPE_AGENT); }
__device__ __forceinline__ unsigned xb_add(unsigned* p, unsigned v) { return __hip_atomic_fetch_add(p, v, __ATOMIC_RELAXED, __HIP_MEMORY_SCOPE_AGENT); }
__device__ __forceinline__ unsigned xb_xcc_id() { return (unsigned)__builtin_amdgcn_s_getreg((3 << 11) | 20) & 0xFu; }
#define XB_SPIN(cond, bar) do { unsigned _sp = 0; while (cond) { __builtin_amdgcn_s_sleep(1); \
    if ((++_sp & 255u) == 0u) { if (xb_ld(&(bar)[XB_TMO])) break; if (_sp > XB_SPIN_CAP) { atomicAdd(&(bar)[XB_TMO], 1u); break; } } } } while (0)
struct XcdBarrier { unsigned* bar; unsigned x; volatile LAS unsigned* st; };
__device__ __forceinline__ XcdBarrier xcd_barrier_post(unsigned* bar, volatile LAS unsigned* st) {
    XcdBarrier b; b.bar = bar; b.x = xb_xcc_id(); b.st = st;
    if (threadIdx.x == 0) (void)xb_add(&bar[XB_XCNT(b.x)], 1u);
    return b;
}
__device__ __forceinline__ void xcd_barrier_complete(unsigned* bar, unsigned x, unsigned& nloc, unsigned& nx) {
    const unsigned G = gridDim.x * gridDim.y * gridDim.z;
    unsigned sum, cnt, mine, sp = 0u;
    for (;;) {
        sum = 0u; cnt = 0u; mine = 0u;
#pragma unroll
        for (unsigned j = 0; j < 16; ++j) { const unsigned c = xb_ld(&bar[XB_XCNT(j)]); sum += c; cnt += (c > 0u) ? 1u : 0u; mine = (j == x) ? c : mine; }
        if (sum == G) break;
        __builtin_amdgcn_s_sleep(1);
        if ((++sp & 255u) == 0u) { if (xb_ld(&bar[XB_TMO])) break; if (sp > XB_SPIN_CAP) { atomicAdd(&bar[XB_TMO], 1u); break; } }
    }
    nloc = mine > 0u ? mine : 1u; nx = cnt > 0u ? cnt : 1u;
}
__device__ __forceinline__ void xcd_barrier(const XcdBarrier& b) {
    asm volatile("s_waitcnt vmcnt(0)" ::: "memory");
    __syncthreads();
    if (threadIdx.x == 0) {
        unsigned* bar = b.bar;
        __builtin_amdgcn_s_waitcnt(0);
        unsigned nloc = b.st[0], nx = b.st[1];
        if (nloc == 0u) { xcd_barrier_complete(bar, b.x, nloc, nx); b.st[0] = nloc; b.st[1] = nx; }
        const unsigned old = xb_add(&bar[XB_XSUB(b.x)], 1u);
        const unsigned gen = old / nloc;
        if (old + 1u == (gen + 1u) * nloc) {
            __builtin_amdgcn_fence(__ATOMIC_RELEASE, "agent");
            asm volatile("s_waitcnt vmcnt(0)" ::: "memory");
            const unsigned og = xb_add(&bar[XB_TOP], 1u);
            const unsigned tg = og / nx;
            if (og + 1u == (tg + 1u) * nx) xb_add(&bar[XB_TOPGEN], 1u);
            else XB_SPIN(xb_ld(&bar[XB_TOPGEN]) == tg, bar);
            __builtin_amdgcn_fence(__ATOMIC_ACQUIRE, "agent");
            xb_add(&bar[XB_XGEN(b.x)], 1u);
            asm volatile("s_waitcnt vmcnt(0)" ::: "memory");
        } else {
            XB_SPIN(xb_ld(&bar[XB_XGEN(b.x)]) == gen, bar);
            __builtin_amdgcn_fence(__ATOMIC_ACQUIRE, "agent");
            asm volatile("s_waitcnt vmcnt(0)" ::: "memory");
        }
    }
    __syncthreads();
}

namespace pg8 {
constexpr int BM = 256, BK = 64, HALF = 128, HTB = HALF * BK * 2, STAGE_BYTES = 8 * HTB, NXCD = 8, WGM = 8;
__host__ __device__ __forceinline__ int lds_byte(int r, int c) { const int st = (r >> 4) * 2 + (c >> 5), rr = r & 15, cc = c & 31, ob = rr * 64 + cc * 2; return st * 1024 + (ob ^ (((ob >> 9) & 1) << 5)); }
__host__ __device__ __forceinline__ void stage_rc(int b, int& R, int& C) { const int st = b / 1024, sb = b % 1024, swz = sb ^ (((sb >> 9) & 1) << 5); R = (st >> 1) * 16 + swz / 64; C = (st & 1) * 32 + (swz % 64) / 2; }
__host__ __device__ __forceinline__ int perm32(int rho) { const int n = rho >> 4, i = rho & 15; return 8 * (i >> 2) + 4 * n + (i & 3); }

__device__ __forceinline__ void tile_of(int L, int nM, int nN, int& pm, int& pn) {
    const int nwg = nM * nN; int wgid = L;
    { const int q = nwg / NXCD, r = nwg % NXCD, xcd = wgid % NXCD, off = wgid / NXCD; wgid = (xcd < r ? xcd * (q + 1) : r * (q + 1) + (xcd - r) * q) + off; }
    const int nig = WGM * nN, gid = wgid / nig, fm = gid * WGM, gsz = (nM - fm) < WGM ? (nM - fm) : WGM;
    pm = fm + ((wgid % nig) % gsz); pn = (wgid % nig) / gsz;
}

struct GUnit {
    const char* A;
    const char* B;
    unsigned lda, ldb;
    int nk;
    const int* gather;
    char* C; unsigned ldc;
    const float* rs;
    int i0, i1;
};

struct EpiScaleBf16 {
    static constexpr bool PERM = true, BMAP = false;
    __device__ __forceinline__ void operator()(const f32x4 (&acc)[2][2][4][2], const GUnit& u, int wr, int wc, int fr, int fq) const {
#pragma unroll
        for (int ai = 0; ai < 2; ++ai)
#pragma unroll
            for (int m = 0; m < 4; ++m) { const int r = ai * HALF + wr * 64 + m * 16 + fr; const float s = u.rs ? u.rs[r] : 1.f;
                char* rowp = u.C + (size_t)r * u.ldc + (wc * 32 + 8 * fq) * 2;
#pragma unroll
                for (int bj = 0; bj < 2; ++bj) { const f32x4 v0 = acc[ai][bj][m][0] * s, v1 = acc[ai][bj][m][1] * s;
                    u32x4 w; w.x = cvt_pk_bf16(v0[0], v0[1]); w.y = cvt_pk_bf16(v0[2], v0[3]); w.z = cvt_pk_bf16(v1[0], v1[1]); w.w = cvt_pk_bf16(v1[2], v1[3]);
                    *(u32x4*)(rowp + bj * HALF * 2) = w; } }
    }
};
struct EpiScaleBf16L {
    static constexpr bool PERM = true, BMAP = true;
    __device__ __forceinline__ void operator()(const f32x4 (&acc)[2][2][4][2], const GUnit& u, int wr, int wc, int fr, int fq) const {
#pragma unroll
        for (int ai = 0; ai < 2; ++ai)
#pragma unroll
            for (int m = 0; m < 4; ++m) { const int r = ai * HALF + wr * 64 + m * 16 + fr;
                char* rowp = u.C + (size_t)r * u.ldc + (wc * 64 + 8 * fq) * 2;
#pragma unroll
                for (int bj = 0; bj < 2; ++bj) { const f32x4 v0 = acc[ai][bj][m][0], v1 = acc[ai][bj][m][1];
                    u32x4 w; w.x = cvt_pk_bf16(v0[0], v0[1]); w.y = cvt_pk_bf16(v0[2], v0[3]); w.z = cvt_pk_bf16(v1[0], v1[1]); w.w = cvt_pk_bf16(v1[2], v1[3]);
                    *(u32x4*)(rowp + bj * 64) = w; } }
    }
};
struct EpiS3 {
    static constexpr bool PERM = true, BMAP = false;
    const float* rstdkv; const float* ssqpe; const float* kr; const float* gk; bf16_t* KF; bf16_t* VB; LAS float* P;
    __device__ __forceinline__ void operator()(const f32x4 (&acc)[2][2][4][2], const GUnit& u, int wr, int wc, int fr, int fq) const {
        if ((u.i1 >> 8) == 0) { EpiScaleBf16 e; e(acc, u, wr, wc, fr, fq); return; }
        const int h = u.i1 & 255; const size_t row0 = (size_t)u.i0;
#pragma unroll
        for (int ai = 0; ai < 2; ++ai)
#pragma unroll
            for (int m = 0; m < 4; ++m) { const int r = ai * HALF + wr * 64 + m * 16 + fr; float s = 0.f;
#pragma unroll
                for (int n = 0; n < 2; ++n) { const f32x4 v = acc[ai][0][m][n]; s += (v[0] * v[0] + v[1] * v[1]) + (v[2] * v[2] + v[3] * v[3]); }
                s += __shfl_xor(s, 16); s += __shfl_xor(s, 32);
                if (fq == 0) P[r * 4 + wc] = s; }
        asm volatile("s_waitcnt lgkmcnt(0)" ::: "memory"); __builtin_amdgcn_s_barrier(); asm volatile("" ::: "memory");
        const int c0 = wc * 32 + 8 * fq;
        const f32x4 g0 = *(const f32x4*)(gk + c0), g1 = *(const f32x4*)(gk + c0 + 4);
        float sp8[8];
#pragma unroll
        for (int g = 0; g < 8; ++g) sp8[g] = ssqpe[row0 + (g >> 2) * HALF + wr * 64 + (g & 3) * 16 + fr];
        const int tid2 = (wr * 4 + wc) * 64 + fq * 16 + fr, rr2 = tid2 >> 1, hf2 = tid2 & 1;
        const float spr = ssqpe[row0 + rr2]; f32x4 krv[8];
        { const float* src = kr + (row0 + rr2) * 64 + 32 * hf2;
#pragma unroll
          for (int q = 0; q < 8; ++q) krv[q] = *(const f32x4*)(src + 4 * q); }
#pragma unroll
        for (int ai = 0; ai < 2; ++ai)
#pragma unroll
            for (int m = 0; m < 4; ++m) { const int r = ai * HALF + wr * 64 + m * 16 + fr; const float rs = 1.f;
                const f32x4 pp = *(const LAS f32x4*)(P + r * 4);
                const float rh = rsqrtf((((pp[0] + pp[1]) + (pp[2] + pp[3])) * rs * rs + sp8[ai * 4 + m]) * (1.f / DQK) + EPS);
                const float a = rs * rh; const f32x4 k0 = acc[ai][0][m][0] * a * g0, k1 = acc[ai][0][m][1] * a * g1, v0 = acc[ai][1][m][0] * rs, v1 = acc[ai][1][m][1] * rs;
                u32x4 w; w.x = cvt_pk_bf16(k0[0], k0[1]); w.y = cvt_pk_bf16(k0[2], k0[3]); w.z = cvt_pk_bf16(k1[0], k1[1]); w.w = cvt_pk_bf16(k1[2], k1[3]);
                *(u32x4*)(KF + (row0 + r) * QW + h * DQK + c0) = w;
                w.x = cvt_pk_bf16(v0[0], v0[1]); w.y = cvt_pk_bf16(v0[2], v0[3]); w.z = cvt_pk_bf16(v1[0], v1[1]); w.w = cvt_pk_bf16(v1[2], v1[3]);
                *(u32x4*)(VB + (row0 + r) * (NH * DV) + h * DV + c0) = w; }
        { const f32x4 pp = *(const LAS f32x4*)(P + rr2 * 4);
          const float rh = rsqrtf((((pp[0] + pp[1]) + (pp[2] + pp[3])) + spr) * (1.f / DQK) + EPS);
          bf16_t* dst = KF + (row0 + rr2) * QW + h * DQK + DNOPE + 32 * hf2;
#pragma unroll
          for (int q = 0; q < 4; ++q) { const f32x4 a = krv[2 * q] * rh, b = krv[2 * q + 1] * rh;
              u32x4 w; w.x = cvt_pk_bf16(a[0], a[1]); w.y = cvt_pk_bf16(a[2], a[3]); w.z = cvt_pk_bf16(b[0], b[1]); w.w = cvt_pk_bf16(b[2], b[3]);
              *(u32x4*)(dst + 8 * q) = w; } }
    }
};
struct EpiNone { static constexpr bool PERM = true, BMAP = false; __device__ __forceinline__ void operator()(const f32x4 (&acc)[2][2][4][2], const GUnit& u, int wr, int wc, int fr, int fq) const { float x = acc[0][0][0][0][0] + acc[1][1][3][1][3]; asm volatile("" :: "v"(x)); } };
struct EpiProbeA {
    static constexpr bool PERM = true, BMAP = true; char* scr;
    __device__ __forceinline__ void operator()(const f32x4 (&acc)[2][2][4][2], const GUnit& u, int wr, int wc, int fr, int fq) const {
        GUnit v = u; v.C = scr + (size_t)blockIdx.x * 131072; v.ldc = 512; EpiScaleBf16L e; e(acc, v, wr, wc, fr, fq); }
};
struct EpiWout {
    static constexpr bool PERM = true, BMAP = false;
    const float* x; bf16_t* hi; bf16_t* lo; float* ssq;
    __device__ __forceinline__ void operator()(const f32x4 (&acc)[2][2][4][2], const GUnit& u, int wr, int wc, int fr, int fq) const {
        const int c0 = u.i1 * BM + wc * 32 + 8 * fq;
        const size_t rbase = (size_t)u.i0 + wr * 64 + fr;
        f32x4 xa[4], xb[4];
#define EW_LOAD(X_, g_) do { const size_t off_ = (rbase + ((g_) >> 2) * HALF + ((g_) & 3) * 16) * DM + c0; \
            X_[0] = *(const f32x4*)(x + off_); X_[1] = *(const f32x4*)(x + off_ + 4); X_[2] = *(const f32x4*)(x + off_ + HALF); X_[3] = *(const f32x4*)(x + off_ + HALF + 4); } while (0)
#define EW_PROC(X_, g_) do { const int ai_ = (g_) >> 2, m_ = (g_) & 3; const size_t row_ = rbase + ai_ * HALF + m_ * 16; float sq = 0.f; \
            _Pragma("unroll") for (int bj = 0; bj < 2; ++bj) { const size_t off = row_ * DM + c0 + bj * HALF; \
                const f32x4 v0 = acc[ai_][bj][m_][0] + X_[2 * bj], v1 = acc[ai_][bj][m_][1] + X_[2 * bj + 1]; \
                sq += (v0[0] * v0[0] + v0[1] * v0[1]) + (v0[2] * v0[2] + v0[3] * v0[3]) + (v1[0] * v1[0] + v1[1] * v1[1]) + (v1[2] * v1[2] + v1[3] * v1[3]); \
                u32x4 w; w.x = cvt_pk_bf16(v0[0], v0[1]); w.y = cvt_pk_bf16(v0[2], v0[3]); w.z = cvt_pk_bf16(v1[0], v1[1]); w.w = cvt_pk_bf16(v1[2], v1[3]); \
                *(u32x4*)(hi + off) = w; \
                u32x4 l; l.x = cvt_pk_bf16(v0[0] - bf_lo(w.x), v0[1] - bf_hi(w.x)); l.y = cvt_pk_bf16(v0[2] - bf_lo(w.y), v0[3] - bf_hi(w.y)); \
                l.z = cvt_pk_bf16(v1[0] - bf_lo(w.z), v1[1] - bf_hi(w.z)); l.w = cvt_pk_bf16(v1[2] - bf_lo(w.w), v1[3] - bf_hi(w.w)); \
                *(u32x4*)(lo + off) = l; } \
            sq += __shfl_xor(sq, 16); sq += __shfl_xor(sq, 32); \
            if (fq == 0) ssq[row_ * 64 + u.i1 * 4 + wc] = sq; } while (0)
        EW_LOAD(xa, 0); EW_LOAD(xb, 1);
        EW_PROC(xa, 0); EW_LOAD(xa, 2); EW_PROC(xb, 1); EW_LOAD(xb, 3);
        EW_PROC(xa, 2); EW_LOAD(xa, 4); EW_PROC(xb, 3); EW_LOAD(xb, 5);
        EW_PROC(xa, 4); EW_LOAD(xa, 6); EW_PROC(xb, 5); EW_LOAD(xb, 7);
        EW_PROC(xa, 6); EW_PROC(xb, 7);
#undef EW_LOAD
#undef EW_PROC
    }
};
struct EpiMoe1 {
    static constexpr bool PERM = true, BMAP = false;
    const float* rstd2; const float* gate;
    __device__ __forceinline__ void operator()(const f32x4 (&acc)[2][2][4][2], const GUnit& u, int wr, int wc, int fr, int fq) const {
        float sc[8], gt[8];
#pragma unroll
        for (int g = 0; g < 8; ++g) { const int r = (g >> 2) * HALF + wr * 64 + (g & 3) * 16 + fr; sc[g] = __int_as_float(u.gather[r]); gt[g] = gate[u.i0 + r]; }
#pragma unroll
        for (int g = 0; g < 8; ++g) sc[g] = rstd2[__float_as_int(sc[g])];
#pragma unroll
        for (int ai = 0; ai < 2; ++ai)
#pragma unroll
            for (int m = 0; m < 4; ++m) { const int r = ai * HALF + wr * 64 + m * 16 + fr; const float s = sc[ai * 4 + m], gg = gt[ai * 4 + m];
                float h[8];
#pragma unroll
                for (int n = 0; n < 2; ++n)
#pragma unroll
                    for (int j = 0; j < 4; ++j) { const float g = acc[ai][0][m][n][j] * s, up = acc[ai][1][m][n][j] * s;
                        h[n * 4 + j] = g * __builtin_amdgcn_rcpf(1.f + __builtin_amdgcn_exp2f(-1.4426950408889634f * g)) * up * gg; }
                u32x4 w; w.x = cvt_pk_bf16(h[0], h[1]); w.y = cvt_pk_bf16(h[2], h[3]); w.z = cvt_pk_bf16(h[4], h[5]); w.w = cvt_pk_bf16(h[6], h[7]);
                *(u32x4*)(u.C + (size_t)r * u.ldc + (wc * 32 + 8 * fq) * 2) = w; }
    }
};

template <class Epi, class Sched>
__device__ __forceinline__ void gemm_phase(LAS unsigned char* lds, const Sched& S, const Epi& E) {
    const int tid = threadIdx.x, wid = __builtin_amdgcn_readfirstlane(tid >> 6), lane = tid & 63, wr = wid >> 2, wc = wid & 3, fr = lane & 15, fq = lane >> 4;
    const unsigned ldsw = (unsigned)wid * 1024u;
    const int aoff = lds_byte(wr * 64 + fr, fq * 8), boff = lds_byte(wc * 32 + fr, fq * 8);
#define PG8_SA(b, h) (((b) * 2 + (h)) * HTB)
#define PG8_SB(b, h) ((4 + (b) * 2 + (h)) * HTB)
#define PG8_STAGE(bufoff, gbase, voff) do { _Pragma("unroll") for (int _i = 0; _i < 2; ++_i) \
        __builtin_amdgcn_global_load_lds((const unsigned*)((const char*)(gbase) + (voff)[_i]), (LAS unsigned*)(lds + (bufoff) + ldsw + _i * 8192), 16, 0, 0); } while (0)
#define PG8_LDA(dst, b, h) do { _Pragma("unroll") for (int m = 0; m < 4; ++m) _Pragma("unroll") for (int k = 0; k < 2; ++k) dst[m][k] = *(const LAS bf16x8*)(lds + PG8_SA(b, h) + aoff + m * 2048 + k * 1024); } while (0)
#define PG8_LDB(dst, b, h) do { _Pragma("unroll") for (int n = 0; n < 2; ++n) _Pragma("unroll") for (int k = 0; k < 2; ++k) dst[n][k] = *(const LAS bf16x8*)(lds + PG8_SB(b, h) + boff + n * 2048 + k * 1024); } while (0)
#define PG8_MMA(ai, bj, At, Bt) do { __builtin_amdgcn_s_setprio(1); _Pragma("unroll") for (int m = 0; m < 4; ++m) _Pragma("unroll") for (int n = 0; n < 2; ++n) _Pragma("unroll") for (int k = 0; k < 2; ++k) \
        acc[ai][bj][m][n] = __builtin_amdgcn_mfma_f32_16x16x32_bf16(Bt[n][k], At[m][k], acc[ai][bj][m][n], 0, 0, 0); __builtin_amdgcn_s_setprio(0); } while (0)
#define PG8_WAIT_V(n) asm volatile("s_waitcnt vmcnt(" #n ")" ::: "memory")
#define PG8_WAIT_L(n) asm volatile("s_waitcnt lgkmcnt(" #n ")" ::: "memory")
#define PG8_BAR __builtin_amdgcn_s_barrier()
#define PG8_SCHED __builtin_amdgcn_sched_barrier(0)
#define PG8_OFFS(u, gi0, gi1) do { _Pragma("unroll") for (int _i = 0; _i < 2; ++_i) { int R_, C_; stage_rc(tid * 16 + _i * 8192, R_, C_); \
        const int Rb_ = Epi::BMAP ? (64 * (R_ >> 5) + perm32(R_ & 31)) : (Epi::PERM ? ((R_ & ~31) + perm32(R_ & 31)) : R_); int r0_ = R_, r1_ = HALF + R_; if (Sched::GATHER) { r0_ = gi0[_i]; r1_ = gi1[_i]; } \
        vA0[_i] = (unsigned)r0_ * (u).lda + (unsigned)C_ * 2u; vA1[_i] = (unsigned)r1_ * (u).lda + (unsigned)C_ * 2u; \
        vB[_i] = (unsigned)Rb_ * (u).ldb + (unsigned)C_ * 2u; } hsB = (unsigned)(Epi::BMAP ? 32 : HALF) * (u).ldb; } while (0)
#define PG8_GIDX(u, gi0, gi1) do { if (Sched::GATHER) { _Pragma("unroll") for (int _i = 0; _i < 2; ++_i) { int R_, C_; stage_rc(tid * 16 + _i * 8192, R_, C_); gi0[_i] = (u).gather[R_]; gi1[_i] = (u).gather[HALF + R_]; } } } while (0)
    GUnit cur, nxt; int ui = 0;
    if (!S.next(0, cur)) return;
    f32x4 acc[2][2][4][2];
#pragma unroll
    for (int a = 0; a < 2; ++a)
#pragma unroll
        for (int b = 0; b < 2; ++b)
#pragma unroll
            for (int m = 0; m < 4; ++m)
#pragma unroll
                for (int n = 0; n < 2; ++n) acc[a][b][m][n] = (f32x4){0.f, 0.f, 0.f, 0.f};
    bf16x8 At[4][2], B0[2][2], B1[2][2];
    unsigned vA0[2], vA1[2], vB[2]; unsigned hsB; int gi0[2] = {0, 0}, gi1[2] = {0, 0};
    PG8_GIDX(cur, gi0, gi1); PG8_OFFS(cur, gi0, gi1);
    const char* cA = cur.A; const char* cB = cur.B;
    const size_t kstep = (size_t)(BK * 2);
    PG8_STAGE(PG8_SB(0, 0), cB, vB); PG8_STAGE(PG8_SB(0, 1), cB + hsB, vB); PG8_STAGE(PG8_SA(0, 0), cA, vA0); PG8_STAGE(PG8_SA(0, 1), cA, vA1);
    if (wr == 1) PG8_BAR;
    PG8_WAIT_V(2); PG8_BAR;
    PG8_STAGE(PG8_SB(1, 0), cB + kstep, vB); PG8_STAGE(PG8_SA(1, 0), cA + kstep, vA0); PG8_STAGE(PG8_SB(1, 1), cB + hsB + kstep, vB);
    PG8_WAIT_V(6); PG8_BAR;
    for (;;) {
        const bool has_next = S.next(ui + 1, nxt);
        const char* nA = cA; const char* nBp = cB;
        if (has_next) { nA = nxt.A; nBp = nxt.B; PG8_GIDX(nxt, gi0, gi1); }
        const int nt = cur.nk;
        for (int t = 0; t < nt; t += 2) {
            const bool last = (t == nt - 2);
            const char* a1 = cA + (size_t)(t + 1) * kstep;
            const char* a2 = last ? nA : cA + (size_t)(t + 2) * kstep; const char* b2 = last ? nBp : cB + (size_t)(t + 2) * kstep;
            const char* a3 = a2 + kstep; const char* b3 = b2 + kstep;
            PG8_LDB(B0, 0, 0); PG8_LDB(B1, 0, 1); PG8_SCHED; PG8_LDA(At, 0, 0); PG8_STAGE(PG8_SA(1, 1), a1, vA1);
            if (last && has_next) { PG8_OFFS(nxt, gi0, gi1); }
            PG8_WAIT_V(8); PG8_WAIT_L(0); PG8_BAR; PG8_MMA(0, 0, At, B0); PG8_MMA(0, 1, At, B1); PG8_BAR; PG8_SCHED;
            PG8_LDA(At, 0, 1); PG8_STAGE(PG8_SB(0, 0), b2, vB); PG8_STAGE(PG8_SB(0, 1), b2 + hsB, vB); PG8_STAGE(PG8_SA(0, 0), a2, vA0);
            PG8_WAIT_V(8); PG8_WAIT_L(0); PG8_BAR; PG8_MMA(1, 0, At, B0); PG8_MMA(1, 1, At, B1); PG8_BAR; PG8_SCHED;
            PG8_LDB(B0, 1, 0); PG8_LDB(B1, 1, 1); PG8_SCHED; PG8_LDA(At, 1, 0); PG8_STAGE(PG8_SA(0, 1), a2, vA1);
            PG8_WAIT_V(8); PG8_WAIT_L(0); PG8_BAR; PG8_MMA(0, 0, At, B0); PG8_MMA(0, 1, At, B1); PG8_BAR; PG8_SCHED;
            PG8_LDA(At, 1, 1); PG8_STAGE(PG8_SB(1, 0), b3, vB); PG8_STAGE(PG8_SB(1, 1), b3 + hsB, vB); PG8_STAGE(PG8_SA(1, 0), a3, vA0);
            PG8_WAIT_V(8); PG8_WAIT_L(0); PG8_BAR; PG8_MMA(1, 0, At, B0); PG8_MMA(1, 1, At, B1); PG8_BAR; PG8_SCHED;
        }
        if (wr == 0) PG8_BAR;
        { int fr_ = fr, fq_ = fq; asm volatile("" : "+v"(fr_), "+v"(fq_)); E(acc, cur, wr, wc, fr_, fq_); }
        if (!has_next) break;
#pragma unroll
        for (int a = 0; a < 2; ++a)
#pragma unroll
            for (int b = 0; b < 2; ++b)
#pragma unroll
                for (int m = 0; m < 4; ++m)
#pragma unroll
                    for (int n = 0; n < 2; ++n) acc[a][b][m][n] = (f32x4){0.f, 0.f, 0.f, 0.f};
        cur = nxt; cA = nA; cB = nBp; ++ui;
        if (wr == 1) PG8_BAR;
    }
    PG8_WAIT_V(0);
    PG8_BAR;
#undef PG8_SA
#undef PG8_SB
#undef PG8_STAGE
#undef PG8_LDA
#undef PG8_LDB
#undef PG8_MMA
#undef PG8_WAIT_V
#undef PG8_WAIT_L
#undef PG8_BAR
#undef PG8_SCHED
#undef PG8_OFFS
#undef PG8_GIDX
}
}
namespace att {
constexpr int NW = 8, QBLK = 32, KVBLK = 64, QB = 256;
constexpr int KT_BYTES = 64 * 384, VT_BYTES = 64 * 256;
constexpr int LDS_K = 0, LDS_V = 3 * KT_BYTES, LDS_WS = LDS_V + 2 * VT_BYTES, LDS_TOTAL = LDS_WS + NW * 256;
static_assert(LDS_TOTAL == CONV_OFF, "LDS map");
constexpr unsigned KROW = QW * 2, VROW = NH * DV * 2;
constexpr float THR = 8.f;
#define SBAR() __builtin_amdgcn_sched_barrier(0)
__device__ __forceinline__ int crow(int r, int hi) { return (r & 3) + 8 * (r >> 2) + 4 * hi; }
__device__ __forceinline__ void glds16(const void* gsrc, unsigned lds_dst) { unsigned keep;
    asm volatile("s_mov_b32 %0, m0\n\ts_mov_b32 m0, %2\n\ts_nop 0\n\tglobal_load_lds_dwordx4 %1, off\n\ts_mov_b32 m0, %0" : "=&s"(keep) : "v"(gsrc), "s"(lds_dst) : "memory"); }
#define WAIT_BAR(N) asm volatile("s_waitcnt vmcnt(" #N ") lgkmcnt(0)\n\ts_barrier" ::: "memory")
__device__ __forceinline__ int v_rd_base(int lane) { return ((lane & 3) << 3) | (((lane >> 2) & 3) << 6) | (((lane >> 4) & 1) << 5) | (((lane >> 5) & 1) << 8); }
constexpr int v_rd_off(int d0, int ks, int half) { return d0 * 512 + ks * 4096 + half * 2048; }

__device__ __forceinline__ void mask_tile(f32x16& p0, f32x16& p1, int dq) {
    const float NEG = -__builtin_inff();
#pragma unroll
    for (int r = 0; r < 16; ++r) { const int c = (r & 3) + 8 * (r >> 2);
        if (dq - c < 0) p0[r] = NEG;
        if (dq - c - 32 < 0) p1[r] = NEG; }
}
__device__ __forceinline__ void partialSM(f32x16& p0, f32x16& p1, float& m_reg, float& mn, float& alpha) {
    float pmax = p0[0];
#pragma unroll
    for (int r = 1; r < 16; ++r) pmax = fmaxf(pmax, p0[r]);
#pragma unroll
    for (int r = 0; r < 16; ++r) pmax = fmaxf(pmax, p1[r]);
    { auto rr = __builtin_amdgcn_permlane32_swap(__float_as_uint(pmax), __float_as_uint(pmax), false, false);
      pmax = fmaxf(__uint_as_float(rr[0]), __uint_as_float(rr[1])); }
    if (__builtin_expect(__all(pmax - m_reg <= THR), 1)) { mn = m_reg; alpha = 1.f; }
    else { mn = fmaxf(m_reg, pmax); alpha = __builtin_amdgcn_exp2f(m_reg - mn); m_reg = mn; }
#pragma unroll
    for (int r = 0; r < 16; ++r) { p0[r] = p0[r] - mn; p1[r] = p1[r] - mn; }
#pragma unroll
    for (int r = 0; r < 16; ++r) p0[r] = __builtin_amdgcn_exp2f(p0[r]);
}
__device__ __forceinline__ void finishSM(f32x16& p0, f32x16& p1, float alpha, float& l_reg, bf16x8& pa0, bf16x8& pa1, bf16x8& pa2, bf16x8& pa3) {
#pragma unroll
    for (int r = 0; r < 16; ++r) p1[r] = __builtin_amdgcn_exp2f(p1[r]);
    float ps = 0;
#pragma unroll
    for (int r = 0; r < 16; ++r) ps += p0[r];
#pragma unroll
    for (int r = 0; r < 16; ++r) ps += p1[r];
    { auto rr = __builtin_amdgcn_permlane32_swap(__float_as_uint(ps), __float_as_uint(ps), false, false);
      ps = __uint_as_float(rr[0]) + __uint_as_float(rr[1]); }
    l_reg = l_reg * alpha + ps;
#define PK4(P, B_, OUT) do { unsigned a0 = cvt_pk_bf16(P[B_+0], P[B_+1]), a1 = cvt_pk_bf16(P[B_+2], P[B_+3]);                          \
        unsigned b0 = cvt_pk_bf16(P[B_+4], P[B_+5]), b1 = cvt_pk_bf16(P[B_+6], P[B_+7]);                                             \
        auto r0 = __builtin_amdgcn_permlane32_swap(a0, b0, false, false); auto r1 = __builtin_amdgcn_permlane32_swap(a1, b1, false, false); \
        u32x4 w = {r0[0], r1[0], r0[1], r1[1]}; OUT = __builtin_bit_cast(bf16x8, w); } while (0)
    PK4(p0, 0, pa0); PK4(p0, 8, pa1); PK4(p1, 0, pa2); PK4(p1, 8, pa3);
#undef PK4
}
__device__ __forceinline__ void qkt(f32x16& p0, f32x16& p1, const LAS char* const (&kb)[4], const bf16x8 (&qr)[12]) {
    p0 = f32x16{}; p1 = f32x16{};
#pragma unroll
    for (int d0 = 0; d0 < 12; ++d0) { const LAS char* a = kb[d0 & 3] + (d0 >> 2) * 128;
        const bf16x8 b0 = *(const LAS bf16x8*)(a);
        const bf16x8 b1 = *(const LAS bf16x8*)(a + 32 * 384);
        p0 = __builtin_amdgcn_mfma_f32_32x32x16_bf16(b0, qr[d0], p0, 0, 0, 0);
        p1 = __builtin_amdgcn_mfma_f32_32x32x16_bf16(b1, qr[d0], p1, 0, 0, 0); }
}
template <int HALF_> __device__ __forceinline__ void pv_tile(f32x16* o, int vb0, bf16x8 pa0, bf16x8 pa1, bf16x8 pa2, bf16x8 pa3) {
#define TRRD(dst, off) asm volatile("ds_read_b64_tr_b16 %0, %1 offset:%2" : "=&v"(dst) : "v"(vb0), "i"(off) : "memory")
#define PV_D0(d0) do { s16x4 l0, l1, l2, l3, h0, h1, h2, h3; constexpr int b_ = v_rd_off(d0, 0, 0); \
        TRRD(l0, b_); TRRD(h0, b_ + 2048); TRRD(l1, b_ + 4096); TRRD(h1, b_ + 6144); TRRD(l2, b_ + 8192); TRRD(h2, b_ + 10240); TRRD(l3, b_ + 12288); TRRD(h3, b_ + 14336); \
        asm volatile("s_waitcnt lgkmcnt(0)" ::: "memory"); SBAR(); \
        o[d0] = __builtin_amdgcn_mfma_f32_32x32x16_bf16(pa0, (bf16x8){l0[0], l0[1], l0[2], l0[3], h0[0], h0[1], h0[2], h0[3]}, o[d0], 0, 0, 0);   \
        o[d0] = __builtin_amdgcn_mfma_f32_32x32x16_bf16(pa1, (bf16x8){l1[0], l1[1], l1[2], l1[3], h1[0], h1[1], h1[2], h1[3]}, o[d0], 0, 0, 0);   \
        o[d0] = __builtin_amdgcn_mfma_f32_32x32x16_bf16(pa2, (bf16x8){l2[0], l2[1], l2[2], l2[3], h2[0], h2[1], h2[2], h2[3]}, o[d0], 0, 0, 0);   \
        o[d0] = __builtin_amdgcn_mfma_f32_32x32x16_bf16(pa3, (bf16x8){l3[0], l3[1], l3[2], l3[3], h3[0], h3[1], h3[2], h3[3]}, o[d0], 0, 0, 0); } while (0)
    if (HALF_ == 0) { PV_D0(0); PV_D0(1); } else { PV_D0(2); PV_D0(3); }
#undef PV_D0
#undef TRRD
}

struct ConvCtx {
    int ci, cd, n, base_it, stride;
    int bi, bd;
    const float* wg; const float* wu; const float* wd; const float* fg; bf16_t* WGU; bf16_t* WDn;
};
struct ConvTile { const float* W; int ldw, k0, n0; bf16_t* WT; int drow, ldt; bool gain; };
__device__ __forceinline__ void conv_decode(const ConvCtx& c, int i, ConvTile& t) {
    constexpr int TG = 64 * 64 * 8;
    int r = c.base_it + i * c.stride;
    if (r < 2 * TG) { const bool up = r >= TG; if (up) r -= TG; const int e = r >> 9, q = r & 511, kb = q >> 3, nb = q & 7; const int n0 = 64 * nb;
        t.W = (up ? c.wu : c.wg) + (size_t)e * DM * DE; t.ldw = DE; t.k0 = 64 * kb; t.n0 = n0; t.WT = c.WGU + (size_t)e * 1024 * DM; t.drow = (n0 >> 7) * 256 + (up ? 128 : 0) + (n0 & 127); t.ldt = DM; t.gain = true; }
    else { r -= 2 * TG; const int e = r >> 9, q = r & 511, kb = q >> 6, nb = q & 63;
        t.W = c.wd + (size_t)e * DE * DM; t.ldw = DM; t.k0 = 64 * kb; t.n0 = 64 * nb; t.WT = c.WDn + (size_t)e * DM * DE; t.drow = 64 * nb; t.ldt = DE; t.gain = false; }
}
__device__ __forceinline__ void conv_process(const ConvCtx& c, int i, int buf, LAS char* shm, int wid, int lane) {
    ConvTile t; conv_decode(c, i, t);
    const LAS float* T = (const LAS float*)(shm + CONV_OFF + buf * 16384) + wid * 8 * 64 + lane;
    float v[8];
#pragma unroll
    for (int j = 0; j < 8; ++j) v[j] = T[j * 64];
    if (t.gain) { const __attribute__((address_space(4))) float* g = (const __attribute__((address_space(4))) float*)(c.fg + t.k0 + 8 * wid);
#pragma unroll
        for (int j = 0; j < 8; ++j) v[j] *= g[j]; }
    u32x4 o; o.x = cvt_pk_bf16(v[0], v[1]); o.y = cvt_pk_bf16(v[2], v[3]); o.z = cvt_pk_bf16(v[4], v[5]); o.w = cvt_pk_bf16(v[6], v[7]);
    *(u32x4*)((char*)(t.WT + (size_t)t.drow * t.ldt + t.k0 + 8 * wid) + (unsigned)lane * (unsigned)t.ldt * 2u) = o;
}
__device__ __forceinline__ void conv_dma(const ConvCtx& c, int i, int buf, unsigned lds0, int wid, int lane) {
    ConvTile t; conv_decode(c, i, t);
    const char* g = (const char*)(t.W + (size_t)(t.k0 + 8 * wid) * t.ldw + t.n0);
    const unsigned lo = (unsigned)(lane >> 4) * (unsigned)t.ldw * 4u + (unsigned)(lane & 15) * 16u;
    const unsigned dst = lds0 + CONV_OFF + buf * 16384 + wid * 2048;
    glds16(g + lo, (unsigned)__builtin_amdgcn_readfirstlane(dst));
    glds16(g + (size_t)t.ldw * 16 + lo, (unsigned)__builtin_amdgcn_readfirstlane(dst + 1024));
}
__device__ __forceinline__ bool conv_proc_ready(const ConvCtx& c) { return c.ci < c.n && c.cd - c.ci >= 2; }
__device__ __forceinline__ void conv_proc_step(ConvCtx& c, LAS char* shm, int wid, int lane) {
    if (conv_proc_ready(c)) { conv_process(c, c.ci, c.bi, shm, wid, lane); ++c.ci; c.bi = c.bi == 2 ? 0 : c.bi + 1; }
}
__device__ __forceinline__ bool conv_dma_begin(const ConvCtx& c, ConvTile& t) { const bool go = c.cd < c.n; if (go) conv_decode(c, c.cd, t); return go; }
__device__ __forceinline__ void conv_dma1(const ConvCtx& c, const ConvTile& t, int piece, unsigned lds0, int wid, int lane) {
    const char* g = (const char*)(t.W + (size_t)(t.k0 + 8 * wid + 4 * piece) * t.ldw + t.n0);
    const unsigned lo = (unsigned)(lane >> 4) * (unsigned)t.ldw * 4u + (unsigned)(lane & 15) * 16u;
    glds16(g + lo, (unsigned)__builtin_amdgcn_readfirstlane(lds0 + CONV_OFF + c.bd * 16384 + wid * 2048 + piece * 1024));
}
__device__ __forceinline__ void conv_dma_end(ConvCtx& c) { ++c.cd; c.bd = c.bd == 2 ? 0 : c.bd + 1; }
__device__ __forceinline__ bool conv_dma_step(ConvCtx& c, unsigned lds0, int wid, int lane) {
    const bool go = c.cd < c.n;
    if (go) conv_dma(c, c.cd, c.bd, lds0, wid, lane);
    ++c.cd; c.bd = c.bd == 2 ? 0 : c.bd + 1;
    return go;
}

__device__ __forceinline__ void attn_unit(int b, int h, int qb, const bf16_t* Q, const bf16_t* KF, const bf16_t* VBp, bf16_t* MIX, const float* gq, const float* rope, ConvCtx& cv, LAS char* shm) {
    int tid = threadIdx.x; asm volatile("" : "+v"(tid));
    const int lane = tid & 63, r32 = lane & 31, hi = lane >> 5; const int wid = __builtin_amdgcn_readfirstlane(tid >> 6);
    const int NT = 4 * qb + 5;
    const char* Kg = (const char*)KF + ((size_t)(b * LSEQ) * QW + h * DQK) * 2;
    const char* Vg = (const char*)VBp + ((size_t)(b * LSEQ) * (NH * DV) + h * DV) * 2;
    const char* Qg = (const char*)Q + ((size_t)(b * SEQ + qb * QB + wid * QBLK + r32) * QW + h * DQK) * 2;
    const unsigned lds0 = (unsigned)(uintptr_t)shm;
    bf16x8 qr[12];
    { u32x4 raw[12];
#pragma unroll
      for (int d0 = 0; d0 < 12; ++d0) raw[d0] = *(const u32x4*)(Qg + (d0 * 16 + hi * 8) * 2);
      const int tpos = NMETA + qb * QB + wid * QBLK + r32; const float* rp = rope + (size_t)tpos * 64 + 8 * hi;
      float ss = 0.f;
#pragma unroll
      for (int d0 = 0; d0 < 12; ++d0)
#pragma unroll
          for (int j = 0; j < 4; ++j) { const float x = bf_lo(raw[d0][j]), y = bf_hi(raw[d0][j]); ss += x * x + y * y; }
      { auto rr = __builtin_amdgcn_permlane32_swap(__float_as_uint(ss), __float_as_uint(ss), false, false); ss = __uint_as_float(rr[0]) + __uint_as_float(rr[1]); }
      const float rq = rsqrtf(ss * (1.f / DQK) + EPS) * QSCALE;
#pragma unroll
      for (int d0 = 0; d0 < 8; ++d0) { const f32x4 g0 = *(const f32x4*)(gq + d0 * 16 + hi * 8), g1 = *(const f32x4*)(gq + d0 * 16 + hi * 8 + 4); u32x4 w;
          w.x = cvt_pk_bf16(bf_lo(raw[d0][0]) * rq * g0[0], bf_hi(raw[d0][0]) * rq * g0[1]); w.y = cvt_pk_bf16(bf_lo(raw[d0][1]) * rq * g0[2], bf_hi(raw[d0][1]) * rq * g0[3]);
          w.z = cvt_pk_bf16(bf_lo(raw[d0][2]) * rq * g1[0], bf_hi(raw[d0][2]) * rq * g1[1]); w.w = cvt_pk_bf16(bf_lo(raw[d0][3]) * rq * g1[2], bf_hi(raw[d0][3]) * rq * g1[3]);
          qr[d0] = __builtin_bit_cast(bf16x8, w); }
#pragma unroll
      for (int dd = 0; dd < 2; ++dd) {
          float x1[8], x2[8], cs[8], sn[8];
#pragma unroll
          for (int q = 0; q < 2; ++q) { const f32x4 ga = *(const f32x4*)(gq + 128 + 16 * dd + 8 * hi + 4 * q), gb = *(const f32x4*)(gq + 160 + 16 * dd + 8 * hi + 4 * q);
              const f32x4 cc = *(const f32x4*)(rp + 16 * dd + 4 * q), sq = *(const f32x4*)(rp + 32 + 16 * dd + 4 * q);
#pragma unroll
              for (int e = 0; e < 4; ++e) { const int j = 4 * q + e; const unsigned wa = raw[8 + dd][j >> 1], wb = raw[10 + dd][j >> 1];
                  x1[j] = ((j & 1) ? bf_hi(wa) : bf_lo(wa)) * rq * ga[e]; x2[j] = ((j & 1) ? bf_hi(wb) : bf_lo(wb)) * rq * gb[e]; cs[j] = cc[e]; sn[j] = sq[e]; } }
          u32x4 w1, w2;
#pragma unroll
          for (int q = 0; q < 4; ++q) { w1[q] = cvt_pk_bf16(x1[2 * q] * cs[2 * q] - x2[2 * q] * sn[2 * q], x1[2 * q + 1] * cs[2 * q + 1] - x2[2 * q + 1] * sn[2 * q + 1]);
              w2[q] = cvt_pk_bf16(x1[2 * q] * sn[2 * q] + x2[2 * q] * cs[2 * q], x1[2 * q + 1] * sn[2 * q + 1] + x2[2 * q + 1] * cs[2 * q + 1]); }
          qr[8 + dd] = __builtin_bit_cast(bf16x8, w1); qr[10 + dd] = __builtin_bit_cast(bf16x8, w2); }
    }
    unsigned kof[3], vof[2];
#pragma unroll
    for (int j = 0; j < 3; ++j) { const int q = (wid * 3 + j) * 64 + lane, row = q / 24, chp = q - row * 24; const int ch = (chp & ~7) | ((chp & 7) ^ ((row >> 1) & 7));
        kof[j] = (unsigned)row * KROW + (unsigned)ch * 16u; }
#pragma unroll
    for (int j = 0; j < 2; ++j) { const int q = (wid * 2 + j) * 64 + lane, s = q >> 5; const int kk = (s >> 2) * 8 + ((q & 31) >> 2), c = (s & 3) * 32 + (q & 3) * 8;
        const int k = (kk & ~0xC) | ((kk & 4) << 1) | ((kk & 8) >> 1);
        vof[j] = (unsigned)k * VROW + (unsigned)c * 2u; }
    const unsigned kdst = lds0 + LDS_K + wid * 3072, vdst = lds0 + LDS_V + wid * 2048;
#define DMA_K(t, slot) do { const char* g_ = Kg + (size_t)(t) * (KVBLK * KROW); _Pragma("unroll") for (int j_ = 0; j_ < 3; ++j_) glds16(g_ + kof[j_], (unsigned)__builtin_amdgcn_readfirstlane(kdst + (slot) * KT_BYTES + j_ * 1024)); } while (0)
#define DMA_V(t, slot) do { const char* g_ = Vg + (size_t)(t) * (KVBLK * VROW); _Pragma("unroll") for (int j_ = 0; j_ < 2; ++j_) glds16(g_ + vof[j_], (unsigned)__builtin_amdgcn_readfirstlane(vdst + (slot) * VT_BYTES + j_ * 1024)); } while (0)
#define DMA_K1(t, slot, j_) glds16(Kg + (size_t)(t) * (KVBLK * KROW) + kof[j_], (unsigned)__builtin_amdgcn_readfirstlane(kdst + (slot) * KT_BYTES + (j_) * 1024))
#define DMA_V1(t, slot, j_) glds16(Vg + (size_t)(t) * (KVBLK * VROW) + vof[j_], (unsigned)__builtin_amdgcn_readfirstlane(vdst + (slot) * VT_BYTES + (j_) * 1024))
    DMA_K(0, 0); DMA_K(1, 1);
    const LAS char* shm3 = (const LAS char*)shm;
    const int key7 = (r32 >> 1) & 7;
    const LAS char* kb0[4];
#pragma unroll
    for (int dd = 0; dd < 4; ++dd) kb0[dd] = shm3 + LDS_K + r32 * 384 + 16 * ((2 * dd + hi) ^ key7);
    const int vb0 = (int)(lds0 + LDS_V) + v_rd_base(lane);
    LAS float* ws = (LAS float*)(shm + LDS_WS) + wid * 64; LAS float* li_l = ws; LAS float* al_l = ws + 32;
    float m_reg = -1e30f, l_reg = 0.f; f32x16 o[4] = {};
    const int qlo = NMETA + qb * QB + wid * QBLK;
    const int qm = qlo + r32 - 4 * hi;
#define RESC(a) do { if (__any((a) < 1.f)) { if (hi == 0) al_l[r32] = (a); asm volatile("s_waitcnt lgkmcnt(0)" ::: "memory");              \
                     _Pragma("unroll") for (int d_ = 0; d_ < 4; ++d_) _Pragma("unroll") for (int r = 0; r < 16; ++r) o[d_][r] *= al_l[crow(r, hi)]; } } while (0)
#define MASKT(P0_, P1_, t) do { const int kb_ = (t) * KVBLK; if (kb_ + KVBLK - 1 > qlo) mask_tile(P0_, P1_, qm - kb_); } while (0)
    f32x16 pA0, pA1, pB0, pB1; float mnA, mnB, alA, alB; bf16x8 pa0, pa1, pa2, pa3;
    int sK = 0, sKn = 1, sKnn = 2;
    int sVp = 1, sV = 0;
#define ROT() do { int t_ = sK; sK = sKn; sKn = sKnn; sKnn = t_; t_ = sVp; sVp = sV; sV = t_; } while (0)
#define QKT_H(P0_, P1_, t, gk_, gc_) do {                                                                                       \
        const LAS char* kq_[4] = {kb0[0] + sK * KT_BYTES, kb0[1] + sK * KT_BYTES, kb0[2] + sK * KT_BYTES, kb0[3] + sK * KT_BYTES}; \
        P0_ = f32x16{}; P1_ = f32x16{};                                                                                        \
        bf16x8 fa0 = *(const LAS bf16x8*)(kq_[0]), fa1 = *(const LAS bf16x8*)(kq_[0] + 32 * 384), fb0, fb1;                  \
        _Pragma("unroll") for (int d0 = 0; d0 < 12; d0 += 2) {                                                                 \
            { const LAS char* a_ = kq_[(d0 + 1) & 3] + ((d0 + 1) >> 2) * 128; fb0 = *(const LAS bf16x8*)(a_); fb1 = *(const LAS bf16x8*)(a_ + 32 * 384); } \
            if (d0 == 2) { DMA_V1((t), sV, 0); }                                                                              \
            if (d0 == 4) { if (gk_) DMA_K1((t) + 2, sKnn, 0); }                                                               \
            if (d0 == 6) { if (gk_) DMA_K1((t) + 2, sKnn, 2); }                                                               \
            if (d0 == 8) { if (gc_) conv_dma1(cv, cdma_, 1, lds0, wid, lane); }                                               \
            P0_ = __builtin_amdgcn_mfma_f32_32x32x16_bf16(fa0, qr[d0], P0_, 0, 0, 0); P1_ = __builtin_amdgcn_mfma_f32_32x32x16_bf16(fa1, qr[d0], P1_, 0, 0, 0); \
            if (d0 + 2 < 12) { const LAS char* a_ = kq_[(d0 + 2) & 3] + ((d0 + 2) >> 2) * 128; fa0 = *(const LAS bf16x8*)(a_); fa1 = *(const LAS bf16x8*)(a_ + 32 * 384); } \
            if (d0 == 0) { }                                                                                                    \
            if (d0 == 2) { DMA_V1((t), sV, 1); }                                                                              \
            if (d0 == 4) { if (gk_) DMA_K1((t) + 2, sKnn, 1); }                                                               \
            if (d0 == 6) { if (gc_) conv_dma1(cv, cdma_, 0, lds0, wid, lane); }                                               \
            P0_ = __builtin_amdgcn_mfma_f32_32x32x16_bf16(fb0, qr[d0 + 1], P0_, 0, 0, 0); P1_ = __builtin_amdgcn_mfma_f32_32x32x16_bf16(fb1, qr[d0 + 1], P1_, 0, 0, 0); \
        } } while (0)
    WAIT_BAR(0);
#define WAIT_N(n_) do { switch (n_) { case 0: WAIT_BAR(0); break; case 1: WAIT_BAR(1); break; case 2: WAIT_BAR(2); break; case 3: WAIT_BAR(3); break; case 4: WAIT_BAR(4); break; case 5: WAIT_BAR(5); break; default: WAIT_BAR(6); break; } } while (0)
    { ConvTile cdma_; const bool gs0_ = conv_proc_ready(cv); const bool gc0_ = conv_dma_begin(cv, cdma_);
      QKT_H(pA0, pA1, 0, true, gc0_);
      conv_proc_step(cv, shm, wid, lane); conv_dma_end(cv);
      MASKT(pA0, pA1, 0); partialSM(pA0, pA1, m_reg, mnA, alA);
      RESC(alA);
      WAIT_N(3 + (gc0_ ? 2 : 0) + (gs0_ ? 1 : 0)); }
    ROT();
#define STEP(PX0, PX1, mnX, alX, PY0, PY1, alY, t) do {                                                                        \
        const bool gk_ = (t) + 2 < NT; ConvTile cdma_; const bool gs_ = conv_proc_ready(cv); const bool gc_ = conv_dma_begin(cv, cdma_); \
        SBAR(); QKT_H(PX0, PX1, (t), gk_, gc_);                                                                              \
        finishSM(PY0, PY1, alY, l_reg, pa0, pa1, pa2, pa3); SBAR();                                                          \
        pv_tile<0>(o, vb0 + sVp * VT_BYTES, pa0, pa1, pa2, pa3);                                                             \
        conv_proc_step(cv, shm, wid, lane); conv_dma_end(cv);                                                                \
        pv_tile<1>(o, vb0 + sVp * VT_BYTES, pa0, pa1, pa2, pa3); MASKT(PX0, PX1, (t)); partialSM(PX0, PX1, m_reg, mnX, alX); \
        RESC(alX);                                                                                                            \
        WAIT_N((gk_ ? 3 : 0) + (gc_ ? 2 : 0) + (gs_ ? 1 : 0));                                                               \
        ROT(); } while (0)
    for (int t = 1; t + 1 < NT; t += 2) {
        STEP(pB0, pB1, mnB, alB, pA0, pA1, alA, t);
        STEP(pA0, pA1, mnA, alA, pB0, pB1, alB, t + 1);
    }
    finishSM(pA0, pA1, alA, l_reg, pa0, pa1, pa2, pa3); SBAR();
    pv_tile<0>(o, vb0 + sVp * VT_BYTES, pa0, pa1, pa2, pa3); pv_tile<1>(o, vb0 + sVp * VT_BYTES, pa0, pa1, pa2, pa3);
    if (hi == 0) li_l[r32] = l_reg; asm volatile("s_waitcnt lgkmcnt(0)" ::: "memory");
    float rli[16];
#pragma unroll
    for (int r = 0; r < 16; ++r) rli[r] = __builtin_amdgcn_rcpf(li_l[crow(r, hi)]);
    bf16_t* Ow = MIX + (size_t)(b * LSEQ + NMETA + qb * QB + wid * QBLK) * DM + POOLW + h * DV;
#pragma unroll
    for (int r = 0; r < 16; ++r) { const int orow = crow(r, hi);
#pragma unroll
        for (int d0 = 0; d0 < 4; ++d0) { const float v = o[d0][r] * rli[r]; const float vn = __shfl_xor(v, 1);
            if ((r32 & 1) == 0) *(unsigned*)(Ow + (size_t)orow * DM + d0 * 32 + r32) = cvt_pk_bf16(v, vn); } }
    asm volatile("s_waitcnt lgkmcnt(0)\n\ts_barrier" ::: "memory");
#undef DMA_K
#undef DMA_V
#undef RESC
#undef MASKT
#undef ROT
#undef STEP
}
#undef SBAR
#undef WAIT_BAR
}
constexpr int NWAVES = 8;
struct Frame {
    LAS unsigned char* lds;
    volatile LAS unsigned* MISC;
    unsigned* ctl;
    int tid, lane, wave, vcu, G;
    const float* in[21]; float* out; unsigned char* ws;
};
enum { IN_X = 0, IN_META, IN_MIXG, IN_WIN, IN_QLG, IN_WUQ, IN_KVLG, IN_WUKV, IN_QHG, IN_KHG, IN_WPOOL, IN_PSCALE, IN_WOUT, IN_FFNG, IN_WGROUP, IN_BGROUP, IN_WEXP, IN_BEXP, IN_WGATE, IN_WUP, IN_WDOWN };
#define WSP(T, off) ((T*)(F.ws + (off)))

struct TrItem { const float* W; int ldw, k0, n0; bf16_t* WT; int drow, ldt; const float* sk; const float* sn; };
__device__ __forceinline__ void tr_load(f32x4 (&v)[16], const TrItem& t, int lane) {
    const int s = lane >> 4, cq = lane & 15;
#pragma unroll
    for (int i = 0; i < 16; ++i) { const int row = 8 * (i >> 1) + 2 * s + (i & 1); v[i] = *(const f32x4*)(t.W + (size_t)(t.k0 + row) * t.ldw + t.n0 + 4 * cq); }
}
__device__ __forceinline__ void tr_store(const f32x4 (&v)[16], const TrItem& t, LAS unsigned* T, int lane) {
    const int s = lane >> 4, cq = lane & 15;
    f32x4 gn = {1.f, 1.f, 1.f, 1.f}; if (t.sn) gn = *(const f32x4*)(t.sn + t.n0 + 4 * cq);
#pragma unroll
    for (int m = 0; m < 8; ++m) { f32x2 g = {1.f, 1.f}; if (t.sk) g = *(const f32x2*)(t.sk + t.k0 + 8 * m + 2 * s);
#pragma unroll
        for (int c = 0; c < 4; ++c) T[(4 * cq + c) * 33 + 4 * m + s] = cvt_pk_bf16(v[2 * m][c] * g.x * gn[c], v[2 * m + 1][c] * g.y * gn[c]); }
    LDS_WAIT(); asm volatile("" ::: "memory");
    const int q = lane & 7, nr = lane >> 3;
#pragma unroll
    for (int j = 0; j < 8; ++j) { const int n = nr + 8 * j; const LAS unsigned* r = T + n * 33 + 4 * q; u32x4 o; o.x = r[0]; o.y = r[1]; o.z = r[2]; o.w = r[3];
        *(u32x4*)(t.WT + (size_t)(t.drow + n) * t.ldt + t.k0 + 8 * q) = o; }
    LDS_WAIT(); asm volatile("" ::: "memory");
}
constexpr int TI_IN = 64 * 41, TI_UQ = 16 * 72, TI_UKV = 8 * 96, TI_P = 4 * 16, TI_O = 64 * 64, TI_SMALL = TI_IN + TI_UQ + TI_UKV + TI_P + TI_O;
constexpr int TI_G = 64 * 64 * 8, TI_D = 64 * 8 * 64, TI_EXP = 2 * TI_G + TI_D, TI_ALL = TI_SMALL + TI_EXP;
__device__ __forceinline__ void tr_decode(const Frame& F, int it, TrItem& t) {
    int r = it; t.sk = nullptr; t.sn = nullptr;
    if (r < TI_IN) { const int kb = r / 41, nb = r % 41; t.W = F.in[IN_WIN]; t.ldw = INC; t.k0 = 64 * kb; t.n0 = 64 * nb; t.WT = WSP(bf16_t, WS_WIN); t.drow = 64 * nb; t.ldt = DM; t.sk = F.in[IN_MIXG]; return; } r -= TI_IN;
    if (r < TI_UQ) { const int kb = r / 72, nb = r % 72; t.W = F.in[IN_WUQ]; t.ldw = QW; t.k0 = 64 * kb; t.n0 = 64 * nb; t.WT = WSP(bf16_t, WS_WUQ); t.drow = 64 * nb; t.ldt = QLR; t.sk = F.in[IN_QLG]; return; } r -= TI_UQ;
    if (r < TI_UKV) { const int kb = r / 96, nb = r % 96; t.W = F.in[IN_WUKV]; t.ldw = KVW; t.k0 = 64 * kb; t.n0 = 64 * nb; t.WT = WSP(bf16_t, WS_WUKV); t.drow = 64 * nb; t.ldt = KVLR; t.sk = F.in[IN_KVLG]; return; } r -= TI_UKV;
    if (r < TI_P) { const int g = r >> 4, q = r & 15, kb = q >> 2, nb = q & 3; t.W = F.in[IN_WPOOL] + (size_t)g * 65536; t.ldw = 256; t.k0 = 64 * kb; t.n0 = 64 * nb; t.WT = WSP(bf16_t, WS_WP) + (size_t)g * 65536; t.drow = 64 * nb; t.ldt = 256;
        t.sn = F.in[IN_PSCALE] + g * 256; return; } r -= TI_P;
    if (r < TI_O) { const int kb = r >> 6, nb = r & 63; t.W = F.in[IN_WOUT]; t.ldw = DM; t.k0 = 64 * kb; t.n0 = 64 * nb; t.WT = WSP(bf16_t, WS_WO); t.drow = 64 * nb; t.ldt = DM; return; } r -= TI_O;
    if (r < 2 * TI_G) { const bool up = r >= TI_G; if (up) r -= TI_G; const int e = r >> 9, q = r & 511, kb = q >> 3, nb = q & 7; const int n0 = 64 * nb;
        t.W = (up ? F.in[IN_WUP] : F.in[IN_WGATE]) + (size_t)e * DM * DE; t.ldw = DE; t.k0 = 64 * kb; t.n0 = n0; t.WT = WSP(bf16_t, WS_WGU) + (size_t)e * 1024 * DM; t.drow = (n0 >> 7) * 256 + (up ? 128 : 0) + (n0 & 127); t.ldt = DM;
        t.sk = F.in[IN_FFNG]; return; } r -= 2 * TI_G;
    { const int e = r >> 9, q = r & 511, kb = q >> 6, nb = q & 63; t.W = F.in[IN_WDOWN] + (size_t)e * DE * DM; t.ldw = DM; t.k0 = 64 * kb; t.n0 = 64 * nb; t.WT = WSP(bf16_t, WS_WD) + (size_t)e * DM * DE; t.drow = 64 * nb; t.ldt = DE; }
}
__device__ __forceinline__ void tr_range(Frame& F, int lo, int hi) {
    LAS unsigned* T = (LAS unsigned*)(F.lds + F.wave * 16384);
    const int gw = F.vcu * NWAVES + F.wave, NGW = F.G * NWAVES, lane = F.lane;
    int it = lo + gw; if (it >= hi) return;
    TrItem ta, tb; f32x4 va[16], vb[16];
    tr_decode(F, it, ta); tr_load(va, ta, lane);
    for (;;) {
        const int i1 = it + NGW; const bool h1 = i1 < hi;
        if (h1) { tr_decode(F, i1, tb); tr_load(vb, tb, lane); }
        tr_store(va, ta, T, lane);
        if (!h1) break;
        const int i2 = i1 + NGW; const bool h2 = i2 < hi;
        if (h2) { tr_decode(F, i2, ta); tr_load(va, ta, lane); }
        tr_store(vb, tb, T, lane);
        if (!h2) break;
        it = i2;
    }
}
__device__ __forceinline__ void p0_prologue(Frame& F) {
    const int gw = F.vcu * NWAVES + F.wave, NGW = F.G * NWAVES, lane = F.lane;
    const int gt = gw * 64 + lane, NGT = NGW * 64;
    tr_range(F, 0, TI_SMALL);
    { bf16_t* hi = WSP(bf16_t, WS_WRT); bf16_t* lo = hi + 96 * DM;
      for (int i = gt; i < 96 * DM; i += NGT) { const int j = i / DM, k = i % DM; float v = 0.f;
          if (j < 8) v = F.in[IN_WGROUP][(size_t)k * NG + j] * F.in[IN_FFNG][k]; else if (j < 72) v = F.in[IN_WEXP][(size_t)k * NE + (j - 8)] * F.in[IN_FFNG][k];
          const unsigned h = cvt_pk_bf16(v, 0.f) & 0xffffu; hi[i] = (bf16_t)h; lo[i] = (bf16_t)(cvt_pk_bf16(v - bf_lo(h), 0.f) & 0xffffu); } }
    { float* rt = WSP(float, WS_ROPE);
      for (int i = gt; i < LSEQ * 32; i += NGT) { const int t = i >> 5, f = i & 31; const float inv = 1.0f / powf(10000.0f, (float)(2 * f) / (float)ROPE); const float ang = (float)t * inv;
          rt[t * 64 + f] = cosf(ang); rt[t * 64 + 32 + f] = sinf(ang); } }
    { float* rstd1 = WSP(float, WS_SMALL + SM_RSTD1); bf16_t* XB = WSP(bf16_t, WS_XB);
      auto rowptr = [&](int row) -> const f32x4* { const int b = row / LSEQ, t = row % LSEQ;
          const float* h = t < NMETA ? F.in[IN_META] + (size_t)t * DM : F.in[IN_X] + ((size_t)b * SEQ + (t - NMETA)) * DM; return (const f32x4*)h + lane; };
      f32x4 va[16], vb[16];
      int row = gw;
      if (row < NTOK) { const f32x4* xr = rowptr(row);
#pragma unroll
          for (int j = 0; j < 16; ++j) va[j] = xr[64 * j]; }
      for (; row < MPAD; row += 2 * NGW) {
          const int r1 = row + NGW;
          if (r1 < NTOK) { const f32x4* xr = rowptr(r1);
#pragma unroll
              for (int j = 0; j < 16; ++j) vb[j] = xr[64 * j]; }
#define XB_ROW(V_, ROW_) do { unsigned long long* o8 = (unsigned long long*)(XB + (size_t)(ROW_) * DM) + lane;                       \
          if ((ROW_) >= NTOK) { _Pragma("unroll") for (int j = 0; j < 16; ++j) o8[64 * j] = 0ull; if (lane == 0) rstd1[(ROW_)] = 0.f; }       \
          else { float s = 0.f; _Pragma("unroll") for (int j = 0; j < 16; ++j) s += (V_[j].x * V_[j].x + V_[j].y * V_[j].y) + (V_[j].z * V_[j].z + V_[j].w * V_[j].w); \
              s = wave_sum(s); const float rs = rsqrtf(s * (1.f / DM) + EPS); if (lane == 0) rstd1[(ROW_)] = rs;                     \
              _Pragma("unroll") for (int j = 0; j < 16; ++j) o8[64 * j] = (unsigned long long)cvt_pk_bf16(V_[j].x * rs, V_[j].y * rs) | ((unsigned long long)cvt_pk_bf16(V_[j].z * rs, V_[j].w * rs) << 32); } } while (0)
          XB_ROW(va, row);
          const int r2 = r1 + NGW;
          if (r2 < NTOK) { const f32x4* xr = rowptr(r2);
#pragma unroll
              for (int j = 0; j < 16; ++j) va[j] = xr[64 * j]; }
          if (r1 < MPAD) XB_ROW(vb, r1);
#undef XB_ROW
      } }
}

template <int W> __device__ __forceinline__ void pool_cols(const bf16_t* PROJ, bf16_t* DIFF, int row0, int t0, int c) {
    float v0[31], v1[31];
#pragma unroll
    for (int i = 0; i < 31; ++i) { const int dt = i - 15; unsigned w = 0u; if (t0 + dt >= 0) w = *(const unsigned*)(PROJ + (size_t)(row0 + dt) * INCP + c); v0[i] = bf_lo(w); v1[i] = bf_hi(w); }
#pragma unroll
    for (int i = 0; i < 16; ++i) { float s0 = 0.f, s1 = 0.f;
#pragma unroll
        for (int j = 0; j < W; ++j) { s0 += v0[15 + i - j]; s1 += v1[15 + i - j]; }
        const int t = t0 + i; const float inv = 1.f / (float)((t + 1 < W) ? t + 1 : W);
        *(unsigned*)(DIFF + (size_t)(row0 + i) * POOLW + c) = cvt_pk_bf16(s0 * inv - v0[15 + i], s1 * inv - v1[15 + i]); }
}
__device__ __forceinline__ void s2_phase(Frame& F) {
    const bf16_t* PROJ = WSP(bf16_t, WS_PROJ); bf16_t* DIFF = WSP(bf16_t, WS_DIFF);
    float* rstdq = WSP(float, WS_SMALL + SM_RSTDQ); float* rstdkv = WSP(float, WS_SMALL + SM_RSTDKV); float* ssqpe = WSP(float, WS_SMALL + SM_SSQPE); float* kr = WSP(float, WS_KR);
    const float* rope = WSP(float, WS_ROPE);
    for (int tile = F.vcu; tile < MPAD / 16; tile += F.G) {
        const int row0 = tile * 16, t0 = row0 % LSEQ;
        const int c = 2 * F.tid, gi = F.wave >> 1;
        if (gi == 0) pool_cols<2>(PROJ, DIFF, row0, t0, c); else if (gi == 1) pool_cols<4>(PROJ, DIFF, row0, t0, c); else if (gi == 2) pool_cols<8>(PROJ, DIFF, row0, t0, c); else pool_cols<16>(PROJ, DIFF, row0, t0, c);
#pragma unroll
        for (int rr = 0; rr < 2; ++rr) { const int row = row0 + 2 * F.wave + rr; const bf16_t* p = PROJ + (size_t)row * INCP;
            const u32x4 a = *(const u32x4*)(p + POOLW + 8 * F.lane), b = *(const u32x4*)(p + POOLW + 512 + 8 * F.lane), k = *(const u32x4*)(p + POOLW + QLR + 8 * F.lane);
            float sq = 0.f, sk = 0.f;
#pragma unroll
            for (int j = 0; j < 4; ++j) { float x;
                x = bf_lo(a[j]); sq += x * x; x = bf_hi(a[j]); sq += x * x; x = bf_lo(b[j]); sq += x * x; x = bf_hi(b[j]); sq += x * x;
                x = bf_lo(k[j]); sk += x * x; x = bf_hi(k[j]); sk += x * x; }
            sq = wave_sum(sq); sk = wave_sum(sk);
            const int cl = F.lane & 7; const u32x4 kp = *(const u32x4*)(p + POOLW + QLR + KVLR + 8 * cl); const int t = row % LSEQ;
            float x[8], sp = 0.f;
#pragma unroll
            for (int j = 0; j < 4; ++j) { x[2 * j] = bf_lo(kp[j]); x[2 * j + 1] = bf_hi(kp[j]); }
#pragma unroll
            for (int j = 0; j < 8; ++j) { sp += x[j] * x[j]; x[j] *= F.in[IN_KHG][DNOPE + 8 * cl + j]; }
            sp += __shfl_xor(sp, 1); sp += __shfl_xor(sp, 2); sp += __shfl_xor(sp, 4);
            const float* rp = rope + (size_t)t * 64 + 8 * (cl & 3); float o[8];
#pragma unroll
            for (int j = 0; j < 8; ++j) { const float other = __shfl_xor(x[j], 4); const float cs = rp[j], sn = rp[32 + j];
                o[j] = (cl >= 4) ? other * sn + x[j] * cs : x[j] * cs - other * sn; }
            if (F.lane < 8) { *(f32x4*)(kr + (size_t)row * 64 + 8 * cl) = (f32x4){o[0], o[1], o[2], o[3]}; *(f32x4*)(kr + (size_t)row * 64 + 8 * cl + 4) = (f32x4){o[4], o[5], o[6], o[7]}; }
            { const float rq = rsqrtf(sq * (1.f / QLR) + EPS), rk = rsqrtf(sk * (1.f / KVLR) + EPS);
              u32x4 na, nb, nk;
#pragma unroll
              for (int j = 0; j < 4; ++j) { na[j] = cvt_pk_bf16(bf_lo(a[j]) * rq, bf_hi(a[j]) * rq); nb[j] = cvt_pk_bf16(bf_lo(b[j]) * rq, bf_hi(b[j]) * rq); nk[j] = cvt_pk_bf16(bf_lo(k[j]) * rk, bf_hi(k[j]) * rk); }
              bf16_t* pw = (bf16_t*)p; *(u32x4*)(pw + POOLW + 8 * F.lane) = na; *(u32x4*)(pw + POOLW + 512 + 8 * F.lane) = nb; *(u32x4*)(pw + POOLW + QLR + 8 * F.lane) = nk; }
            if (F.lane == 0) ssqpe[row] = sp; }
    }
}

__device__ __forceinline__ void s7_route(Frame& F) {
    const bf16_t* H1HI = WSP(bf16_t, WS_H1HI); const bf16_t* H1LO = WSP(bf16_t, WS_H1LO); const bf16_t* WHI = WSP(bf16_t, WS_WRT); const bf16_t* WLO = WHI + 96 * DM;
    const float* SSQ2 = WSP(float, WS_SSQ2); float* RSTD2 = WSP(float, WS_SMALL + SM_RSTD2);
    int* ETOK = WSP(int, WS_SMALL + SM_ETOK); int* RANK = WSP(int, WS_SMALL + SM_RANK); float* GTOK = WSP(float, WS_SMALL + SM_GTOK);
    LAS float* red = (LAS float*)F.lds;
    LAS int* cntl = (LAS int*)(F.lds + 4 * 64 * 97 * 4);
    const int lane = F.lane, r32 = lane & 31, hi = lane >> 5, rh = F.wave & 1, kq = F.wave >> 1;
    for (int u = F.vcu; u < NREAL / 64; u += F.G) {
        const int t0 = u * 64;
        if (F.tid < 128) cntl[F.tid] = 0;
        f32x16 acc[3] = {};
        const bf16_t* ah = H1HI + (size_t)(t0 + 32 * rh + r32) * DM + kq * 1024 + 8 * hi; const bf16_t* al = H1LO + (size_t)(t0 + 32 * rh + r32) * DM + kq * 1024 + 8 * hi;
        const bf16_t* bh = WHI + (size_t)r32 * DM + kq * 1024 + 8 * hi; const bf16_t* bl = WLO + (size_t)r32 * DM + kq * 1024 + 8 * hi;
#pragma unroll 8
        for (int ks = 0; ks < 64; ++ks) {
            const bf16x8 a_h = *(const bf16x8*)(ah + 16 * ks), a_l = *(const bf16x8*)(al + 16 * ks);
#pragma unroll
            for (int c = 0; c < 3; ++c) { const bf16x8 b_h = *(const bf16x8*)(bh + (size_t)c * 32 * DM + 16 * ks), b_l = *(const bf16x8*)(bl + (size_t)c * 32 * DM + 16 * ks);
                acc[c] = __builtin_amdgcn_mfma_f32_32x32x16_bf16(a_h, b_h, acc[c], 0, 0, 0);
                acc[c] = __builtin_amdgcn_mfma_f32_32x32x16_bf16(a_l, b_h, acc[c], 0, 0, 0);
                acc[c] = __builtin_amdgcn_mfma_f32_32x32x16_bf16(a_h, b_l, acc[c], 0, 0, 0); }
        }
#pragma unroll
        for (int c = 0; c < 3; ++c)
#pragma unroll
            for (int r = 0; r < 16; ++r) red[(kq * 64 + 32 * rh + att::crow(r, hi)) * 97 + 32 * c + r32] = acc[c][r];
        __syncthreads();
        int e0 = 0, e1 = 0, lr0 = 0, lr1 = 0; float g0 = 0.f, g1 = 0.f;
        if (F.tid < 64) {
            const int tt = F.tid, t = t0 + tt; float sq = 0.f;
            for (int j = 0; j < 64; ++j) sq += SSQ2[(size_t)t * 64 + j];
            const float rs = rsqrtf(sq * (1.f / DM) + EPS); RSTD2[t] = rs;
            LAS float* lg = red + tt * 97;
            for (int j = 0; j < 72; ++j) { const float v = (red[(0 * 64 + tt) * 97 + j] + red[(1 * 64 + tt) * 97 + j]) + (red[(2 * 64 + tt) * 97 + j] + red[(3 * 64 + tt) * 97 + j]);
                lg[j] = v * rs + (j < 8 ? F.in[IN_BGROUP][j] : F.in[IN_BEXP][j - 8]); }
            int gi = 0; float gm = lg[0];
            for (int j = 1; j < 8; ++j) { const float v = lg[j]; if (v > gm) { gm = v; gi = j; } }
            float den = 0.f; for (int j = 0; j < 8; ++j) den += __expf(lg[j] - gm);
            const float gp = 1.f / den;
            const LAS float* el = lg + 8 + gi * 8;
            int i0 = 0; float m0 = el[0];
            for (int j = 1; j < 8; ++j) { const float v = el[j]; if (v > m0) { m0 = v; i0 = j; } }
            int i1 = -1; float m1 = -__builtin_inff();
            for (int j = 0; j < 8; ++j) { const float v = el[j]; if (j != i0 && v > m1) { m1 = v; i1 = j; } }
            const float w1 = 1.f / (1.f + __expf(m0 - m1)), w0 = 1.f - w1;
            e0 = gi * 8 + i0; e1 = gi * 8 + i1; g0 = gp * w0; g1 = gp * w1;
            lr0 = __hip_atomic_fetch_add(cntl + e0, 1, __ATOMIC_RELAXED, __HIP_MEMORY_SCOPE_WORKGROUP); lr1 = __hip_atomic_fetch_add(cntl + e1, 1, __ATOMIC_RELAXED, __HIP_MEMORY_SCOPE_WORKGROUP);
        }
        __syncthreads();
        if (F.tid < 64) { const int n = cntl[F.tid]; cntl[64 + F.tid] = n > 0 ? (int)__hip_atomic_fetch_add(F.ctl + CW_CNT + F.tid, (unsigned)n, RLX_AGENT) : 0; }
        __syncthreads();
        if (F.tid < 64) { const int t = t0 + F.tid;
            ETOK[2 * t] = e0; ETOK[2 * t + 1] = e1; RANK[2 * t] = cntl[64 + e0] + lr0; RANK[2 * t + 1] = cntl[64 + e1] + lr1; GTOK[2 * t] = g0; GTOK[2 * t + 1] = g1; }
        __syncthreads();
    }
}
__device__ __forceinline__ void moe_tables(Frame& F) {
    __syncthreads();
    if (F.tid == 0) { unsigned a = 0;
        for (int e = 0; e < NE; ++e) { F.MISC[64 + e] = a; a += (__hip_atomic_load(F.ctl + CW_CNT + e, RLX_AGENT) + 255u) >> 8; }
        F.MISC[128] = a; }
    __syncthreads();
}
__device__ __forceinline__ void s7c_slots(Frame& F) {
    const int* ETOK = WSP(int, WS_SMALL + SM_ETOK); const int* RANK = WSP(int, WS_SMALL + SM_RANK); const float* GTOK = WSP(float, WS_SMALL + SM_GTOK); int* SLOT = WSP(int, WS_SMALL + SM_SLOT);
    moe_tables(F);
    for (int u = F.vcu; u < NREAL / 64; u += F.G) {
        if (F.tid < 128) { const int i = 2 * (u * 64) + F.tid; const int e = ETOK[i]; const int slot = (int)F.MISC[64 + e] * 256 + RANK[i];
            F.ctl[CW_TOKSLOT + slot] = (unsigned)(i >> 1); ((float*)F.ctl)[CW_GATESLOT + slot] = GTOK[i]; SLOT[i] = slot; }
    }
}
__device__ __forceinline__ void s10_combine(Frame& F) {
    int lane = __builtin_amdgcn_mbcnt_hi(~0u, __builtin_amdgcn_mbcnt_lo(~0u, 0u)); const int gw = F.vcu * NWAVES + F.wave, NGW = F.G * NWAVES;
    const bf16_t* H1HI = WSP(bf16_t, WS_H1HI); const bf16_t* H1LO = WSP(bf16_t, WS_H1LO); const bf16_t* Y = WSP(bf16_t, WS_Y); const int* SLOT = WSP(int, WS_SMALL + SM_SLOT);
    for (int t = gw; t < NREAL; t += NGW) {
        const int s0 = SLOT[2 * t], s1 = SLOT[2 * t + 1];
#pragma unroll 4
        for (int j = 0; j < 8; ++j) { const int col = (j * 64 + lane) * 8;
            const u32x4 a = *(const u32x4*)(H1HI + (size_t)t * DM + col), b = {0u, 0u, 0u, 0u}, y0 = *(const u32x4*)(Y + (size_t)s0 * DM + col), y1 = *(const u32x4*)(Y + (size_t)s1 * DM + col);
            f32x4 o0, o1;
#pragma unroll
            for (int q = 0; q < 2; ++q) { o0[2 * q] = (bf_lo(a[q]) + bf_lo(b[q])) + bf_lo(y0[q]) + bf_lo(y1[q]); o0[2 * q + 1] = (bf_hi(a[q]) + bf_hi(b[q])) + bf_hi(y0[q]) + bf_hi(y1[q]);
                o1[2 * q] = (bf_lo(a[2 + q]) + bf_lo(b[2 + q])) + bf_lo(y0[2 + q]) + bf_lo(y1[2 + q]); o1[2 * q + 1] = (bf_hi(a[2 + q]) + bf_hi(b[2 + q])) + bf_hi(y0[2 + q]) + bf_hi(y1[2 + q]); }
            *(f32x4*)(F.out + (size_t)t * DM + col) = o0; *(f32x4*)(F.out + (size_t)t * DM + col + 4) = o1; }
    }
}

struct FV { unsigned char* ws; unsigned* ctl; volatile LAS unsigned* MISC; int G, vcu; };
struct SchedS1 {
    static constexpr bool GATHER = false; FV f;
    __device__ __forceinline__ bool next(int i, pg8::GUnit& u) const {
        const int L = i * f.G + (int)blockIdx.x; if (L >= 65 * 11) return false;
        int pm, pn; pg8::tile_of(L, 65, 11, pm, pn);
        u.A = (const char*)(f.ws + WS_XB) + (size_t)pm * 256 * DM * 2; u.lda = DM * 2; u.B = (const char*)(f.ws + WS_WIN) + (size_t)pn * 256 * DM * 2; u.ldb = DM * 2; u.nk = DM / 64; u.gather = nullptr;
        u.C = (char*)(f.ws + WS_PROJ) + ((size_t)pm * 256 * INCP + pn * 256) * 2; u.ldc = INCP * 2; u.rs = nullptr; u.i0 = 0; u.i1 = 0; return true; }
};
struct SchedS3 {
    static constexpr bool GATHER = false; FV f;
    __device__ __forceinline__ bool next(int i, pg8::GUnit& u) const {
        const int c = (int)blockIdx.x, G = f.G; int pm, pn; u.gather = nullptr; u.i0 = 0; u.i1 = 0;
        const int nq = c < 64 * 18 ? (64 * 18 - c + G - 1) / G : 0, nkv = c < 65 * 24 ? (65 * 24 - c + G - 1) / G : 0, np = c < 65 * 4 ? (65 * 4 - c + G - 1) / G : 0;
        const int m = nq < nkv ? nq : nkv; int type, j;
        if (i < 2 * m) { j = i >> 1; type = (i & 1) ^ ((c >> 3) & 1); }
        else { int r = i - 2 * m; if (r < nq - m) { type = 0; j = m + r; } else { r -= nq - m; if (r < nkv - m) { type = 1; j = m + r; } else { r -= nkv - m; if (r < np) { type = 2; j = r; } else return false; } } }
        int L = j * G + c + (type == 1 ? 64 * 18 : type == 2 ? 64 * 18 + 65 * 24 : 0);
        if (L < 64 * 18) { pg8::tile_of(L, 64, 18, pm, pn); const int b = pm >> 5, r0 = b * LSEQ + NMETA + (pm & 31) * 256;
            u.A = (const char*)(f.ws + WS_PROJ) + ((size_t)r0 * INCP + POOLW) * 2; u.lda = INCP * 2; u.B = (const char*)(f.ws + WS_WUQ) + (size_t)pn * 256 * QLR * 2; u.ldb = QLR * 2; u.nk = QLR / 64;
            u.C = (char*)(f.ws + WS_Q) + ((size_t)pm * 256 * QW + pn * 256) * 2; u.ldc = QW * 2; u.rs = nullptr; return true; }
        L -= 64 * 18;
        if (L < 65 * 24) { pg8::tile_of(L, 65, 24, pm, pn);
            u.A = (const char*)(f.ws + WS_PROJ) + ((size_t)pm * 256 * INCP + POOLW + QLR) * 2; u.lda = INCP * 2; u.B = (const char*)(f.ws + WS_WUKV) + (size_t)pn * 256 * KVLR * 2; u.ldb = KVLR * 2; u.nk = KVLR / 64;
            u.C = nullptr; u.ldc = 0; u.rs = nullptr; u.i0 = pm * 256; u.i1 = 256 + pn; return true; }
        L -= 65 * 24;
        if (L < 65 * 4) { pm = L >> 2; pn = L & 3;
            u.A = (const char*)(f.ws + WS_DIFF) + ((size_t)pm * 256 * POOLW + pn * 256) * 2; u.lda = POOLW * 2; u.B = (const char*)(f.ws + WS_WP) + (size_t)pn * 65536 * 2; u.ldb = 256 * 2; u.nk = 4;
            u.C = (char*)(f.ws + WS_MIX) + ((size_t)pm * 256 * DM + pn * 256) * 2; u.ldc = DM * 2; u.rs = nullptr; return true; }
        return false; }
};
struct SchedS6 {
    static constexpr bool GATHER = false; FV f;
    __device__ __forceinline__ bool next(int i, pg8::GUnit& u) const {
        const int L = i * f.G + (int)blockIdx.x; if (L >= 64 * 16) return false;
        int pm, pn; pg8::tile_of(L, 64, 16, pm, pn); const int b = pm >> 5, r0 = b * LSEQ + NMETA + (pm & 31) * 256;
        u.A = (const char*)(f.ws + WS_MIX) + (size_t)r0 * DM * 2; u.lda = DM * 2; u.B = (const char*)(f.ws + WS_WO) + (size_t)pn * 256 * DM * 2; u.ldb = DM * 2; u.nk = DM / 64; u.gather = nullptr;
        u.C = nullptr; u.ldc = 0; u.rs = nullptr; u.i0 = pm * 256; u.i1 = pn; return true; }
};
__device__ __forceinline__ int expert_of_tile(const FV& f, int g) {
    int e = 0;
#pragma unroll
    for (int s = 32; s > 0; s >>= 1) { const int c = e + s; if ((int)f.MISC[64 + c] <= g) e = c; }
    return e;
}
struct SchedS8 {
    static constexpr bool GATHER = true; FV f;
    __device__ __forceinline__ bool next(int i, pg8::GUnit& u) const {
        const int L = i * f.G + f.vcu; const int nrt = (int)f.MISC[128]; if (L >= nrt * 4) return false;
        const int g = L >> 2, ct = L & 3, e = expert_of_tile(f, g);
        u.A = (const char*)(f.ws + WS_H1HI); u.lda = DM * 2; u.gather = (const int*)(f.ctl + CW_TOKSLOT) + g * 256;
        u.B = (const char*)(f.ws + WS_WGU) + ((size_t)e * 1024 + ct * 256) * DM * 2; u.ldb = DM * 2; u.nk = DM / 64;
        u.C = (char*)(f.ws + WS_HID) + ((size_t)g * 256 * DE + ct * 128) * 2; u.ldc = DE * 2; u.rs = nullptr; u.i0 = g * 256; u.i1 = 0; return true; }
};
struct SchedS9 {
    static constexpr bool GATHER = false; FV f;
    __device__ __forceinline__ bool next(int i, pg8::GUnit& u) const {
        const int L = i * f.G + f.vcu; const int nrt = (int)f.MISC[128]; if (L >= nrt * 16) return false;
        const int g = L >> 4, ct = L & 15, e = expert_of_tile(f, g);
        u.A = (const char*)(f.ws + WS_HID) + (size_t)g * 256 * DE * 2; u.lda = DE * 2; u.gather = nullptr;
        u.B = (const char*)(f.ws + WS_WD) + ((size_t)e * DM + ct * 256) * DE * 2; u.ldb = DE * 2; u.nk = DE / 64;
        u.C = (char*)(f.ws + WS_Y) + ((size_t)g * 256 * DM + ct * 256) * 2; u.ldc = DM * 2; u.rs = nullptr; u.i0 = 0; u.i1 = 0; return true; }
};

struct Args { const float* in[21]; float* out; unsigned char* ws; int ph_lo, ph_hi, li, pad; };
constexpr int N_PHASES = 12;
__global__ void __launch_bounds__(NWAVES * 64, 2) mk_fwd(Args args) {
    extern __shared__ __attribute__((aligned(16))) unsigned char lds_raw[];
    Frame F;
    F.lds = (LAS unsigned char*)lds_raw;
    F.MISC = (volatile LAS unsigned*)(F.lds + MISC_OFF);
    F.tid = threadIdx.x; F.lane = F.tid & 63; F.wave = __builtin_amdgcn_readfirstlane(F.tid >> 6);
    F.G = gridDim.x; { const int bx = blockIdx.x; F.vcu = (F.G % 8 == 0) ? (bx % 8) * (F.G / 8) + bx / 8 : bx; }
    F.ws = args.ws; F.ctl = (unsigned*)(args.ws + WS_CTL); F.out = args.out;
#pragma unroll
    for (int i = 0; i < 21; ++i) F.in[i] = args.in[i];
    for (int u = F.tid; u < 512; u += NWAVES * 64) ((LAS unsigned*)(F.lds + MISC_OFF))[u] = 0u;
    __syncthreads();
    XcdBarrier bar = xcd_barrier_post((unsigned*)(F.ctl + CW_BAR) + args.li * XCD_BAR_WORDS, F.MISC + 8);
    const int lo = args.ph_lo, hi = args.ph_hi;
    const FV fv{F.ws, F.ctl, F.MISC, F.G, F.vcu};
#ifdef ONLY_PHASE
#define IN(k) ((k) == ONLY_PHASE)
#else
#define IN(k) (lo <= (k) && (k) < hi)
#endif
#define SEAM(k) do { if (IN(k) && IN((k) + 1)) xcd_barrier(bar); } while (0)
#ifndef DBL_PHASE
#define DBL_PHASE -1
#endif
#define REP(k) for (int rep_ = 0; rep_ < ((k) == DBL_PHASE ? 2 : 1); ++rep_)
    if (IN(0)) REP(0) { p0_prologue(F); } SEAM(0);
    if (IN(1)) REP(1) { SchedS1 S{fv}; pg8::EpiScaleBf16L E; pg8::gemm_phase(F.lds, S, E); } SEAM(1);
    if (IN(2)) REP(2) { s2_phase(F); } SEAM(2);
    if (IN(3)) REP(3) { SchedS3 S{fv}; pg8::EpiS3 E{WSP(float, WS_SMALL + SM_RSTDKV), WSP(float, WS_SMALL + SM_SSQPE), WSP(float, WS_KR), F.in[IN_KHG], WSP(bf16_t, WS_KF), WSP(bf16_t, WS_VB), (LAS float*)(F.lds + PTAB_OFF)}; pg8::gemm_phase(F.lds, S, E); }
    if (IN(3) && IN(5)) xcd_barrier(bar);
    if (IN(5)) REP(5) {
        const bf16_t* Q = WSP(bf16_t, WS_Q); const bf16_t* KF = WSP(bf16_t, WS_KF); const bf16_t* KV = WSP(bf16_t, WS_VB); bf16_t* MIX = WSP(bf16_t, WS_MIX); const float* gq = F.in[IN_QHG]; const float* rope = WSP(float, WS_ROPE);
        att::ConvCtx cv; cv.ci = 0; cv.cd = 0; cv.bi = 0; cv.bd = 0; cv.base_it = F.vcu; cv.stride = F.G; cv.n = (TI_EXP - F.vcu + F.G - 1) / F.G;
        cv.wg = F.in[IN_WGATE]; cv.wu = F.in[IN_WUP]; cv.wd = F.in[IN_WDOWN]; cv.fg = F.in[IN_FFNG]; cv.WGU = WSP(bf16_t, WS_WGU); cv.WDn = WSP(bf16_t, WS_WD);
        if (rep_ > 0) cv.n = 0;
        for (int it = F.vcu; it < 768; it += F.G) { const int bh = it >> 4, s = it & 15;
            att::attn_unit(bh / NH, bh % NH, 31 - s, Q, KF, KV, MIX, gq, rope, cv, (LAS char*)F.lds);
            att::attn_unit(bh / NH, bh % NH, s, Q, KF, KV, MIX, gq, rope, cv, (LAS char*)F.lds); }
        while (cv.ci < cv.n) { const unsigned lds0 = (unsigned)(uintptr_t)(LAS char*)F.lds;
            att::conv_proc_step(cv, (LAS char*)F.lds, F.wave, F.lane); (void)att::conv_dma_step(cv, lds0, F.wave, F.lane);
            asm volatile("s_waitcnt vmcnt(0) lgkmcnt(0)\n\ts_barrier" ::: "memory"); }
    } SEAM(5);
    if (IN(6)) REP(6) { SchedS6 S{fv}; pg8::EpiWout E{F.in[IN_X], WSP(bf16_t, WS_H1HI), WSP(bf16_t, WS_H1LO), WSP(float, WS_SSQ2)}; pg8::gemm_phase(F.lds, S, E); } SEAM(6);
    if (IN(7)) { s7_route(F); } SEAM(7);
    if (IN(8)) { s7c_slots(F); } SEAM(8);
    if (IN(9)) REP(9) { moe_tables(F); SchedS8 S{fv}; pg8::EpiMoe1 E{WSP(float, WS_SMALL + SM_RSTD2), (const float*)(F.ctl + CW_GATESLOT)}; pg8::gemm_phase(F.lds, S, E); } SEAM(9);
    if (IN(10)) REP(10) { moe_tables(F); SchedS9 S{fv};
        { pg8::EpiScaleBf16L E; pg8::gemm_phase(F.lds, S, E); } } SEAM(10);
    if (IN(11)) REP(11) { s10_combine(F); }
#undef IN
#undef SEAM
}

extern "C" void kernel_launch(void* const* d_in, const int* in_sizes, int n_in, void* d_out, int out_size, void* d_ws, size_t ws_size, hipStream_t stream) {
    static int grid = 0;
    if (grid == 0) {
        if (n_in != 21 || out_size != NREAL * DM || ws_size < WS_END) { fprintf(stderr, "kernel_launch: unexpected shapes (n_in %d out %d ws %zu)\n", n_in, out_size, ws_size); grid = -1; return; }
        int dev = 0, cus = 0, per_cu = 0;
        if (hipGetDevice(&dev) != hipSuccess || hipDeviceGetAttribute(&cus, hipDeviceAttributeMultiprocessorCount, dev) != hipSuccess) { grid = -1; return; }
        if (hipFuncSetAttribute((const void*)mk_fwd, hipFuncAttributeMaxDynamicSharedMemorySize, LDS_BYTES) != hipSuccess) { fprintf(stderr, "kernel_launch: hipFuncSetAttribute failed\n"); grid = -1; return; }
        if (hipOccupancyMaxActiveBlocksPerMultiprocessor(&per_cu, (const void*)mk_fwd, NWAVES * 64, LDS_BYTES) != hipSuccess || per_cu < 1) fprintf(stderr, "kernel_launch: occupancy query says %d\n", per_cu);
        (void)hipGetLastError();
        grid = cus;
    }
    if (grid < 0) return;
    (void)hipMemsetAsync((char*)d_ws + WS_CTL, 0, CTL_ZERO_BYTES, stream);
    Args a{};
    for (int i = 0; i < 21; ++i) a.in[i] = (const float*)d_in[i];
    a.out = (float*)d_out; a.ws = (unsigned char*)d_ws; a.ph_lo = 0; a.ph_hi = N_PHASES; a.li = 0; a.pad = 0;
    hipLaunchKernelGGL(mk_fwd, dim3(grid), dim3(NWAVES * 64), LDS_BYTES, stream, a);
}
```

```cpp
#include <hip/hip_runtime.h>
#include <hip/hip_bf16.h>
#include <cstdio>
#include <cstdint>

#define LAS __attribute__((address_space(3)))
#define GAS __attribute__((address_space(1)))
typedef unsigned short bf16_t;
typedef short bf16x8 __attribute__((ext_vector_type(8)));
typedef short s16x4 __attribute__((ext_vector_type(4)));
typedef float f32x4 __attribute__((ext_vector_type(4)));
typedef float f32x2 __attribute__((ext_vector_type(2)));
typedef float f32x16 __attribute__((ext_vector_type(16)));
typedef unsigned u32x4 __attribute__((ext_vector_type(4)));
typedef unsigned u32x2 __attribute__((ext_vector_type(2)));

constexpr int DM = 4096, NB = 2, SEQ = 8192, NMETA = 16, LSEQ = SEQ + NMETA  , NTOK = NB * LSEQ  , NREAL = NB * SEQ  ;
constexpr int MPAD = 16640;
constexpr int POOLW = 1024, QLR = 1024, KVLR = 512, ROPE = 64, INC = 2624, INCP = 2816;
constexpr int NH = 24, DQK = 192, DNOPE = 128, DV = 128, QW = NH * DQK  , KVW = NH * 256  ;
constexpr int NG = 8, NE = 64, DE = 512;
constexpr int NSLOT = 49152;
constexpr float EPS = 1e-6f;
constexpr float QSCALE = 0.07216878364870322f * 1.4426950408889634f;

constexpr size_t MiB = 1u << 20;
constexpr size_t WS_CTL = 0, CTL_ZERO_BYTES = 1 * MiB;
constexpr size_t WS_WIN = 1 * MiB;
constexpr size_t WS_WUQ = 23 * MiB;
constexpr size_t WS_WUKV = 32 * MiB;
constexpr size_t WS_WP = 38 * MiB;
constexpr size_t WS_WRT = 38 * MiB + 512 * 1024;
constexpr size_t WS_WO = 40 * MiB;
constexpr size_t WS_WGU = 72 * MiB;
constexpr size_t WS_WD = 584 * MiB;
constexpr size_t WS_ROPE = 840 * MiB;
constexpr size_t WS_SMALL = 843 * MiB;
constexpr size_t WS_XB = 846 * MiB;
constexpr size_t WS_PROJ = 976 * MiB;
constexpr size_t WS_DIFF = 1066 * MiB;
constexpr size_t WS_Q = 1099 * MiB;
constexpr size_t WS_KV = 1243 * MiB;
constexpr size_t WS_KF = 1438 * MiB;
constexpr size_t WS_MIX = 1585 * MiB;
constexpr size_t WS_VB = 1715 * MiB;
constexpr size_t WS_KR = 1813 * MiB;
constexpr size_t WS_END = 1818 * MiB;
constexpr size_t WS_H1HI = 846 * MiB;
constexpr size_t WS_H1LO = 974 * MiB;
constexpr size_t WS_SSQ2 = 1102 * MiB;
constexpr size_t WS_HID = 1106 * MiB;
constexpr size_t WS_Y = 1154 * MiB;
constexpr size_t SM_RSTD1 = 0, SM_RSTDQ = 128 * 1024, SM_RSTDKV = 256 * 1024, SM_RSTD2 = 384 * 1024, SM_ETOK = 512 * 1024, SM_RANK = 640 * 1024, SM_GTOK = 768 * 1024, SM_SLOT = 896 * 1024, SM_SSQPE = 1024 * 1024;
constexpr int CW_TMO = 0, CW_BAR = 4096, CW_CNT = 8192, CW_TOKSLOT = 16384, CW_GATESLOT = 65536;
static_assert((CW_GATESLOT + NSLOT) * 4 <= (int)CTL_ZERO_BYTES, "CTL");

constexpr int RING_BYTES = 131072;
constexpr int PTAB_OFF = 133120;
constexpr int CONV_OFF = 124928;
constexpr int MISC_OFF = 157696;
constexpr int LDS_BYTES = 159744;

#define RLX_AGENT __ATOMIC_RELAXED, __HIP_MEMORY_SCOPE_AGENT
#define LDS_WAIT() asm volatile("s_waitcnt lgkmcnt(0)" ::: "memory")
#define VM_WAIT() asm volatile("s_waitcnt vmcnt(0)" ::: "memory")

__device__ __forceinline__ unsigned cvt_pk_bf16(float lo, float hi) { unsigned r; asm volatile("v_cvt_pk_bf16_f32 %0, %1, %2" : "=v"(r) : "v"(lo), "v"(hi)); return r; }
__device__ __forceinline__ float bf_lo(unsigned w) { return __uint_as_float(w << 16); }
__device__ __forceinline__ float bf_hi(unsigned w) { return __uint_as_float(w & 0xffff0000u); }
__device__ __forceinline__ float wave_sum(float v) {
#pragma unroll
    for (int o = 1; o < 64; o <<= 1) v += __shfl_xor(v, o);
    return v;
}

#define XB_TMO      128
#define XB_XCNT(j)  (256  + 64 * (j))
#define XB_XSUB(j)  (1280 + 64 * (j))
#define XB_XGEN(j)  (2304 + 64 * (j))
#define XB_TOP      3328
#define XB_TOPGEN   3392
#define XCD_BAR_WORDS 3456
#define XB_SPIN_CAP (1u << 18)
__device__ __forceinline__ unsigned xb_ld(unsigned* p)              { return __hip_atomic_load(p, __ATOMIC_RELAXED, __HIP_MEMORY_SCOPE_AGENT); }
__device__ __forceinline__ unsigned xb_add(unsigned* p, unsigned v) { return __hip_atomic_fetch_add(p, v, __ATOMIC_RELAXED, __HIP_MEMORY_SCOPE_AGENT); }
__device__ __forceinline__ unsigned xb_xcc_id() { return (unsigned)__builtin_amdgcn_s_getreg((3 << 11) | 20) & 0xFu; }
#define XB_SPIN(cond, bar) do { unsigned _sp = 0; while (cond) { __builtin_amdgcn_s_sleep(1); \
    if ((++_sp & 255u) == 0u) { if (xb_ld(&(bar)[XB_TMO])) break; if (_sp > XB_SPIN_CAP) { atomicAdd(&(bar)[XB_TMO], 1u); break; } } } } while (0)
struct XcdBarrier { unsigned* bar; unsigned x; volatile LAS unsigned* st; };
__device__ __forceinline__ XcdBarrier xcd_barrier_post(unsigned* bar, volatile LAS unsigned* st) {
    XcdBarrier b; b.bar = bar; b.x = xb_xcc_id(); b.st = st;
    if (threadIdx.x == 0) (void)xb_add(&bar[XB_XCNT(b.x)], 1u);
    return b;
}
__device__ __forceinline__ void xcd_barrier_complete(unsigned* bar, unsigned x, unsigned& nloc, unsigned& nx) {
    const unsigned G = gridDim.x * gridDim.y * gridDim.z;
    unsigned sum, cnt, mine, sp = 0u;
    for (;;) {
        sum = 0u; cnt = 0u; mine = 0u;
#pragma unroll
        for (unsigned j = 0; j < 16; ++j) { const unsigned c = xb_ld(&bar[XB_XCNT(j)]); sum += c; cnt += (c > 0u) ? 1u : 0u; mine = (j == x) ? c : mine; }
        if (sum == G) break;
        __builtin_amdgcn_s_sleep(1);
        if ((++sp & 255u) == 0u) { if (xb_ld(&bar[XB_TMO])) break; if (sp > XB_SPIN_CAP) { atomicAdd(&bar[XB_TMO], 1u); break; } }
    }
    nloc = mine > 0u ? mine : 1u; nx = cnt > 0u ? cnt : 1u;
}
__device__ __forceinline__ void xcd_barrier(const XcdBarrier& b) {
    asm volatile("s_waitcnt vmcnt(0)" ::: "memory");
    __syncthreads();
    if (threadIdx.x == 0) {
        unsigned* bar = b.bar;
        __builtin_amdgcn_s_waitcnt(0);
        unsigned nloc = b.st[0], nx = b.st[1];
        if (nloc == 0u) { xcd_barrier_complete(bar, b.x, nloc, nx); b.st[0] = nloc; b.st[1] = nx; }
        const unsigned old = xb_add(&bar[XB_XSUB(b.x)], 1u);
        const unsigned gen = old / nloc;
        if (old + 1u == (gen + 1u) * nloc) {
            __builtin_amdgcn_fence(__ATOMIC_RELEASE, "agent");
            asm volatile("s_waitcnt vmcnt(0)" ::: "memory");
            const unsigned og = xb_add(&bar[XB_TOP], 1u);
            const unsigned tg = og / nx;
            if (og + 1u == (tg + 1u) * nx) xb_add(&bar[XB_TOPGEN], 1u);
            else XB_SPIN(xb_ld(&bar[XB_TOPGEN]) == tg, bar);
            __builtin_amdgcn_fence(__ATOMIC_ACQUIRE, "agent");
            xb_add(&bar[XB_XGEN(b.x)], 1u);
            asm volatile("s_waitcnt vmcnt(0)" ::: "memory");
        } else {
            XB_SPIN(xb_ld(&bar[XB_XGEN(b.x)]) == gen, bar);
            __builtin_amdgcn_fence(__ATOMIC_ACQUIRE, "agent");
            asm volatile("s_waitcnt vmcnt(0)" ::: "memory");
        }
    }
    __syncthreads();
}

namespace pg8 {
constexpr int BM = 256, BK = 64, HALF = 128, HTB = HALF * BK * 2, STAGE_BYTES = 8 * HTB, NXCD = 8, WGM = 8;
__host__ __device__ __forceinline__ int lds_byte(int r, int c) { const int st = (r >> 4) * 2 + (c >> 5), rr = r & 15, cc = c & 31, ob = rr * 64 + cc * 2; return st * 1024 + (ob ^ (((ob >> 9) & 1) << 5)); }
__host__ __device__ __forceinline__ void stage_rc(int b, int& R, int& C) { const int st = b / 1024, sb = b % 1024, swz = sb ^ (((sb >> 9) & 1) << 5); R = (st >> 1) * 16 + swz / 64; C = (st & 1) * 32 + (swz % 64) / 2; }
__host__ __device__ __forceinline__ int perm32(int rho) { const int n = rho >> 4, i = rho & 15; return 8 * (i >> 2) + 4 * n + (i & 3); }

__device__ __forceinline__ void tile_of(int L, int nM, int nN, int& pm, int& pn) {
    const int nwg = nM * nN; int wgid = L;
    { const int q = nwg / NXCD, r = nwg % NXCD, xcd = wgid % NXCD, off = wgid / NXCD; wgid = (xcd < r ? xcd * (q + 1) : r * (q + 1) + (xcd - r) * q) + off; }
    const int nig = WGM * nN, gid = wgid / nig, fm = gid * WGM, gsz = (nM - fm) < WGM ? (nM - fm) : WGM;
    pm = fm + ((wgid % nig) % gsz); pn = (wgid % nig) / gsz;
}

struct GUnit {
    const char* A;
    const char* B;
    unsigned lda, ldb;
    int nk;
    const int* gather;
    char* C; unsigned ldc;
    const float* rs;
    int i0, i1;
};

struct EpiScaleBf16 {
    static constexpr bool PERM = true, BMAP = false;
    __device__ __forceinline__ void operator()(const f32x4 (&acc)[2][2][4][2], const GUnit& u, int wr, int wc, int fr, int fq) const {
#pragma unroll
        for (int ai = 0; ai < 2; ++ai)
#pragma unroll
            for (int m = 0; m < 4; ++m) { const int r = ai * HALF + wr * 64 + m * 16 + fr; const float s = u.rs ? u.rs[r] : 1.f;
                char* rowp = u.C + (size_t)r * u.ldc + (wc * 32 + 8 * fq) * 2;
#pragma unroll
                for (int bj = 0; bj < 2; ++bj) { const f32x4 v0 = acc[ai][bj][m][0] * s, v1 = acc[ai][bj][m][1] * s;
                    u32x4 w; w.x = cvt_pk_bf16(v0[0], v0[1]); w.y = cvt_pk_bf16(v0[2], v0[3]); w.z = cvt_pk_bf16(v1[0], v1[1]); w.w = cvt_pk_bf16(v1[2], v1[3]);
                    *(u32x4*)(rowp + bj * HALF * 2) = w; } }
    }
};
struct EpiScaleBf16L {
    static constexpr bool PERM = true, BMAP = true;
    __device__ __forceinline__ void operator()(const f32x4 (&acc)[2][2][4][2], const GUnit& u, int wr, int wc, int fr, int fq) const {
#pragma unroll
        for (int ai = 0; ai < 2; ++ai) { if (ai == 1 && u.i1) break;
#pragma unroll
            for (int m = 0; m < 4; ++m) { const int r = ai * HALF + wr * 64 + m * 16 + fr;
                char* rowp = u.C + (size_t)r * u.ldc + (wc * 64 + 8 * fq) * 2;
#pragma unroll
                for (int bj = 0; bj < 2; ++bj) { const f32x4 v0 = acc[ai][bj][m][0], v1 = acc[ai][bj][m][1];
                    u32x4 w; w.x = cvt_pk_bf16(v0[0], v0[1]); w.y = cvt_pk_bf16(v0[2], v0[3]); w.z = cvt_pk_bf16(v1[0], v1[1]); w.w = cvt_pk_bf16(v1[2], v1[3]);
                    *(u32x4*)(rowp + bj * 64) = w; } } }
    }
};
struct EpiS3 {
    static constexpr bool PERM = true, BMAP = false;
    const float* rstdkv; const float* ssqpe; const float* kr; const float* gk; bf16_t* KF; bf16_t* VB; LAS float* P;
    __device__ __forceinline__ void operator()(const f32x4 (&acc)[2][2][4][2], const GUnit& u, int wr, int wc, int fr, int fq) const {
        if ((u.i1 >> 8) == 0) { EpiScaleBf16 e; e(acc, u, wr, wc, fr, fq); return; }
        const int h = u.i1 & 255; const size_t row0 = (size_t)u.i0;
#pragma unroll
        for (int ai = 0; ai < 2; ++ai)
#pragma unroll
            for (int m = 0; m < 4; ++m) { const int r = ai * HALF + wr * 64 + m * 16 + fr; float s = 0.f;
#pragma unroll
                for (int n = 0; n < 2; ++n) { const f32x4 v = acc[ai][0][m][n]; s += (v[0] * v[0] + v[1] * v[1]) + (v[2] * v[2] + v[3] * v[3]); }
                s += __shfl_xor(s, 16); s += __shfl_xor(s, 32);
                if (fq == 0) P[r * 4 + wc] = s; }
        asm volatile("s_waitcnt lgkmcnt(0)" ::: "memory"); __builtin_amdgcn_s_barrier(); asm volatile("" ::: "memory");
        const int c0 = wc * 32 + 8 * fq;
        const f32x4 g0 = *(const f32x4*)(gk + c0), g1 = *(const f32x4*)(gk + c0 + 4);
        float sp8[8];
#pragma unroll
        for (int g = 0; g < 8; ++g) sp8[g] = ssqpe[row0 + (g >> 2) * HALF + wr * 64 + (g & 3) * 16 + fr];
        const int tid2 = (wr * 4 + wc) * 64 + fq * 16 + fr, rr2 = tid2 >> 1, hf2 = tid2 & 1;
        const float spr = ssqpe[row0 + rr2]; f32x4 krv[8];
        { const float* src = kr + (row0 + rr2) * 64 + 32 * hf2;
#pragma unroll
          for (int q = 0; q < 8; ++q) krv[q] = *(const f32x4*)(src + 4 * q); }
#pragma unroll
        for (int ai = 0; ai < 2; ++ai)
#pragma unroll
            for (int m = 0; m < 4; ++m) { const int r = ai * HALF + wr * 64 + m * 16 + fr; const float rs = 1.f;
                const f32x4 pp = *(const LAS f32x4*)(P + r * 4);
                const float rh = rsqrtf((((pp[0] + pp[1]) + (pp[2] + pp[3])) * rs * rs + sp8[ai * 4 + m]) * (1.f / DQK) + EPS);
                const float a = rs * rh; const f32x4 k0 = acc[ai][0][m][0] * a * g0, k1 = acc[ai][0][m][1] * a * g1, v0 = acc[ai][1][m][0] * rs, v1 = acc[ai][1][m][1] * rs;
                u32x4 w; w.x = cvt_pk_bf16(k0[0], k0[1]); w.y = cvt_pk_bf16(k0[2], k0[3]); w.z = cvt_pk_bf16(k1[0], k1[1]); w.w = cvt_pk_bf16(k1[2], k1[3]);
                *(u32x4*)(KF + (row0 + r) * QW + h * DQK + c0) = w;
                w.x = cvt_pk_bf16(v0[0], v0[1]); w.y = cvt_pk_bf16(v0[2], v0[3]); w.z = cvt_pk_bf16(v1[0], v1[1]); w.w = cvt_pk_bf16(v1[2], v1[3]);
                *(u32x4*)(VB + (row0 + r) * (NH * DV) + h * DV + c0) = w; }
        { const f32x4 pp = *(const LAS f32x4*)(P + rr2 * 4);
          const float rh = rsqrtf((((pp[0] + pp[1]) + (pp[2] + pp[3])) + spr) * (1.f / DQK) + EPS);
          bf16_t* dst = KF + (row0 + rr2) * QW + h * DQK + DNOPE + 32 * hf2;
#pragma unroll
          for (int q = 0; q < 4; ++q) { const f32x4 a = krv[2 * q] * rh, b = krv[2 * q + 1] * rh;
              u32x4 w; w.x = cvt_pk_bf16(a[0], a[1]); w.y = cvt_pk_bf16(a[2], a[3]); w.z = cvt_pk_bf16(b[0], b[1]); w.w = cvt_pk_bf16(b[2], b[3]);
              *(u32x4*)(dst + 8 * q) = w; } }
    }
};
struct EpiNone { static constexpr bool PERM = true, BMAP = false; __device__ __forceinline__ void operator()(const f32x4 (&acc)[2][2][4][2], const GUnit& u, int wr, int wc, int fr, int fq) const { float x = acc[0][0][0][0][0] + acc[1][1][3][1][3]; asm volatile("" :: "v"(x)); } };
struct EpiProbeA {
    static constexpr bool PERM = true, BMAP = true; char* scr;
    __device__ __forceinline__ void operator()(const f32x4 (&acc)[2][2][4][2], const GUnit& u, int wr, int wc, int fr, int fq) const {
        GUnit v = u; v.C = scr + (size_t)blockIdx.x * 131072; v.ldc = 512; EpiScaleBf16L e; e(acc, v, wr, wc, fr, fq); }
};
struct EpiWout {
    static constexpr bool PERM = true, BMAP = false;
    const float* x; bf16_t* hi; bf16_t* lo; float* ssq;
    __device__ __forceinline__ void operator()(const f32x4 (&acc)[2][2][4][2], const GUnit& u, int wr, int wc, int fr, int fq) const {
        const int c0 = u.i1 * BM + wc * 32 + 8 * fq;
        const size_t rbase = (size_t)u.i0 + wr * 64 + fr;
        f32x4 xa[4], xb[4];
#define EW_LOAD(X_, g_) do { const size_t off_ = (rbase + ((g_) >> 2) * HALF + ((g_) & 3) * 16) * DM + c0; \
            X_[0] = *(const f32x4*)(x + off_); X_[1] = *(const f32x4*)(x + off_ + 4); X_[2] = *(const f32x4*)(x + off_ + HALF); X_[3] = *(const f32x4*)(x + off_ + HALF + 4); } while (0)
#define EW_PROC(X_, g_) do { const int ai_ = (g_) >> 2, m_ = (g_) & 3; const size_t row_ = rbase + ai_ * HALF + m_ * 16; float sq = 0.f; \
            _Pragma("unroll") for (int bj = 0; bj < 2; ++bj) { const size_t off = row_ * DM + c0 + bj * HALF; \
                const f32x4 v0 = acc[ai_][bj][m_][0] + X_[2 * bj], v1 = acc[ai_][bj][m_][1] + X_[2 * bj + 1]; \
                sq += (v0[0] * v0[0] + v0[1] * v0[1]) + (v0[2] * v0[2] + v0[3] * v0[3]) + (v1[0] * v1[0] + v1[1] * v1[1]) + (v1[2] * v1[2] + v1[3] * v1[3]); \
                u32x4 w; w.x = cvt_pk_bf16(v0[0], v0[1]); w.y = cvt_pk_bf16(v0[2], v0[3]); w.z = cvt_pk_bf16(v1[0], v1[1]); w.w = cvt_pk_bf16(v1[2], v1[3]); \
                *(u32x4*)(hi + off) = w; } \
            sq += __shfl_xor(sq, 16); sq += __shfl_xor(sq, 32); \
            if (fq == 0) ssq[row_ * 64 + u.i1 * 4 + wc] = sq; } while (0)
        EW_LOAD(xa, 0); EW_LOAD(xb, 1);
        EW_PROC(xa, 0); EW_LOAD(xa, 2); EW_PROC(xb, 1); EW_LOAD(xb, 3);
        EW_PROC(xa, 2); EW_LOAD(xa, 4); EW_PROC(xb, 3); EW_LOAD(xb, 5);
        EW_PROC(xa, 4); EW_LOAD(xa, 6); EW_PROC(xb, 5); EW_LOAD(xb, 7);
        EW_PROC(xa, 6); EW_PROC(xb, 7);
#undef EW_LOAD
#undef EW_PROC
    }
};
struct EpiMoe1 {
    static constexpr bool PERM = true, BMAP = false;
    const float* rstd2; const float* gate;
    __device__ __forceinline__ void operator()(const f32x4 (&acc)[2][2][4][2], const GUnit& u, int wr, int wc, int fr, int fq) const {
        float sc[8], gt[8];
#pragma unroll
        for (int g = 0; g < 8; ++g) { const int r = (g >> 2) * HALF + wr * 64 + (g & 3) * 16 + fr; sc[g] = __int_as_float(u.gather[r]); gt[g] = gate[u.i0 + r]; }
#pragma unroll
        for (int g = 0; g < 8; ++g) sc[g] = rstd2[__float_as_int(sc[g])];
#pragma unroll
        for (int ai = 0; ai < 2; ++ai) { if (ai == 1 && u.i1) break;
#pragma unroll
            for (int m = 0; m < 4; ++m) { const int r = ai * HALF + wr * 64 + m * 16 + fr; const float s = sc[ai * 4 + m], gg = gt[ai * 4 + m];
                float h[8];
#pragma unroll
                for (int n = 0; n < 2; ++n)
#pragma unroll
                    for (int j = 0; j < 4; ++j) { const float g = acc[ai][0][m][n][j] * s, up = acc[ai][1][m][n][j] * s;
                        h[n * 4 + j] = g * __builtin_amdgcn_rcpf(1.f + __builtin_amdgcn_exp2f(-1.4426950408889634f * g)) * up * gg; }
                u32x4 w; w.x = cvt_pk_bf16(h[0], h[1]); w.y = cvt_pk_bf16(h[2], h[3]); w.z = cvt_pk_bf16(h[4], h[5]); w.w = cvt_pk_bf16(h[6], h[7]);
                *(u32x4*)(u.C + (size_t)r * u.ldc + (wc * 32 + 8 * fq) * 2) = w; } }
    }
};

template <class Epi, class Sched>
__device__ __forceinline__ void gemm_phase(LAS unsigned char* lds, const Sched& S, const Epi& E) {
    const int tid = threadIdx.x, wid = __builtin_amdgcn_readfirstlane(tid >> 6), lane = tid & 63, wr = wid >> 2, wc = wid & 3, fr = lane & 15, fq = lane >> 4;
    const unsigned ldsw = (unsigned)wid * 1024u;
    const int aoff = lds_byte(wr * 64 + fr, fq * 8), boff = lds_byte(wc * 32 + fr, fq * 8);
#define PG8_SA(b, h) (((b) * 2 + (h)) * HTB)
#define PG8_SB(b, h) ((4 + (b) * 2 + (h)) * HTB)
#define PG8_STAGE(bufoff, gbase, voff) do { _Pragma("unroll") for (int _i = 0; _i < 2; ++_i) \
        __builtin_amdgcn_global_load_lds((const unsigned*)((const char*)(gbase) + (voff)[_i]), (LAS unsigned*)(lds + (bufoff) + ldsw + _i * 8192), 16, 0, 0); } while (0)
#define PG8_LDA(dst, b, h) do { _Pragma("unroll") for (int m = 0; m < 4; ++m) _Pragma("unroll") for (int k = 0; k < 2; ++k) dst[m][k] = *(const LAS bf16x8*)(lds + PG8_SA(b, h) + aoff + m * 2048 + k * 1024); } while (0)
#define PG8_LDB(dst, b, h) do { _Pragma("unroll") for (int n = 0; n < 2; ++n) _Pragma("unroll") for (int k = 0; k < 2; ++k) dst[n][k] = *(const LAS bf16x8*)(lds + PG8_SB(b, h) + boff + n * 2048 + k * 1024); } while (0)
#define PG8_MMA(ai, bj, At, Bt) do { __builtin_amdgcn_s_setprio(1); _Pragma("unroll") for (int m = 0; m < 4; ++m) _Pragma("unroll") for (int n = 0; n < 2; ++n) _Pragma("unroll") for (int k = 0; k < 2; ++k) \
        acc[ai][bj][m][n] = __builtin_amdgcn_mfma_f32_16x16x32_bf16(Bt[n][k], At[m][k], acc[ai][bj][m][n], 0, 0, 0); __builtin_amdgcn_s_setprio(0); } while (0)
#define PG8_WAIT_V(n) asm volatile("s_waitcnt vmcnt(" #n ")" ::: "memory")
#define PG8_WAIT_L(n) asm volatile("s_waitcnt lgkmcnt(" #n ")" ::: "memory")
#define PG8_BAR __builtin_amdgcn_s_barrier()
#define PG8_SCHED __builtin_amdgcn_sched_barrier(0)
#define PG8_OFFS(u, gi0, gi1) do { _Pragma("unroll") for (int _i = 0; _i < 2; ++_i) { int R_, C_; stage_rc(tid * 16 + _i * 8192, R_, C_); \
        const int Rb_ = Epi::BMAP ? (64 * (R_ >> 5) + perm32(R_ & 31)) : (Epi::PERM ? ((R_ & ~31) + perm32(R_ & 31)) : R_); int r0_ = R_, r1_ = HALF + R_; if (Sched::GATHER) { r0_ = gi0[_i]; r1_ = gi1[_i]; } \
        vA0[_i] = (unsigned)r0_ * (u).lda + (unsigned)C_ * 2u; vA1[_i] = (unsigned)r1_ * (u).lda + (unsigned)C_ * 2u; \
        vB[_i] = (unsigned)Rb_ * (u).ldb + (unsigned)C_ * 2u; } hsB = (unsigned)(Epi::BMAP ? 32 : HALF) * (u).ldb; } while (0)
#define PG8_GIDX(u, gi0, gi1) do { if (Sched::GATHER) { _Pragma("unroll") for (int _i = 0; _i < 2; ++_i) { int R_, C_; stage_rc(tid * 16 + _i * 8192, R_, C_); gi0[_i] = (u).gather[R_]; gi1[_i] = (u).gather[HALF + R_]; } } } while (0)
    GUnit cur, nxt; int ui = 0;
    if (!S.next(0, cur)) return;
    f32x4 acc[2][2][4][2];
#pragma unroll
    for (int a = 0; a < 2; ++a)
#pragma unroll
        for (int b = 0; b < 2; ++b)
#pragma unroll
            for (int m = 0; m < 4; ++m)
#pragma unroll
                for (int n = 0; n < 2; ++n) acc[a][b][m][n] = (f32x4){0.f, 0.f, 0.f, 0.f};
    bf16x8 At[4][2], B0[2][2], B1[2][2];
    unsigned vA0[2], vA1[2], vB[2]; unsigned hsB; int gi0[2] = {0, 0}, gi1[2] = {0, 0};
    PG8_GIDX(cur, gi0, gi1); PG8_OFFS(cur, gi0, gi1);
    const char* cA = cur.A; const char* cB = cur.B;
    const size_t kstep = (size_t)(BK * 2);
    PG8_STAGE(PG8_SB(0, 0), cB, vB); PG8_STAGE(PG8_SB(0, 1), cB + hsB, vB); PG8_STAGE(PG8_SA(0, 0), cA, vA0); PG8_STAGE(PG8_SA(0, 1), cA, vA1);
    if (wr == 1) PG8_BAR;
    PG8_WAIT_V(2); PG8_BAR;
    PG8_STAGE(PG8_SB(1, 0), cB + kstep, vB); PG8_STAGE(PG8_SA(1, 0), cA + kstep, vA0); PG8_STAGE(PG8_SB(1, 1), cB + hsB + kstep, vB);
    PG8_WAIT_V(6); PG8_BAR;
    for (;;) {
        const bool has_next = S.next(ui + 1, nxt);
        const char* nA = cA; const char* nBp = cB;
        if (has_next) { nA = nxt.A; nBp = nxt.B; PG8_GIDX(nxt, gi0, gi1); }
        const int nt = cur.nk;
        for (int t = 0; t < nt; t += 2) {
            const bool last = (t == nt - 2);
            const char* a1 = cA + (size_t)(t + 1) * kstep;
            const char* a2 = last ? nA : cA + (size_t)(t + 2) * kstep; const char* b2 = last ? nBp : cB + (size_t)(t + 2) * kstep;
            const char* a3 = a2 + kstep; const char* b3 = b2 + kstep;
            PG8_LDB(B0, 0, 0); PG8_LDB(B1, 0, 1); PG8_SCHED; PG8_LDA(At, 0, 0); PG8_STAGE(PG8_SA(1, 1), a1, vA1);
            if (last && has_next) { PG8_OFFS(nxt, gi0, gi1); }
            PG8_WAIT_V(8); PG8_WAIT_L(0); PG8_BAR; PG8_MMA(0, 0, At, B0); PG8_MMA(0, 1, At, B1); PG8_BAR; PG8_SCHED;
            PG8_LDA(At, 0, 1); PG8_STAGE(PG8_SB(0, 0), b2, vB); PG8_STAGE(PG8_SB(0, 1), b2 + hsB, vB); PG8_STAGE(PG8_SA(0, 0), a2, vA0);
            PG8_WAIT_V(8); PG8_WAIT_L(0); PG8_BAR; if (!Sched::HALF || !cur.i1) { PG8_MMA(1, 0, At, B0); PG8_MMA(1, 1, At, B1); } PG8_BAR; PG8_SCHED;
            PG8_LDB(B0, 1, 0); PG8_LDB(B1, 1, 1); PG8_SCHED; PG8_LDA(At, 1, 0); PG8_STAGE(PG8_SA(0, 1), a2, vA1);
            PG8_WAIT_V(8); PG8_WAIT_L(0); PG8_BAR; PG8_MMA(0, 0, At, B0); PG8_MMA(0, 1, At, B1); PG8_BAR; PG8_SCHED;
            PG8_LDA(At, 1, 1); PG8_STAGE(PG8_SB(1, 0), b3, vB); PG8_STAGE(PG8_SB(1, 1), b3 + hsB, vB); PG8_STAGE(PG8_SA(1, 0), a3, vA0);
            PG8_WAIT_V(8); PG8_WAIT_L(0); PG8_BAR; if (!Sched::HALF || !cur.i1) { PG8_MMA(1, 0, At, B0); PG8_MMA(1, 1, At, B1); } PG8_BAR; PG8_SCHED;
        }
        if (wr == 0) PG8_BAR;
        { int fr_ = fr, fq_ = fq; asm volatile("" : "+v"(fr_), "+v"(fq_)); E(acc, cur, wr, wc, fr_, fq_); }
        if (!has_next) break;
#pragma unroll
        for (int a = 0; a < 2; ++a)
#pragma unroll
            for (int b = 0; b < 2; ++b)
#pragma unroll
                for (int m = 0; m < 4; ++m)
#pragma unroll
                    for (int n = 0; n < 2; ++n) acc[a][b][m][n] = (f32x4){0.f, 0.f, 0.f, 0.f};
        cur = nxt; cA = nA; cB = nBp; ++ui;
        if (wr == 1) PG8_BAR;
    }
    PG8_WAIT_V(0);
    PG8_BAR;
#undef PG8_SA
#undef PG8_SB
#undef PG8_STAGE
#undef PG8_LDA
#undef PG8_LDB
#undef PG8_MMA
#undef PG8_WAIT_V
#undef PG8_WAIT_L
#undef PG8_BAR
#undef PG8_SCHED
#undef PG8_OFFS
#undef PG8_GIDX
}
}
namespace att {
constexpr int NW = 8, QBLK = 32, KVBLK = 64, QB = 256;
constexpr int KT_BYTES = 64 * 384, VT_BYTES = 64 * 256;
constexpr int LDS_K = 0, LDS_V = 3 * KT_BYTES, LDS_WS = LDS_V + 3 * VT_BYTES, LDS_TOTAL = LDS_WS + NW * 256;
static_assert(LDS_TOTAL == CONV_OFF, "LDS map");
constexpr unsigned KROW = QW * 2, VROW = NH * DV * 2;
constexpr float THR = 8.f;
#define SBAR() __builtin_amdgcn_sched_barrier(0)
#ifdef ATT_PROBE
#define PBT(k) do { unsigned long long t_; asm volatile("s_memrealtime %0\n\ts_waitcnt lgkmcnt(0)" : "=s"(t_) :: "memory"); const unsigned tl_ = (unsigned)t_; cv.pb[k] += tl_ - cv.pbl; cv.pbl = tl_; } while (0)
#else
#define PBT(k) do { } while (0)
#endif
__device__ __forceinline__ int crow(int r, int hi) { return (r & 3) + 8 * (r >> 2) + 4 * hi; }
__device__ __forceinline__ void glds16(const void* gsrc, unsigned lds_dst) { unsigned keep;
    asm volatile("s_mov_b32 %0, m0\n\ts_mov_b32 m0, %2\n\ts_nop 0\n\tglobal_load_lds_dwordx4 %1, off\n\ts_mov_b32 m0, %0" : "=&s"(keep) : "v"(gsrc), "s"(lds_dst) : "memory"); }
__device__ __forceinline__ void glds16_nt(const void* gsrc, unsigned lds_dst) { unsigned keep;
    asm volatile("s_mov_b32 %0, m0\n\ts_mov_b32 m0, %2\n\ts_nop 0\n\tglobal_load_lds_dwordx4 %1, off nt\n\ts_mov_b32 m0, %0" : "=&s"(keep) : "v"(gsrc), "s"(lds_dst) : "memory"); }
__device__ __forceinline__ void glds16s(const void* base, unsigned voff, unsigned lds_dst) {
    asm volatile("s_mov_b32 m0, %2\n\ts_nop 0\n\tglobal_load_lds_dwordx4 %1, %0" :: "s"(base), "v"(voff), "s"(lds_dst) : "memory", "m0"); }
__device__ __forceinline__ void glds16s_nt(const void* base, unsigned voff, unsigned lds_dst) {
    asm volatile("s_mov_b32 m0, %2\n\ts_nop 0\n\tglobal_load_lds_dwordx4 %1, %0 nt" :: "s"(base), "v"(voff), "s"(lds_dst) : "memory", "m0"); }
#ifdef ATT_PROBE
#define WAIT_BAR(N) do { asm volatile("s_waitcnt vmcnt(" #N ") lgkmcnt(0)" ::: "memory"); PBT(2); asm volatile("s_barrier" ::: "memory"); } while (0)
#else
#define WAIT_BAR(N) asm volatile("s_waitcnt vmcnt(" #N ") lgkmcnt(0)\n\ts_barrier" ::: "memory")
#endif
__device__ __forceinline__ int v_rd_base(int lane) { return ((lane & 3) << 3) | (((lane >> 2) & 3) << 6) | (((lane >> 4) & 1) << 5) | (((lane >> 5) & 1) << 8); }
constexpr int v_rd_off(int d0, int ks, int half) { return d0 * 512 + ks * 4096 + half * 2048; }

__device__ __forceinline__ void mask_tile(f32x16& p0, f32x16& p1, int dq) {
    const float NEG = -__builtin_inff();
#pragma unroll
    for (int r = 0; r < 16; ++r) { const int c = (r & 3) + 8 * (r >> 2);
        if (dq - c < 0) p0[r] = NEG;
        if (dq - c - 32 < 0) p1[r] = NEG; }
}
__device__ __forceinline__ void partialSM(f32x16& p0, f32x16& p1, float& m_reg, float& mn, float& alpha) {
    float pmax = p0[0];
#pragma unroll
    for (int r = 1; r < 16; ++r) pmax = fmaxf(pmax, p0[r]);
#pragma unroll
    for (int r = 0; r < 16; ++r) pmax = fmaxf(pmax, p1[r]);
    { auto rr = __builtin_amdgcn_permlane32_swap(__float_as_uint(pmax), __float_as_uint(pmax), false, false);
      pmax = fmaxf(__uint_as_float(rr[0]), __uint_as_float(rr[1])); }
    if (__builtin_expect(__all(pmax - m_reg <= THR), 1)) { mn = m_reg; alpha = 1.f; }
    else { mn = fmaxf(m_reg, pmax); alpha = __builtin_amdgcn_exp2f(m_reg - mn); m_reg = mn; }
#pragma unroll
    for (int r = 0; r < 16; ++r) { p0[r] = p0[r] - mn; p1[r] = p1[r] - mn; }
#pragma unroll
    for (int r = 0; r < 16; ++r) p0[r] = __builtin_amdgcn_exp2f(p0[r]);
}
__device__ __forceinline__ void finishSM(f32x16& p0, f32x16& p1, float alpha, float& l_reg, bf16x8& pa0, bf16x8& pa1, bf16x8& pa2, bf16x8& pa3) {
#pragma unroll
    for (int r = 0; r < 16; ++r) p1[r] = __builtin_amdgcn_exp2f(p1[r]);
    float ps = 0;
#pragma unroll
    for (int r = 0; r < 16; ++r) ps += p0[r];
#pragma unroll
    for (int r = 0; r < 16; ++r) ps += p1[r];
    { auto rr = __builtin_amdgcn_permlane32_swap(__float_as_uint(ps), __float_as_uint(ps), false, false);
      ps = __uint_as_float(rr[0]) + __uint_as_float(rr[1]); }
    l_reg = l_reg * alpha + ps;
#define PK4(P, B_, OUT) do { unsigned a0 = cvt_pk_bf16(P[B_+0], P[B_+1]), a1 = cvt_pk_bf16(P[B_+2], P[B_+3]);                          \
        unsigned b0 = cvt_pk_bf16(P[B_+4], P[B_+5]), b1 = cvt_pk_bf16(P[B_+6], P[B_+7]);                                             \
        auto r0 = __builtin_amdgcn_permlane32_swap(a0, b0, false, false); auto r1 = __builtin_amdgcn_permlane32_swap(a1, b1, false, false); \
        u32x4 w = {r0[0], r1[0], r0[1], r1[1]}; OUT = __builtin_bit_cast(bf16x8, w); } while (0)
    PK4(p0, 0, pa0); PK4(p0, 8, pa1); PK4(p1, 0, pa2); PK4(p1, 8, pa3);
#undef PK4
}
__device__ __forceinline__ void qkt(f32x16& p0, f32x16& p1, const LAS char* const (&kb)[4], const bf16x8 (&qr)[12]) {
    p0 = f32x16{}; p1 = f32x16{};
#pragma unroll
    for (int d0 = 0; d0 < 12; ++d0) { const LAS char* a = kb[d0 & 3] + (d0 >> 2) * 128;
        const bf16x8 b0 = *(const LAS bf16x8*)(a);
        const bf16x8 b1 = *(const LAS bf16x8*)(a + 32 * 384);
        p0 = __builtin_amdgcn_mfma_f32_32x32x16_bf16(b0, qr[d0], p0, 0, 0, 0);
        p1 = __builtin_amdgcn_mfma_f32_32x32x16_bf16(b1, qr[d0], p1, 0, 0, 0); }
}
template <int HALF_> __device__ __forceinline__ void pv_tile(f32x16* o, int vb0, bf16x8 pa0, bf16x8 pa1, bf16x8 pa2, bf16x8 pa3) {
#define TRRD(dst, off) asm volatile("ds_read_b64_tr_b16 %0, %1 offset:%2" : "=&v"(dst) : "v"(vb0), "i"(off) : "memory")
#define PV_D0(d0) do { s16x4 l0, l1, l2, l3, h0, h1, h2, h3; constexpr int b_ = v_rd_off(d0, 0, 0); \
        TRRD(l0, b_); TRRD(h0, b_ + 2048); TRRD(l1, b_ + 4096); TRRD(h1, b_ + 6144); TRRD(l2, b_ + 8192); TRRD(h2, b_ + 10240); TRRD(l3, b_ + 12288); TRRD(h3, b_ + 14336); \
        asm volatile("s_waitcnt lgkmcnt(0)" ::: "memory"); SBAR(); \
        o[d0] = __builtin_amdgcn_mfma_f32_32x32x16_bf16(pa0, (bf16x8){l0[0], l0[1], l0[2], l0[3], h0[0], h0[1], h0[2], h0[3]}, o[d0], 0, 0, 0);   \
        o[d0] = __builtin_amdgcn_mfma_f32_32x32x16_bf16(pa1, (bf16x8){l1[0], l1[1], l1[2], l1[3], h1[0], h1[1], h1[2], h1[3]}, o[d0], 0, 0, 0);   \
        o[d0] = __builtin_amdgcn_mfma_f32_32x32x16_bf16(pa2, (bf16x8){l2[0], l2[1], l2[2], l2[3], h2[0], h2[1], h2[2], h2[3]}, o[d0], 0, 0, 0);   \
        o[d0] = __builtin_amdgcn_mfma_f32_32x32x16_bf16(pa3, (bf16x8){l3[0], l3[1], l3[2], l3[3], h3[0], h3[1], h3[2], h3[3]}, o[d0], 0, 0, 0); } while (0)
    if (HALF_ == 0) { PV_D0(0); PV_D0(1); } else { PV_D0(2); PV_D0(3); }
#undef PV_D0
#undef TRRD
}

struct ConvCtx {
    int ci, cd, n, base_it, stride;
    int bi, bd;
#ifdef ATT_PROBE
    unsigned pb[4], pbl;
#endif
    const float* wg; const float* wu; const float* wd; const float* fg; bf16_t* WGU; bf16_t* WDn;
};
struct ConvTile { const float* W; int ldw, k0, n0; bf16_t* WT; int drow, ldt; bool gain; };
__device__ __forceinline__ void conv_decode(const ConvCtx& c, int i, ConvTile& t) {
    constexpr int TG = 64 * 64 * 8;
    int r = c.base_it + i * c.stride;
    if (r < 2 * TG) { const bool up = r >= TG; if (up) r -= TG; const int e = r >> 9, q = r & 511, kb = q >> 3, nb = q & 7; const int n0 = 64 * nb;
        t.W = (up ? c.wu : c.wg) + (size_t)e * DM * DE; t.ldw = DE; t.k0 = 64 * kb; t.n0 = n0; t.WT = c.WGU + (size_t)e * 1024 * DM; t.drow = (n0 >> 7) * 256 + (up ? 128 : 0) + (n0 & 127); t.ldt = DM; t.gain = true; }
    else { r -= 2 * TG; const int e = r >> 9, q = r & 511, kb = q >> 6, nb = q & 63;
        t.W = c.wd + (size_t)e * DE * DM; t.ldw = DM; t.k0 = 64 * kb; t.n0 = 64 * nb; t.WT = c.WDn + (size_t)e * DM * DE; t.drow = 64 * nb; t.ldt = DE; t.gain = false; }
}
__device__ __forceinline__ void conv_process(const ConvCtx& c, int i, int buf, LAS char* shm, int wid, int lane) {
    ConvTile t; conv_decode(c, i, t);
    const LAS float* T = (const LAS float*)(shm + CONV_OFF + buf * 16384) + wid * 8 * 64 + lane;
    float v[8];
#pragma unroll
    for (int j = 0; j < 8; ++j) v[j] = T[j * 64];
    if (t.gain) { const __attribute__((address_space(4))) float* g = (const __attribute__((address_space(4))) float*)(c.fg + t.k0 + 8 * wid);
#pragma unroll
        for (int j = 0; j < 8; ++j) v[j] *= g[j]; }
    u32x4 o; o.x = cvt_pk_bf16(v[0], v[1]); o.y = cvt_pk_bf16(v[2], v[3]); o.z = cvt_pk_bf16(v[4], v[5]); o.w = cvt_pk_bf16(v[6], v[7]);
    *(u32x4*)((char*)(t.WT + (size_t)t.drow * t.ldt + t.k0 + 8 * wid) + (unsigned)lane * (unsigned)t.ldt * 2u) = o;
}
__device__ __forceinline__ void conv_dma(const ConvCtx& c, int i, int buf, unsigned lds0, int wid, int lane) {
    ConvTile t; conv_decode(c, i, t);
    const char* g = (const char*)(t.W + (size_t)(t.k0 + 8 * wid) * t.ldw + t.n0);
    const unsigned lo = (unsigned)(lane >> 4) * (unsigned)t.ldw * 4u + (unsigned)(lane & 15) * 16u;
    const unsigned dst = lds0 + CONV_OFF + buf * 16384 + wid * 2048;
    glds16_nt(g + lo, (unsigned)__builtin_amdgcn_readfirstlane(dst));
    glds16_nt(g + (size_t)t.ldw * 16 + lo, (unsigned)__builtin_amdgcn_readfirstlane(dst + 1024));
}
__device__ __forceinline__ void conv_proc_step(ConvCtx& c, LAS char* shm, int wid, int lane) {
    if (c.ci < c.n && c.ci < c.cd) { conv_process(c, c.ci, c.bi, shm, wid, lane); ++c.ci; c.bi ^= 1; }
}
__device__ __forceinline__ bool conv_dma_begin(const ConvCtx& c, ConvTile& t) { const bool go = c.cd < c.n; if (go) conv_decode(c, c.cd, t); return go; }
__device__ __forceinline__ void conv_dma1(const ConvCtx& c, const ConvTile& t, int piece, unsigned lds0, int wid, int lane) {
    const char* g = (const char*)(t.W + (size_t)(t.k0 + 8 * wid + 4 * piece) * t.ldw + t.n0);
    const unsigned lo = (unsigned)(lane >> 4) * (unsigned)t.ldw * 4u + (unsigned)(lane & 15) * 16u;
    glds16s_nt(g, lo, (unsigned)__builtin_amdgcn_readfirstlane(lds0 + CONV_OFF + c.bd * 16384 + wid * 2048 + piece * 1024));
}
__device__ __forceinline__ void conv_dma_end(ConvCtx& c) { ++c.cd; c.bd ^= 1; }
__device__ __forceinline__ bool conv_dma_step(ConvCtx& c, unsigned lds0, int wid, int lane) {
    const bool go = c.cd < c.n;
    if (go) conv_dma(c, c.cd, c.bd, lds0, wid, lane);
    return go;
}

__device__ __forceinline__ void attn_unit(int b, int h, int qb, const bf16_t* Q, const bf16_t* KF, const bf16_t* VBp, bf16_t* MIX, const float* gq, const float* rope, ConvCtx& cv, LAS char* shm) {
    int tid = threadIdx.x; asm volatile("" : "+v"(tid));
    const int lane = tid & 63, r32 = lane & 31, hi = lane >> 5; const int wid = __builtin_amdgcn_readfirstlane(tid >> 6);
    const int NT = 4 * qb + 5;
    const char* Kg = (const char*)KF + ((size_t)(b * LSEQ) * QW + h * DQK) * 2;
    const char* Vg = (const char*)VBp + ((size_t)(b * LSEQ) * (NH * DV) + h * DV) * 2;
    const char* Qg = (const char*)Q + ((size_t)(b * SEQ + qb * QB + wid * QBLK + r32) * QW + h * DQK) * 2;
    const unsigned lds0 = (unsigned)(uintptr_t)shm;
    bf16x8 qr[12];
    { u32x4 raw[12];
#pragma unroll
      for (int d0 = 0; d0 < 12; ++d0) raw[d0] = *(const u32x4*)(Qg + (d0 * 16 + hi * 8) * 2);
      const int tpos = NMETA + qb * QB + wid * QBLK + r32; const float* rp = rope + (size_t)tpos * 64 + 8 * hi;
      float ss = 0.f;
#pragma unroll
      for (int d0 = 0; d0 < 12; ++d0)
#pragma unroll
          for (int j = 0; j < 4; ++j) { const float x = bf_lo(raw[d0][j]), y = bf_hi(raw[d0][j]); ss += x * x + y * y; }
      { auto rr = __builtin_amdgcn_permlane32_swap(__float_as_uint(ss), __float_as_uint(ss), false, false); ss = __uint_as_float(rr[0]) + __uint_as_float(rr[1]); }
      const float rq = rsqrtf(ss * (1.f / DQK) + EPS) * QSCALE;
#pragma unroll
      for (int d0 = 0; d0 < 8; ++d0) { const f32x4 g0 = *(const f32x4*)(gq + d0 * 16 + hi * 8), g1 = *(const f32x4*)(gq + d0 * 16 + hi * 8 + 4); u32x4 w;
          w.x = cvt_pk_bf16(bf_lo(raw[d0][0]) * rq * g0[0], bf_hi(raw[d0][0]) * rq * g0[1]); w.y = cvt_pk_bf16(bf_lo(raw[d0][1]) * rq * g0[2], bf_hi(raw[d0][1]) * rq * g0[3]);
          w.z = cvt_pk_bf16(bf_lo(raw[d0][2]) * rq * g1[0], bf_hi(raw[d0][2]) * rq * g1[1]); w.w = cvt_pk_bf16(bf_lo(raw[d0][3]) * rq * g1[2], bf_hi(raw[d0][3]) * rq * g1[3]);
          qr[d0] = __builtin_bit_cast(bf16x8, w); }
#pragma unroll
      for (int dd = 0; dd < 2; ++dd) {
          float x1[8], x2[8], cs[8], sn[8];
#pragma unroll
          for (int q = 0; q < 2; ++q) { const f32x4 ga = *(const f32x4*)(gq + 128 + 16 * dd + 8 * hi + 4 * q), gb = *(const f32x4*)(gq + 160 + 16 * dd + 8 * hi + 4 * q);
              const f32x4 cc = *(const f32x4*)(rp + 16 * dd + 4 * q), sq = *(const f32x4*)(rp + 32 + 16 * dd + 4 * q);
#pragma unroll
              for (int e = 0; e < 4; ++e) { const int j = 4 * q + e; const unsigned wa = raw[8 + dd][j >> 1], wb = raw[10 + dd][j >> 1];
                  x1[j] = ((j & 1) ? bf_hi(wa) : bf_lo(wa)) * rq * ga[e]; x2[j] = ((j & 1) ? bf_hi(wb) : bf_lo(wb)) * rq * gb[e]; cs[j] = cc[e]; sn[j] = sq[e]; } }
          u32x4 w1, w2;
#pragma unroll
          for (int q = 0; q < 4; ++q) { w1[q] = cvt_pk_bf16(x1[2 * q] * cs[2 * q] - x2[2 * q] * sn[2 * q], x1[2 * q + 1] * cs[2 * q + 1] - x2[2 * q + 1] * sn[2 * q + 1]);
              w2[q] = cvt_pk_bf16(x1[2 * q] * sn[2 * q] + x2[2 * q] * cs[2 * q], x1[2 * q + 1] * sn[2 * q + 1] + x2[2 * q + 1] * cs[2 * q + 1]); }
          qr[8 + dd] = __builtin_bit_cast(bf16x8, w1); qr[10 + dd] = __builtin_bit_cast(bf16x8, w2); }
    }
    unsigned kof[3], vof[2];
#pragma unroll
    for (int j = 0; j < 3; ++j) { const int q = (wid * 3 + j) * 64 + lane, row = q / 24, chp = q - row * 24; const int ch = (chp & ~7) | ((chp & 7) ^ ((row >> 1) & 7));
        kof[j] = (unsigned)row * KROW + (unsigned)ch * 16u; }
#pragma unroll
    for (int j = 0; j < 2; ++j) { const int q = (wid * 2 + j) * 64 + lane, s = q >> 5; const int kk = (s >> 2) * 8 + ((q & 31) >> 2), c = (s & 3) * 32 + (q & 3) * 8;
        const int k = (kk & ~0xC) | ((kk & 4) << 1) | ((kk & 8) >> 1);
        vof[j] = (unsigned)k * VROW + (unsigned)c * 2u; }
    const unsigned kdst = lds0 + LDS_K + wid * 3072, vdst = lds0 + LDS_V + wid * 2048;
#define DMA_K(t, slot) do { const char* g_ = Kg + (size_t)(t) * (KVBLK * KROW); _Pragma("unroll") for (int j_ = 0; j_ < 3; ++j_) glds16(g_ + kof[j_], (unsigned)__builtin_amdgcn_readfirstlane(kdst + (slot) * KT_BYTES + j_ * 1024)); } while (0)
#define DMA_V(t, slot) do { const char* g_ = Vg + (size_t)(t) * (KVBLK * VROW); _Pragma("unroll") for (int j_ = 0; j_ < 2; ++j_) glds16(g_ + vof[j_], (unsigned)__builtin_amdgcn_readfirstlane(vdst + (slot) * VT_BYTES + j_ * 1024)); } while (0)
#define DMA_K1(t, slot, j_) glds16s(Kg + (size_t)(t) * (KVBLK * KROW), kof[j_], (unsigned)__builtin_amdgcn_readfirstlane(kdst + (slot) * KT_BYTES + (j_) * 1024))
#define DMA_V1(t, slot, j_) glds16s(Vg + (size_t)(t) * (KVBLK * VROW), vof[j_], (unsigned)__builtin_amdgcn_readfirstlane(vdst + (slot) * VT_BYTES + (j_) * 1024))
    DMA_K(0, 0); DMA_K(1, 1); DMA_V(0, 1);
    const LAS char* shm3 = (const LAS char*)shm;
    const int key7 = (r32 >> 1) & 7;
    const LAS char* kb0[4];
#pragma unroll
    for (int dd = 0; dd < 4; ++dd) kb0[dd] = shm3 + LDS_K + r32 * 384 + 16 * ((2 * dd + hi) ^ key7);
    const int vb0 = (int)(lds0 + LDS_V) + v_rd_base(lane);
    LAS float* ws = (LAS float*)(shm + LDS_WS) + wid * 64; LAS float* li_l = ws; LAS float* al_l = ws + 32;
    float m_reg = -1e30f, l_reg = 0.f; f32x16 o[4] = {};
    const int qlo = NMETA + qb * QB + wid * QBLK;
    const int qm = qlo + r32 - 4 * hi;
#define RESC(a) do { if (__any((a) < 1.f)) { if (hi == 0) al_l[r32] = (a); asm volatile("s_waitcnt lgkmcnt(0)" ::: "memory");              \
                     _Pragma("unroll") for (int d_ = 0; d_ < 4; ++d_) _Pragma("unroll") for (int r = 0; r < 16; ++r) o[d_][r] *= al_l[crow(r, hi)]; } } while (0)
#define MASKT(P0_, P1_, t) do { const int kb_ = (t) * KVBLK; if (kb_ + KVBLK - 1 > qlo) mask_tile(P0_, P1_, qm - kb_); } while (0)
    const bool g1 = wid >= 4, hk = true;
    f32x16 p0, p1; float alpha; bf16x8 pa0, pa1, pa2, pa3;
    int sK = 0, sKn = 1, sKnn = 2;
    int sVp = 0, sVm = 1, sV = 2;
    bool gc = false; ConvTile cdma_;
#define ROT() do { int t_ = sK; sK = sKn; sKn = sKnn; sKnn = t_; t_ = sVp; sVp = sVm; sVm = sV; sV = t_; } while (0)
#define IV_BEGIN() do { gc = conv_dma_begin(cv, cdma_); } while (0)
#define IV_END() do { if (gc) asm volatile("s_waitcnt vmcnt(7)" ::: "memory"); else asm volatile("s_waitcnt vmcnt(5)" ::: "memory"); PBT(2);                             \
        conv_proc_step(cv, shm, wid, lane); conv_dma_end(cv); asm volatile("s_waitcnt lgkmcnt(0)\n\ts_barrier" ::: "memory"); ROT(); } while (0)
#define TKC(I) (((I) + 2 < NT) ? (I) + 2 : NT - 1)
#define TVC(I) (((I) + 1 < NT) ? (I) + 1 : NT - 1)
#define HOOKS_ALL(I) do { const int tk_ = TKC(I), tv_ = TVC(I); DMA_V1(tv_, sV, 0); DMA_V1(tv_, sV, 1); DMA_K1(tk_, sKnn, 0); DMA_K1(tk_, sKnn, 1); DMA_K1(tk_, sKnn, 2);   \
        if (gc) { conv_dma1(cv, cdma_, 0, lds0, wid, lane); conv_dma1(cv, cdma_, 1, lds0, wid, lane); } } while (0)
#define LDK(dst, base, off) asm volatile("ds_read_b128 %0, %1 offset:%2" : "=&v"(dst) : "v"(base), "i"(off) : "memory")
#define LDV(dst, off) asm volatile("ds_read_b64_tr_b16 %0, %1 offset:%2" : "=&v"(dst) : "v"(vbs_), "i"(off) : "memory")
#define LW2(n, a, b) asm volatile("s_waitcnt lgkmcnt(" #n ")" : "+v"(a), "+v"(b) :: "memory")
#define LW4(n, a, b, c, d) asm volatile("s_waitcnt lgkmcnt(" #n ")" : "+v"(a), "+v"(b), "+v"(c), "+v"(d) :: "memory")
#define RDK(d0, s) do { LDK(kf[s][0], kq_[(d0) & 3], ((d0) >> 2) * 128); LDK(kf[s][1], kq_[(d0) & 3], ((d0) >> 2) * 128 + 32 * 384); } while (0)
#define RDV(j, s) do { LDV(vl[s][0], v_rd_off((j) >> 1, 2 * ((j) & 1), 0)); LDV(vh[s][0], v_rd_off((j) >> 1, 2 * ((j) & 1), 1)); LDV(vl[s][1], v_rd_off((j) >> 1, 2 * ((j) & 1) + 1, 0)); LDV(vh[s][1], v_rd_off((j) >> 1, 2 * ((j) & 1) + 1, 1)); } while (0)
#define MMK(d0, s, n) do { LW2(n, kf[s][0], kf[s][1]); p0 = __builtin_amdgcn_mfma_f32_32x32x16_bf16(kf[s][0], qr[d0], p0, 0, 0, 0); p1 = __builtin_amdgcn_mfma_f32_32x32x16_bf16(kf[s][1], qr[d0], p1, 0, 0, 0); } while (0)
#define VOP(s, k) ((bf16x8){vl[s][k][0], vl[s][k][1], vl[s][k][2], vl[s][k][3], vh[s][k][0], vh[s][k][1], vh[s][k][2], vh[s][k][3]})
#define MMV(j, s, n) do { LW4(n, vl[s][0], vh[s][0], vl[s][1], vh[s][1]);                                                                                                   \
        o[(j) >> 1] = __builtin_amdgcn_mfma_f32_32x32x16_bf16(((j) & 1) ? pa2 : pa0, VOP(s, 0), o[(j) >> 1], 0, 0, 0);                                                       \
        o[(j) >> 1] = __builtin_amdgcn_mfma_f32_32x32x16_bf16(((j) & 1) ? pa3 : pa1, VOP(s, 1), o[(j) >> 1], 0, 0, 0); } while (0)
#ifdef NO_SETPRIO
#define SETPRIO_M(x) do { } while (0)
#else
#define SETPRIO_M(x) __builtin_amdgcn_s_setprio(x)
#endif
#define MCLUSTER(I, HK_, PV_) do {                                                                                                                                          \
        const unsigned kq_[4] = {(unsigned)(uintptr_t)kb0[0] + sK * KT_BYTES, (unsigned)(uintptr_t)kb0[1] + sK * KT_BYTES, (unsigned)(uintptr_t)kb0[2] + sK * KT_BYTES, (unsigned)(uintptr_t)kb0[3] + sK * KT_BYTES}; \
        const int vbs_ = vb0 + sVp * VT_BYTES; const int tk_ = TKC(I), tv_ = TVC(I);                                                                                                       \
        bf16x8 kf[4][2]; s16x4 vl[4][2], vh[4][2];                                                                                                                           \
        SETPRIO_M(1);                                                                                                                                                        \
        p0 = f32x16{}; p1 = f32x16{};                                                                                                                                        \
        RDK(0, 0); RDK(1, 1); RDK(2, 2);                                                                                                                                     \
        RDK(3, 3); MMK(0, 0, 6);                                                                                                                                             \
        RDK(4, 0); MMK(1, 1, 6); if (HK_) { DMA_V1(tv_, sV, 0); }                                                                                                            \
        RDK(5, 1); MMK(2, 2, 6); if (HK_) { DMA_V1(tv_, sV, 1); }                                                                                                            \
        RDK(6, 2); MMK(3, 3, 6); if (HK_) { DMA_K1(tk_, sKnn, 0); }                                                                                                          \
        RDK(7, 3); MMK(4, 0, 6); if (HK_) { DMA_K1(tk_, sKnn, 1); }                                                                                                          \
        RDK(8, 0); MMK(5, 1, 6); if (HK_) { DMA_K1(tk_, sKnn, 2); }                                                                                                          \
        RDK(9, 1); MMK(6, 2, 6); if (HK_) { if (gc) conv_dma1(cv, cdma_, 0, lds0, wid, lane); }                                                                              \
        RDK(10, 2); MMK(7, 3, 6); if (HK_) { if (gc) conv_dma1(cv, cdma_, 1, lds0, wid, lane); }                                                                             \
        RDK(11, 3); MMK(8, 0, 6);                                                                                                                                            \
        if (PV_) {                                                                                                                                                           \
            RDV(0, 0); MMK(9, 1, 8);                                                                                                                                         \
            RDV(1, 1); MMK(10, 2, 10);                                                                                                                                       \
            RDV(2, 2); MMK(11, 3, 12);                                                                                                                                       \
            RDV(3, 3); MMV(0, 0, 12);                                                                                                                                        \
            RDV(4, 0); MMV(1, 1, 12);                                                                                                                                        \
            RDV(5, 1); MMV(2, 2, 12);                                                                                                                                        \
            RDV(6, 2); MMV(3, 3, 12);                                                                                                                                        \
            RDV(7, 3); MMV(4, 0, 12);                                                                                                                                        \
            MMV(5, 1, 8);                                                                                                                                                    \
            MMV(6, 2, 4);                                                                                                                                                    \
            MMV(7, 3, 0);                                                                                                                                                    \
        } else { MMK(9, 1, 4); MMK(10, 2, 2); MMK(11, 3, 0); }                                                                                                               \
        SETPRIO_M(0); } while (0)
#define MCLUSTER_PV(I, HK_) do {                                                                                                                                            \
        const int vbs_ = vb0 + sVp * VT_BYTES; const int tk_ = TKC(I), tv_ = TVC(I);                                                                                         \
        s16x4 vl[4][2], vh[4][2];                                                                                                                                            \
        SETPRIO_M(1);                                                                                                                                                        \
        RDV(0, 0); RDV(1, 1); RDV(2, 2);                                                                                                                                     \
        RDV(3, 3); MMV(0, 0, 12); if (HK_) { DMA_V1(tv_, sV, 0); }                                                                                                           \
        RDV(4, 0); MMV(1, 1, 12); if (HK_) { DMA_V1(tv_, sV, 1); }                                                                                                           \
        RDV(5, 1); MMV(2, 2, 12); if (HK_) { DMA_K1(tk_, sKnn, 0); }                                                                                                         \
        RDV(6, 2); MMV(3, 3, 12); if (HK_) { DMA_K1(tk_, sKnn, 1); }                                                                                                         \
        RDV(7, 3); MMV(4, 0, 12); if (HK_) { DMA_K1(tk_, sKnn, 2); }                                                                                                         \
        MMV(5, 1, 8); if (HK_) { if (gc) conv_dma1(cv, cdma_, 0, lds0, wid, lane); }                                                                                         \
        MMV(6, 2, 4); if (HK_) { if (gc) conv_dma1(cv, cdma_, 1, lds0, wid, lane); }                                                                                         \
        MMV(7, 3, 0);                                                                                                                                                        \
        SETPRIO_M(0); } while (0)
#define VCLUSTER(I, HV_, IH_) do { const int tk_ = TKC(IH_), tv_ = TVC(IH_);                                                                                               \
        MASKT(p0, p1, (I));                                                                                                                                                  \
        if (HV_) { DMA_V1(tv_, sV, 0); }                                                                                                                                     \
                          \
        float pm0 = p0[0], pm1 = p0[1], pm2 = p0[2], pm3 = p0[3];                                                                                                            \
        _Pragma("unroll") for (int r = 4; r < 16; r += 4) { pm0 = fmaxf(pm0, p0[r]); pm1 = fmaxf(pm1, p0[r + 1]); pm2 = fmaxf(pm2, p0[r + 2]); pm3 = fmaxf(pm3, p0[r + 3]); }   \
        if (HV_) { DMA_V1(tv_, sV, 1); }                                                                                                                                     \
        _Pragma("unroll") for (int r = 0; r < 16; r += 4) { pm0 = fmaxf(pm0, p1[r]); pm1 = fmaxf(pm1, p1[r + 1]); pm2 = fmaxf(pm2, p1[r + 2]); pm3 = fmaxf(pm3, p1[r + 3]); }   \
        float pmax = fmaxf(fmaxf(pm0, pm1), fmaxf(pm2, pm3));                                                                                                                \
        { auto rr = __builtin_amdgcn_permlane32_swap(__float_as_uint(pmax), __float_as_uint(pmax), false, false); pmax = fmaxf(__uint_as_float(rr[0]), __uint_as_float(rr[1])); } \
        float mn_;                                                                                                                                                           \
        if (__builtin_expect(__all(pmax - m_reg <= THR), 1)) { mn_ = m_reg; alpha = 1.f; }                                                                                   \
        else { mn_ = fmaxf(m_reg, pmax); alpha = __builtin_amdgcn_exp2f(m_reg - mn_); m_reg = mn_; }                                                                         \
        if (HV_) { DMA_K1(tk_, sKnn, 0); }                                                                                                                                   \
        _Pragma("unroll") for (int r = 0; r < 16; ++r) p0[r] = __builtin_amdgcn_exp2f(p0[r] - mn_);                                                                          \
        if (HV_) { DMA_K1(tk_, sKnn, 1); }                                                                                                                                   \
        _Pragma("unroll") for (int r = 0; r < 16; ++r) p1[r] = __builtin_amdgcn_exp2f(p1[r] - mn_);                                                                          \
        if (HV_) { DMA_K1(tk_, sKnn, 2); }                                                                                                                                   \
        float ps0 = p0[0] + p1[0], ps1 = p0[1] + p1[1], ps2 = p0[2] + p1[2], ps3 = p0[3] + p1[3];                                                                            \
        _Pragma("unroll") for (int r = 4; r < 16; r += 4) { ps0 += p0[r] + p1[r]; ps1 += p0[r + 1] + p1[r + 1]; ps2 += p0[r + 2] + p1[r + 2]; ps3 += p0[r + 3] + p1[r + 3]; } \
        float ps = (ps0 + ps1) + (ps2 + ps3);                                                                                                                                \
        { auto rr = __builtin_amdgcn_permlane32_swap(__float_as_uint(ps), __float_as_uint(ps), false, false); ps = __uint_as_float(rr[0]) + __uint_as_float(rr[1]); }       \
        l_reg = l_reg * alpha + ps;                                                                                                                                          \
        if (HV_) { if (gc) conv_dma1(cv, cdma_, 0, lds0, wid, lane); }                                                                                                       \
        PK4(p0, 0, pa0); PK4(p0, 8, pa1);                                                                                                                                    \
        if (HV_) { if (gc) conv_dma1(cv, cdma_, 1, lds0, wid, lane); }                                                                                                       \
        PK4(p1, 0, pa2); PK4(p1, 8, pa3);                                                                                                                                    \
        RESC(alpha); } while (0)
#define PK4(P, B_, OUT) do { unsigned a0 = cvt_pk_bf16(P[B_+0], P[B_+1]), a1 = cvt_pk_bf16(P[B_+2], P[B_+3]);                          \
        unsigned b0 = cvt_pk_bf16(P[B_+4], P[B_+5]), b1 = cvt_pk_bf16(P[B_+6], P[B_+7]);                                             \
        auto r0 = __builtin_amdgcn_permlane32_swap(a0, b0, false, false); auto r1 = __builtin_amdgcn_permlane32_swap(a1, b1, false, false); \
        u32x4 w = {r0[0], r1[0], r0[1], r1[1]}; OUT = __builtin_bit_cast(bf16x8, w); } while (0)
    WAIT_BAR(0);
    IV_BEGIN(); HOOKS_ALL(0);
    MCLUSTER(0, false, false);
    if (g1) { IV_END(); IV_BEGIN(); }
    VCLUSTER(0, false, 1);
    if (!g1) { IV_END(); }
    PBT(3);
    const int Tw = (qlo + QBLK - 1) >> 6;
    int t = 1;
    for (; t <= Tw && t < NT; ++t) {
        if (hk) IV_BEGIN();
        MCLUSTER(t, hk, true); PBT(0);
        bool hv = false;
        if (g1) { IV_END(); PBT(3); if (t + 1 < NT) { IV_BEGIN(); } }
        VCLUSTER(t, hv, t + 1); PBT(1);
        if (!g1) { IV_END(); PBT(3); }
    }
    for (; t < NT; ++t) {
        if (hk) IV_BEGIN();
        if (t - 1 == Tw) { MCLUSTER_PV(t, hk); } else { HOOKS_ALL(t); }
        IV_END();
    }
    if (NT - 1 <= Tw) { const int vbs_ = vb0 + sVp * VT_BYTES; s16x4 vl[4][2], vh[4][2];
      RDV(0, 0); RDV(1, 1); RDV(2, 2);
      RDV(3, 3); MMV(0, 0, 12);
      RDV(4, 0); MMV(1, 1, 12);
      RDV(5, 1); MMV(2, 2, 12);
      RDV(6, 2); MMV(3, 3, 12);
      RDV(7, 3); MMV(4, 0, 12);
      MMV(5, 1, 8); MMV(6, 2, 4); MMV(7, 3, 0); }
    if (hi == 0) li_l[r32] = l_reg; asm volatile("s_waitcnt lgkmcnt(0)" ::: "memory");
    float rli[16];
#pragma unroll
    for (int r = 0; r < 16; ++r) rli[r] = __builtin_amdgcn_rcpf(li_l[crow(r, hi)]);
    bf16_t* Ow = MIX + (size_t)(b * LSEQ + NMETA + qb * QB + wid * QBLK) * DM + POOLW + h * DV;
#pragma unroll
    for (int r = 0; r < 16; ++r) { const int orow = crow(r, hi);
#pragma unroll
        for (int d0 = 0; d0 < 4; ++d0) { const float v = o[d0][r] * rli[r]; const float vn = __shfl_xor(v, 1);
            if ((r32 & 1) == 0) *(unsigned*)(Ow + (size_t)orow * DM + d0 * 32 + r32) = cvt_pk_bf16(v, vn); } }
    asm volatile("s_waitcnt lgkmcnt(0)\n\ts_barrier" ::: "memory");
#undef DMA_K
#undef DMA_V
#undef RESC
#undef MASKT
#undef ROT
#undef IV_BEGIN
#undef IV_END
#undef TKC
#undef TVC
#undef HOOKS_ALL
#undef LDK
#undef LDV
#undef LW2
#undef LW4
#undef RDK
#undef RDV
#undef MMK
#undef VOP
#undef MMV
#undef MCLUSTER
#undef MCLUSTER_PV
#undef VCLUSTER
#undef PK4
}
#undef SBAR
#undef WAIT_BAR
}
constexpr int NWAVES = 8;
struct Frame {
    LAS unsigned char* lds;
    volatile LAS unsigned* MISC;
    unsigned* ctl;
    int tid, lane, wave, vcu, G;
    const float* in[21]; float* out; unsigned char* ws;
};
enum { IN_X = 0, IN_META, IN_MIXG, IN_WIN, IN_QLG, IN_WUQ, IN_KVLG, IN_WUKV, IN_QHG, IN_KHG, IN_WPOOL, IN_PSCALE, IN_WOUT, IN_FFNG, IN_WGROUP, IN_BGROUP, IN_WEXP, IN_BEXP, IN_WGATE, IN_WUP, IN_WDOWN };
#define WSP(T, off) ((T*)(F.ws + (off)))

struct TrItem { const float* W; int ldw, k0, n0; bf16_t* WT; int drow, ldt; const float* sk; const float* sn; };
__device__ __forceinline__ void tr_load(f32x4 (&v)[16], const TrItem& t, int lane) {
    const int s = lane >> 4, cq = lane & 15;
#pragma unroll
    for (int i = 0; i < 16; ++i) { const int row = 8 * (i >> 1) + 2 * s + (i & 1); v[i] = *(const f32x4*)(t.W + (size_t)(t.k0 + row) * t.ldw + t.n0 + 4 * cq); }
}
__device__ __forceinline__ void tr_store(const f32x4 (&v)[16], const TrItem& t, LAS unsigned* T, int lane) {
    const int s = lane >> 4, cq = lane & 15;
    f32x4 gn = {1.f, 1.f, 1.f, 1.f}; if (t.sn) gn = *(const f32x4*)(t.sn + t.n0 + 4 * cq);
#pragma unroll
    for (int m = 0; m < 8; ++m) { f32x2 g = {1.f, 1.f}; if (t.sk) g = *(const f32x2*)(t.sk + t.k0 + 8 * m + 2 * s);
#pragma unroll
        for (int c = 0; c < 4; ++c) T[(4 * cq + c) * 33 + 4 * m + s] = cvt_pk_bf16(v[2 * m][c] * g.x * gn[c], v[2 * m + 1][c] * g.y * gn[c]); }
    LDS_WAIT(); asm volatile("" ::: "memory");
    const int q = lane & 7, nr = lane >> 3;
#pragma unroll
    for (int j = 0; j < 8; ++j) { const int n = nr + 8 * j; const LAS unsigned* r = T + n * 33 + 4 * q; u32x4 o; o.x = r[0]; o.y = r[1]; o.z = r[2]; o.w = r[3];
        *(u32x4*)(t.WT + (size_t)(t.drow + n) * t.ldt + t.k0 + 8 * q) = o; }
    LDS_WAIT(); asm volatile("" ::: "memory");
}
constexpr int TI_IN = 64 * 41, TI_UQ = 16 * 72, TI_UKV = 8 * 96, TI_P = 4 * 16, TI_O = 64 * 64, TI_SMALL = TI_IN + TI_UQ + TI_UKV + TI_P + TI_O;
constexpr int TI_G = 64 * 64 * 8, TI_D = 64 * 8 * 64, TI_EXP = 2 * TI_G + TI_D, TI_ALL = TI_SMALL + TI_EXP;
__device__ __forceinline__ void tr_decode(const Frame& F, int it, TrItem& t) {
    int r = it; t.sk = nullptr; t.sn = nullptr;
    if (r < TI_IN) { const int kb = r / 41, nb = r % 41; t.W = F.in[IN_WIN]; t.ldw = INC; t.k0 = 64 * kb; t.n0 = 64 * nb; t.WT = WSP(bf16_t, WS_WIN); t.drow = 64 * nb; t.ldt = DM; t.sk = F.in[IN_MIXG]; return; } r -= TI_IN;
    if (r < TI_UQ) { const int kb = r / 72, nb = r % 72; t.W = F.in[IN_WUQ]; t.ldw = QW; t.k0 = 64 * kb; t.n0 = 64 * nb; t.WT = WSP(bf16_t, WS_WUQ); t.drow = 64 * nb; t.ldt = QLR; t.sk = F.in[IN_QLG]; return; } r -= TI_UQ;
    if (r < TI_UKV) { const int kb = r / 96, nb = r % 96; t.W = F.in[IN_WUKV]; t.ldw = KVW; t.k0 = 64 * kb; t.n0 = 64 * nb; t.WT = WSP(bf16_t, WS_WUKV); t.drow = 64 * nb; t.ldt = KVLR; t.sk = F.in[IN_KVLG]; return; } r -= TI_UKV;
    if (r < TI_P) { const int g = r >> 4, q = r & 15, kb = q >> 2, nb = q & 3; t.W = F.in[IN_WPOOL] + (size_t)g * 65536; t.ldw = 256; t.k0 = 64 * kb; t.n0 = 64 * nb; t.WT = WSP(bf16_t, WS_WP) + (size_t)g * 65536; t.drow = 64 * nb; t.ldt = 256;
        t.sn = F.in[IN_PSCALE] + g * 256; return; } r -= TI_P;
    if (r < TI_O) { const int kb = r >> 6, nb = r & 63; t.W = F.in[IN_WOUT]; t.ldw = DM; t.k0 = 64 * kb; t.n0 = 64 * nb; t.WT = WSP(bf16_t, WS_WO); t.drow = 64 * nb; t.ldt = DM; return; } r -= TI_O;
    if (r < 2 * TI_G) { const bool up = r >= TI_G; if (up) r -= TI_G; const int e = r >> 9, q = r & 511, kb = q >> 3, nb = q & 7; const int n0 = 64 * nb;
        t.W = (up ? F.in[IN_WUP] : F.in[IN_WGATE]) + (size_t)e * DM * DE; t.ldw = DE; t.k0 = 64 * kb; t.n0 = n0; t.WT = WSP(bf16_t, WS_WGU) + (size_t)e * 1024 * DM; t.drow = (n0 >> 7) * 256 + (up ? 128 : 0) + (n0 & 127); t.ldt = DM;
        t.sk = F.in[IN_FFNG]; return; } r -= 2 * TI_G;
    { const int e = r >> 9, q = r & 511, kb = q >> 6, nb = q & 63; t.W = F.in[IN_WDOWN] + (size_t)e * DE * DM; t.ldw = DM; t.k0 = 64 * kb; t.n0 = 64 * nb; t.WT = WSP(bf16_t, WS_WD) + (size_t)e * DM * DE; t.drow = 64 * nb; t.ldt = DE; }
}
__device__ __forceinline__ void tr_range(Frame& F, int lo, int hi) {
    LAS unsigned* T = (LAS unsigned*)(F.lds + F.wave * 16384);
    const int gw = F.vcu * NWAVES + F.wave, NGW = F.G * NWAVES, lane = F.lane;
    int it = lo + gw; if (it >= hi) return;
    TrItem ta, tb; f32x4 va[16], vb[16];
    tr_decode(F, it, ta); tr_load(va, ta, lane);
    for (;;) {
        const int i1 = it + NGW; const bool h1 = i1 < hi;
        if (h1) { tr_decode(F, i1, tb); tr_load(vb, tb, lane); }
        tr_store(va, ta, T, lane);
        if (!h1) break;
        const int i2 = i1 + NGW; const bool h2 = i2 < hi;
        if (h2) { tr_decode(F, i2, ta); tr_load(va, ta, lane); }
        tr_store(vb, tb, T, lane);
        if (!h2) break;
        it = i2;
    }
}
__device__ __forceinline__ void p0_prologue(Frame& F) {
    const int gw = F.vcu * NWAVES + F.wave, NGW = F.G * NWAVES, lane = F.lane;
    const int gt = gw * 64 + lane, NGT = NGW * 64;
    tr_range(F, 0, TI_IN);
    { float* rstd1 = WSP(float, WS_SMALL + SM_RSTD1); bf16_t* XB = WSP(bf16_t, WS_XB);
      auto rowptr = [&](int row) -> const f32x4* { const int b = row / LSEQ, t = row % LSEQ;
          const float* h = t < NMETA ? F.in[IN_META] + (size_t)t * DM : F.in[IN_X] + ((size_t)b * SEQ + (t - NMETA)) * DM; return (const f32x4*)h + lane; };
      f32x4 va[16], vb[16];
      int row = gw - (TI_IN > NGW ? TI_IN - NGW : 0); if (row < 0) row += NGW;
      if (row < NTOK) { const f32x4* xr = rowptr(row);
#pragma unroll
          for (int j = 0; j < 16; ++j) va[j] = xr[64 * j]; }
      for (; row < MPAD; row += 2 * NGW) {
          const int r1 = row + NGW;
          if (r1 < NTOK) { const f32x4* xr = rowptr(r1);
#pragma unroll
              for (int j = 0; j < 16; ++j) vb[j] = xr[64 * j]; }
#define XB_ROW(V_, ROW_) do { unsigned long long* o8 = (unsigned long long*)(XB + (size_t)(ROW_) * DM) + lane;                       \
          if ((ROW_) >= NTOK) { _Pragma("unroll") for (int j = 0; j < 16; ++j) o8[64 * j] = 0ull; if (lane == 0) rstd1[(ROW_)] = 0.f; }       \
          else { float s = 0.f; _Pragma("unroll") for (int j = 0; j < 16; ++j) s += (V_[j].x * V_[j].x + V_[j].y * V_[j].y) + (V_[j].z * V_[j].z + V_[j].w * V_[j].w); \
              s = wave_sum(s); const float rs = rsqrtf(s * (1.f / DM) + EPS); if (lane == 0) rstd1[(ROW_)] = rs;                     \
              _Pragma("unroll") for (int j = 0; j < 16; ++j) o8[64 * j] = (unsigned long long)cvt_pk_bf16(V_[j].x * rs, V_[j].y * rs) | ((unsigned long long)cvt_pk_bf16(V_[j].z * rs, V_[j].w * rs) << 32); } } while (0)
          XB_ROW(va, row);
          const int r2 = r1 + NGW;
          if (r2 < NTOK) { const f32x4* xr = rowptr(r2);
#pragma unroll
              for (int j = 0; j < 16; ++j) va[j] = xr[64 * j]; }
          if (r1 < MPAD) XB_ROW(vb, r1);
#undef XB_ROW
      } }
}

__device__ __forceinline__ void p1_deferred(Frame& F, int first) {
    const int nw = (F.G - first) * NWAVES; if (nw <= 0 || (int)blockIdx.x < first) return;
    const int gw = ((int)blockIdx.x - first) * NWAVES + F.wave, NGW = nw, lane = F.lane;
    const int gt = gw * 64 + lane, NGT = NGW * 64;
    { LAS unsigned* T = (LAS unsigned*)(F.lds + F.wave * 16384);
      TrItem ta; f32x4 va[16];
      for (int it = TI_IN + gw; it < TI_SMALL; it += NGW) { tr_decode(F, it, ta); tr_load(va, ta, lane); tr_store(va, ta, T, lane); } }
    { bf16_t* hi = WSP(bf16_t, WS_WRT); bf16_t* lo = hi + 96 * DM;
      for (int i = gt; i < 96 * DM; i += NGT) { const int j = i / DM, k = i % DM; float v = 0.f;
          if (j < 8) v = F.in[IN_WGROUP][(size_t)k * NG + j] * F.in[IN_FFNG][k]; else if (j < 72) v = F.in[IN_WEXP][(size_t)k * NE + (j - 8)] * F.in[IN_FFNG][k];
          const unsigned h = cvt_pk_bf16(v, 0.f) & 0xffffu; hi[i] = (bf16_t)h; lo[i] = (bf16_t)(cvt_pk_bf16(v - bf_lo(h), 0.f) & 0xffffu); } }
    { float* rt = WSP(float, WS_ROPE);
      for (int i = gt; i < LSEQ * 32; i += NGT) { const int t = i >> 5, f = i & 31; const float inv = 1.0f / powf(10000.0f, (float)(2 * f) / (float)ROPE); const float ang = (float)t * inv;
          rt[t * 64 + f] = cosf(ang); rt[t * 64 + 32 + f] = sinf(ang); } }
}
template <int W> __device__ __forceinline__ void pool_cols(const bf16_t* PROJ, bf16_t* DIFF, int row0, int t0, int c) {
    float v0[31], v1[31];
#pragma unroll
    for (int i = 0; i < 31; ++i) { const int dt = i - 15; unsigned w = 0u; if (t0 + dt >= 0) w = *(const unsigned*)(PROJ + (size_t)(row0 + dt) * INCP + c); v0[i] = bf_lo(w); v1[i] = bf_hi(w); }
#pragma unroll
    for (int i = 0; i < 16; ++i) { float s0 = 0.f, s1 = 0.f;
#pragma unroll
        for (int j = 0; j < W; ++j) { s0 += v0[15 + i - j]; s1 += v1[15 + i - j]; }
        const int t = t0 + i; const float inv = 1.f / (float)((t + 1 < W) ? t + 1 : W);
        *(unsigned*)(DIFF + (size_t)(row0 + i) * POOLW + c) = cvt_pk_bf16(s0 * inv - v0[15 + i], s1 * inv - v1[15 + i]); }
}
__device__ __forceinline__ void s2_phase(Frame& F) {
    const bf16_t* PROJ = WSP(bf16_t, WS_PROJ); bf16_t* DIFF = WSP(bf16_t, WS_DIFF);
    float* rstdq = WSP(float, WS_SMALL + SM_RSTDQ); float* rstdkv = WSP(float, WS_SMALL + SM_RSTDKV); float* ssqpe = WSP(float, WS_SMALL + SM_SSQPE); float* kr = WSP(float, WS_KR);
    const float* rope = WSP(float, WS_ROPE);
    for (int tile = F.vcu; tile < MPAD / 16; tile += F.G) {
        const int row0 = tile * 16, t0 = row0 % LSEQ;
        const int c = 2 * F.tid, gi = F.wave >> 1;
        if (gi == 0) pool_cols<2>(PROJ, DIFF, row0, t0, c); else if (gi == 1) pool_cols<4>(PROJ, DIFF, row0, t0, c); else if (gi == 2) pool_cols<8>(PROJ, DIFF, row0, t0, c); else pool_cols<16>(PROJ, DIFF, row0, t0, c);
#pragma unroll
        for (int rr = 0; rr < 2; ++rr) { const int row = row0 + 2 * F.wave + rr; const bf16_t* p = PROJ + (size_t)row * INCP;
            const u32x4 a = *(const u32x4*)(p + POOLW + 8 * F.lane), b = *(const u32x4*)(p + POOLW + 512 + 8 * F.lane), k = *(const u32x4*)(p + POOLW + QLR + 8 * F.lane);
            float sq = 0.f, sk = 0.f;
#pragma unroll
            for (int j = 0; j < 4; ++j) { float x;
                x = bf_lo(a[j]); sq += x * x; x = bf_hi(a[j]); sq += x * x; x = bf_lo(b[j]); sq += x * x; x = bf_hi(b[j]); sq += x * x;
                x = bf_lo(k[j]); sk += x * x; x = bf_hi(k[j]); sk += x * x; }
            sq = wave_sum(sq); sk = wave_sum(sk);
            const int cl = F.lane & 7; const u32x4 kp = *(const u32x4*)(p + POOLW + QLR + KVLR + 8 * cl); const int t = row % LSEQ;
            float x[8], sp = 0.f;
#pragma unroll
            for (int j = 0; j < 4; ++j) { x[2 * j] = bf_lo(kp[j]); x[2 * j + 1] = bf_hi(kp[j]); }
#pragma unroll
            for (int j = 0; j < 8; ++j) { sp += x[j] * x[j]; x[j] *= F.in[IN_KHG][DNOPE + 8 * cl + j]; }
            sp += __shfl_xor(sp, 1); sp += __shfl_xor(sp, 2); sp += __shfl_xor(sp, 4);
            const float* rp = rope + (size_t)t * 64 + 8 * (cl & 3); float o[8];
#pragma unroll
            for (int j = 0; j < 8; ++j) { const float other = __shfl_xor(x[j], 4); const float cs = rp[j], sn = rp[32 + j];
                o[j] = (cl >= 4) ? other * sn + x[j] * cs : x[j] * cs - other * sn; }
            if (F.lane < 8) { *(f32x4*)(kr + (size_t)row * 64 + 8 * cl) = (f32x4){o[0], o[1], o[2], o[3]}; *(f32x4*)(kr + (size_t)row * 64 + 8 * cl + 4) = (f32x4){o[4], o[5], o[6], o[7]}; }
            { const float rq = rsqrtf(sq * (1.f / QLR) + EPS), rk = rsqrtf(sk * (1.f / KVLR) + EPS);
              u32x4 na, nb, nk;
#pragma unroll
              for (int j = 0; j < 4; ++j) { na[j] = cvt_pk_bf16(bf_lo(a[j]) * rq, bf_hi(a[j]) * rq); nb[j] = cvt_pk_bf16(bf_lo(b[j]) * rq, bf_hi(b[j]) * rq); nk[j] = cvt_pk_bf16(bf_lo(k[j]) * rk, bf_hi(k[j]) * rk); }
              bf16_t* pw = (bf16_t*)p; *(u32x4*)(pw + POOLW + 8 * F.lane) = na; *(u32x4*)(pw + POOLW + 512 + 8 * F.lane) = nb; *(u32x4*)(pw + POOLW + QLR + 8 * F.lane) = nk; }
            if (F.lane == 0) ssqpe[row] = sp; }
    }
}

__device__ __forceinline__ void s7_route(Frame& F) {
    const bf16_t* H1HI = WSP(bf16_t, WS_H1HI); const bf16_t* H1LO = WSP(bf16_t, WS_H1LO); const bf16_t* WHI = WSP(bf16_t, WS_WRT); const bf16_t* WLO = WHI + 96 * DM;
    const float* SSQ2 = WSP(float, WS_SSQ2); float* RSTD2 = WSP(float, WS_SMALL + SM_RSTD2);
    int* ETOK = WSP(int, WS_SMALL + SM_ETOK); int* RANK = WSP(int, WS_SMALL + SM_RANK); float* GTOK = WSP(float, WS_SMALL + SM_GTOK);
    LAS float* red = (LAS float*)F.lds;
    LAS int* cntl = (LAS int*)(F.lds + 4 * 64 * 97 * 4);
    LAS float* bias_l = (LAS float*)(cntl + 128);
    const int lane = F.lane, r32 = lane & 31, hi = lane >> 5, rh = F.wave & 1, kq = F.wave >> 1;
    for (int u = F.vcu; u < NREAL / 64; u += F.G) {
        const int t0 = u * 64;
        if (F.tid < 128) cntl[F.tid] = 0;
        if (F.tid < 72) bias_l[F.tid] = F.tid < 8 ? F.in[IN_BGROUP][F.tid] : F.in[IN_BEXP][F.tid - 8];
        f32x16 acc[3] = {};
        { constexpr int RK = 128, RSTR = RK * 2 + 16;
          LAS char* stA = (LAS char*)F.lds; LAS char* stB = stA + 2 * 64 * RSTR;
          const char* gA = (const char*)(H1HI + (size_t)t0 * DM); const char* gB = (const char*)WHI;
          u32x4 ra0[2], rb0[3], ra1[2], rb1[3], ra2[2], rb2[3], ra3[2], rb3[3];
          const int prow = F.tid >> 4, pc16 = (F.tid & 15) * 16;
#define RT_G(RA, RB, kc) do { _Pragma("unroll") for (int i = 0; i < 2; ++i) RA[i] = *(const u32x4*)(gA + (size_t)(prow + 32 * i) * (DM * 2) + (kc) * (RK * 2) + pc16); \
              _Pragma("unroll") for (int i = 0; i < 3; ++i) RB[i] = *(const u32x4*)(gB + (size_t)(prow + 32 * i) * (DM * 2) + (kc) * (RK * 2) + pc16); } while (0)
#define RT_S(RA, RB, buf) do { _Pragma("unroll") for (int i = 0; i < 2; ++i) *(LAS u32x4*)(stA + (buf) * 64 * RSTR + (prow + 32 * i) * RSTR + pc16) = RA[i]; \
              _Pragma("unroll") for (int i = 0; i < 3; ++i) *(LAS u32x4*)(stB + (buf) * 96 * RSTR + (prow + 32 * i) * RSTR + pc16) = RB[i]; } while (0)
#define RT_C(buf) do { _Pragma("unroll") for (int ksl = 0; ksl < 2; ++ksl) { const int ko = (2 * kq + ksl) * 32 + hi * 16; \
              const bf16x8 a_h = *(const LAS bf16x8*)(stA + (buf) * 64 * RSTR + (32 * rh + r32) * RSTR + ko); \
              _Pragma("unroll") for (int c = 0; c < 3; ++c) { const bf16x8 b_h = *(const LAS bf16x8*)(stB + (buf) * 96 * RSTR + (32 * c + r32) * RSTR + ko); \
                  acc[c] = __builtin_amdgcn_mfma_f32_32x32x16_bf16(a_h, b_h, acc[c], 0, 0, 0); } } } while (0)
          RT_G(ra0, rb0, 0); RT_G(ra1, rb1, 1); RT_G(ra2, rb2, 2); RT_G(ra3, rb3, 3); RT_S(ra0, rb0, 0); __syncthreads();
#pragma nounroll
          for (int kc = 0; kc < 32; kc += 4) {
              if (kc + 4 < 32) RT_G(ra0, rb0, kc + 4);
              RT_C(0); RT_S(ra1, rb1, 1); __syncthreads();
              if (kc + 5 < 32) RT_G(ra1, rb1, kc + 5);
              RT_C(1); RT_S(ra2, rb2, 0); __syncthreads();
              if (kc + 6 < 32) RT_G(ra2, rb2, kc + 6);
              RT_C(0); RT_S(ra3, rb3, 1); __syncthreads();
              if (kc + 7 < 32) RT_G(ra3, rb3, kc + 7);
              RT_C(1); if (kc + 4 < 32) RT_S(ra0, rb0, 0); __syncthreads();
          }
#undef RT_G
#undef RT_S
#undef RT_C
        }
#pragma unroll
        for (int c = 0; c < 3; ++c)
#pragma unroll
            for (int r = 0; r < 16; ++r) red[(kq * 64 + 32 * rh + att::crow(r, hi)) * 97 + 32 * c + r32] = acc[c][r];
        __syncthreads();
        int e0 = 0, e1 = 0, lr0 = 0, lr1 = 0; float g0 = 0.f, g1 = 0.f;
        { const int tt = F.tid & 63, part = F.tid >> 6, t = t0 + tt;
          const f32x4* sp = (const f32x4*)(SSQ2 + (size_t)t * 64); f32x4 acc4 = sp[0];
#pragma unroll
          for (int j = 1; j < 16; ++j) acc4 += sp[j];
          const float rs = rsqrtf(((acc4[0] + acc4[1]) + (acc4[2] + acc4[3])) * (1.f / DM) + EPS);
          if (part == 0) RSTD2[t] = rs;
          float lv[9];
#pragma unroll
          for (int q = 0; q < 9; ++q) { const int j = part * 9 + q;
              const float v = (red[(0 * 64 + tt) * 97 + j] + red[(1 * 64 + tt) * 97 + j]) + (red[(2 * 64 + tt) * 97 + j] + red[(3 * 64 + tt) * 97 + j]);
              lv[q] = v * rs + bias_l[j]; }
          __syncthreads();
#pragma unroll
          for (int q = 0; q < 9; ++q) red[tt * 97 + part * 9 + q] = lv[q]; }
        __syncthreads();
        if (F.tid < 64) {
            const int tt = F.tid;
            LAS float* lg = red + tt * 97;
            int gi = 0; float gm = lg[0];
            for (int j = 1; j < 8; ++j) { const float v = lg[j]; if (v > gm) { gm = v; gi = j; } }
            float den = 0.f; for (int j = 0; j < 8; ++j) den += __expf(lg[j] - gm);
            const float gp = 1.f / den;
            const LAS float* el = lg + 8 + gi * 8;
            int i0 = 0; float m0 = el[0];
            for (int j = 1; j < 8; ++j) { const float v = el[j]; if (v > m0) { m0 = v; i0 = j; } }
            int i1 = -1; float m1 = -__builtin_inff();
            for (int j = 0; j < 8; ++j) { const float v = el[j]; if (j != i0 && v > m1) { m1 = v; i1 = j; } }
            const float w1 = 1.f / (1.f + __expf(m0 - m1)), w0 = 1.f - w1;
            e0 = gi * 8 + i0; e1 = gi * 8 + i1; g0 = gp * w0; g1 = gp * w1;
            lr0 = __hip_atomic_fetch_add(cntl + e0, 1, __ATOMIC_RELAXED, __HIP_MEMORY_SCOPE_WORKGROUP); lr1 = __hip_atomic_fetch_add(cntl + e1, 1, __ATOMIC_RELAXED, __HIP_MEMORY_SCOPE_WORKGROUP);
        }
        __syncthreads();
        if (F.tid < 64) { const int n = cntl[F.tid]; cntl[64 + F.tid] = n > 0 ? (int)__hip_atomic_fetch_add(F.ctl + CW_CNT + F.tid, (unsigned)n, RLX_AGENT) : 0; }
        __syncthreads();
        if (F.tid < 64) { const int t = t0 + F.tid;
            ETOK[2 * t] = e0; ETOK[2 * t + 1] = e1; RANK[2 * t] = cntl[64 + e0] + lr0; RANK[2 * t + 1] = cntl[64 + e1] + lr1; GTOK[2 * t] = g0; GTOK[2 * t + 1] = g1; }
        __syncthreads();
    }
}
__device__ __forceinline__ void moe_tables(Frame& F) {
    __syncthreads();
    if (F.tid < NE) {
        const int e = F.tid; const unsigned nb = (__hip_atomic_load(F.ctl + CW_CNT + e, RLX_AGENT) + 127u) >> 7;
        unsigned a = nb, nf = nb >> 1, nh = nb & 1u;
#pragma unroll
        for (int d = 1; d < 64; d <<= 1) { const unsigned ta = __shfl_up(a, d), tf = __shfl_up(nf, d), th = __shfl_up(nh, d); if (e >= d) { a += ta; nf += tf; nh += th; } }
        F.MISC[64 + e] = a - nb; F.MISC[136 + e] = nf - (nb >> 1); if (nb & 1u) F.MISC[208 + (nh - 1u)] = (unsigned)e;
        if (e == NE - 1) { F.MISC[136 + NE] = nf; F.MISC[128] = nf; F.MISC[129] = nh; } }
    __syncthreads();
}
__device__ __forceinline__ void s7c_slots(Frame& F) {
    const int* ETOK = WSP(int, WS_SMALL + SM_ETOK); const int* RANK = WSP(int, WS_SMALL + SM_RANK); const float* GTOK = WSP(float, WS_SMALL + SM_GTOK); int* SLOT = WSP(int, WS_SMALL + SM_SLOT);
    moe_tables(F);
    for (int u = F.vcu; u < NREAL / 64; u += F.G) {
        if (F.tid < 128) { const int i = 2 * (u * 64) + F.tid; const int e = ETOK[i]; const int slot = (int)F.MISC[64 + e] * 128 + RANK[i];
            F.ctl[CW_TOKSLOT + slot] = (unsigned)(i >> 1); ((float*)F.ctl)[CW_GATESLOT + slot] = GTOK[i]; SLOT[i] = slot; }
    }
}
__device__ __forceinline__ void s10_combine(Frame& F) {
    int lane = __builtin_amdgcn_mbcnt_hi(~0u, __builtin_amdgcn_mbcnt_lo(~0u, 0u)); const int gw = F.vcu * NWAVES + F.wave, NGW = F.G * NWAVES;
    const bf16_t* H1HI = WSP(bf16_t, WS_H1HI); const bf16_t* H1LO = WSP(bf16_t, WS_H1LO); const bf16_t* Y = WSP(bf16_t, WS_Y); const int* SLOT = WSP(int, WS_SMALL + SM_SLOT);
    for (int t = gw; t < NREAL; t += NGW) {
        const int s0 = SLOT[2 * t], s1 = SLOT[2 * t + 1];
#pragma unroll 4
        for (int j = 0; j < 8; ++j) { const int col = (j * 64 + lane) * 8;
            const u32x4 a = *(const u32x4*)(H1HI + (size_t)t * DM + col), b = {0u, 0u, 0u, 0u}, y0 = *(const u32x4*)(Y + (size_t)s0 * DM + col), y1 = *(const u32x4*)(Y + (size_t)s1 * DM + col);
            f32x4 o0, o1;
#pragma unroll
            for (int q = 0; q < 2; ++q) { o0[2 * q] = (bf_lo(a[q]) + bf_lo(b[q])) + bf_lo(y0[q]) + bf_lo(y1[q]); o0[2 * q + 1] = (bf_hi(a[q]) + bf_hi(b[q])) + bf_hi(y0[q]) + bf_hi(y1[q]);
                o1[2 * q] = (bf_lo(a[2 + q]) + bf_lo(b[2 + q])) + bf_lo(y0[2 + q]) + bf_lo(y1[2 + q]); o1[2 * q + 1] = (bf_hi(a[2 + q]) + bf_hi(b[2 + q])) + bf_hi(y0[2 + q]) + bf_hi(y1[2 + q]); }
            *(f32x4*)(F.out + (size_t)t * DM + col) = o0; *(f32x4*)(F.out + (size_t)t * DM + col + 4) = o1; }
    }
}

struct FV { unsigned char* ws; unsigned* ctl; volatile LAS unsigned* MISC; int G, vcu; };
struct SchedS1 {
    static constexpr bool GATHER = false, HALF = false; FV f;
    __device__ __forceinline__ bool next(int i, pg8::GUnit& u) const {
        const int L = i * f.G + (int)blockIdx.x; if (L >= 65 * 11) return false;
        int pm, pn; pg8::tile_of(L, 65, 11, pm, pn);
        u.A = (const char*)(f.ws + WS_XB) + (size_t)pm * 256 * DM * 2; u.lda = DM * 2; u.B = (const char*)(f.ws + WS_WIN) + (size_t)pn * 256 * DM * 2; u.ldb = DM * 2; u.nk = DM / 64; u.gather = nullptr;
        u.C = (char*)(f.ws + WS_PROJ) + ((size_t)pm * 256 * INCP + pn * 256) * 2; u.ldc = INCP * 2; u.rs = nullptr; u.i0 = 0; u.i1 = 0; return true; }
};
struct SchedS3 {
    static constexpr bool GATHER = false, HALF = false; FV f; int only;
    __device__ __forceinline__ bool next(int i, pg8::GUnit& u) const {
        const int c = (int)blockIdx.x, G = f.G; int pm, pn; u.gather = nullptr; u.i0 = 0; u.i1 = 0;
        const int nq = c < 64 * 18 ? (64 * 18 - c + G - 1) / G : 0; int nkv = c < 65 * 24 ? (65 * 24 - c + G - 1) / G : 0, np = c < 65 * 4 ? (65 * 4 - c + G - 1) / G : 0;
        const bool bal = G == 256, grpA = c < 128;
        if (bal) { nkv = 5 + (grpA ? (c < 24 ? 1 : 0) : 2); np = grpA ? (c >= 24 ? 2 : 1) : (c - 128 < 65 * 4 - 232 ? 1 : 0); }
        const int m = nq < nkv ? nq : nkv; int type, j;
        if (only >= 0) { type = only; j = i; if (j >= (only == 0 ? nq : only == 1 ? nkv : np)) return false; }
        else if (i < 2 * m) { j = i >> 1; type = (i & 1) ^ ((c >> 3) & 1); }
        else { int r = i - 2 * m; if (r < nq - m) { type = 0; j = m + r; } else { r -= nq - m; if (r < nkv - m) { type = 1; j = m + r; } else { r -= nkv - m; if (r < np) { type = 2; j = r; } else return false; } } }
        int L = j * G + c + (type == 1 ? 64 * 18 : type == 2 ? 64 * 18 + 65 * 24 : 0);
        if (bal && type == 1 && j >= 5) L = 64 * 18 + (grpA ? 1536 + c : 1280 + (c - 128) + 128 * (j - 5));
        if (bal && type == 2) L = 64 * 18 + 65 * 24 + (grpA ? (c >= 24 ? 2 * (c - 24) + j : 208 + c) : 232 + (c - 128));
        if (L < 64 * 18) { pg8::tile_of(L, 64, 18, pm, pn); const int b = pm >> 5, r0 = b * LSEQ + NMETA + (pm & 31) * 256;
            u.A = (const char*)(f.ws + WS_PROJ) + ((size_t)r0 * INCP + POOLW) * 2; u.lda = INCP * 2; u.B = (const char*)(f.ws + WS_WUQ) + (size_t)pn * 256 * QLR * 2; u.ldb = QLR * 2; u.nk = QLR / 64;
            u.C = (char*)(f.ws + WS_Q) + ((size_t)pm * 256 * QW + pn * 256) * 2; u.ldc = QW * 2; u.rs = nullptr; return true; }
        L -= 64 * 18;
        if (L < 65 * 24) { pg8::tile_of(L, 65, 24, pm, pn);
            u.A = (const char*)(f.ws + WS_PROJ) + ((size_t)pm * 256 * INCP + POOLW + QLR) * 2; u.lda = INCP * 2; u.B = (const char*)(f.ws + WS_WUKV) + (size_t)pn * 256 * KVLR * 2; u.ldb = KVLR * 2; u.nk = KVLR / 64;
            u.C = nullptr; u.ldc = 0; u.rs = nullptr; u.i0 = pm * 256; u.i1 = 256 + pn; return true; }
        L -= 65 * 24;
        if (L < 65 * 4) { pm = L >> 2; pn = L & 3;
            u.A = (const char*)(f.ws + WS_DIFF) + ((size_t)pm * 256 * POOLW + pn * 256) * 2; u.lda = POOLW * 2; u.B = (const char*)(f.ws + WS_WP) + (size_t)pn * 65536 * 2; u.ldb = 256 * 2; u.nk = 4;
            u.C = (char*)(f.ws + WS_MIX) + ((size_t)pm * 256 * DM + pn * 256) * 2; u.ldc = DM * 2; u.rs = nullptr; return true; }
        return false; }
};
struct SchedS6 {
    static constexpr bool GATHER = false, HALF = false; FV f;
    __device__ __forceinline__ bool next(int i, pg8::GUnit& u) const {
        const int L = i * f.G + (int)blockIdx.x; if (L >= 64 * 16) return false;
        int pm, pn; pg8::tile_of(L, 64, 16, pm, pn); const int b = pm >> 5, r0 = b * LSEQ + NMETA + (pm & 31) * 256;
        u.A = (const char*)(f.ws + WS_MIX) + (size_t)r0 * DM * 2; u.lda = DM * 2; u.B = (const char*)(f.ws + WS_WO) + (size_t)pn * 256 * DM * 2; u.ldb = DM * 2; u.nk = DM / 64; u.gather = nullptr;
        u.C = nullptr; u.ldc = 0; u.rs = nullptr; u.i0 = pm * 256; u.i1 = pn; return true; }
};
__device__ __forceinline__ bool moe_unit(const FV& f, int L, int lct, int& e, int& slot0, int& ct, int& half) {
    const int nf = (int)f.MISC[128], nh = (int)f.MISC[129]; ct = L & ((1 << lct) - 1); int g = L >> lct;
    if (g < nf) { e = 0;
#pragma unroll
        for (int s = 32; s > 0; s >>= 1) { const int c = e + s; if ((int)f.MISC[136 + c] <= g) e = c; }
        slot0 = (int)f.MISC[64 + e] * 128 + (g - (int)f.MISC[136 + e]) * 256; half = 0; return true; }
    g -= nf; if (g >= nh) return false;
    e = (int)f.MISC[208 + g]; slot0 = (int)f.MISC[64 + e] * 128 + ((int)f.MISC[136 + e + 1] - (int)f.MISC[136 + e]) * 256; half = 1; return true;
}
struct MoeSplit { int u9, n9b, idle, E; };
__device__ __forceinline__ MoeSplit moe_split(const FV& f) {
    const int nt = (int)f.MISC[128] + (int)f.MISC[129]; MoeSplit m; m.u9 = 4 * nt; m.n9b = m.u9 - 2 * f.G; if (m.n9b < 0) m.n9b = 0;
    m.idle = f.G - m.n9b; if (m.idle < 0) m.idle = 0; if (m.n9b == 0) m.idle = 0;
    const int avail = 16 * (nt < f.G / 2 ? nt : f.G / 2); m.E = m.idle * 4 < avail ? m.idle * 4 : avail; return m;
}
struct SchedS8 {
    static constexpr bool GATHER = true, HALF = true; FV f; int base, rank, stride, limit;
    __device__ __forceinline__ bool next(int i, pg8::GUnit& u) const {
        const int L = base + i * stride + rank; if (L >= limit) return false;
        int e, slot0, ct, half; if (!moe_unit(f, L, 2, e, slot0, ct, half)) return false;
        u.A = (const char*)(f.ws + WS_H1HI); u.lda = DM * 2; u.gather = (const int*)(f.ctl + CW_TOKSLOT) + slot0;
        u.B = (const char*)(f.ws + WS_WGU) + ((size_t)e * 1024 + ct * 256) * DM * 2; u.ldb = DM * 2; u.nk = DM / 64;
        u.C = (char*)(f.ws + WS_HID) + ((size_t)slot0 * DE + ct * 128) * 2; u.ldc = DE * 2; u.rs = nullptr; u.i0 = slot0; u.i1 = half; return true; }
};
struct SchedS9 {
    static constexpr bool GATHER = false, HALF = true; FV f; int base, rank, stride, limit;
    __device__ __forceinline__ bool next(int i, pg8::GUnit& u) const {
        const int L = base + i * stride + rank; if (L >= limit) return false;
        int e, slot0, ct, half; if (!moe_unit(f, L, 4, e, slot0, ct, half)) return false;
        u.A = (const char*)(f.ws + WS_HID) + (size_t)slot0 * DE * 2; u.lda = DE * 2; u.gather = nullptr;
        u.B = (const char*)(f.ws + WS_WD) + ((size_t)e * DM + ct * 256) * DE * 2; u.ldb = DE * 2; u.nk = DE / 64;
        u.C = (char*)(f.ws + WS_Y) + ((size_t)slot0 * DM + ct * 256) * 2; u.ldc = DM * 2; u.rs = nullptr; u.i0 = slot0; u.i1 = half; return true; }
};

struct Args { const float* in[21]; float* out; unsigned char* ws; int ph_lo, ph_hi, li, pad; };
constexpr int N_PHASES = 12;
__global__ void __launch_bounds__(NWAVES * 64, 2) mk_fwd(Args args) {
    extern __shared__ __attribute__((aligned(16))) unsigned char lds_raw[];
    Frame F;
    F.lds = (LAS unsigned char*)lds_raw;
    F.MISC = (volatile LAS unsigned*)(F.lds + MISC_OFF);
    F.tid = threadIdx.x; F.lane = F.tid & 63; F.wave = __builtin_amdgcn_readfirstlane(F.tid >> 6);
    F.G = gridDim.x; { const int bx = blockIdx.x; F.vcu = (F.G % 8 == 0) ? (bx % 8) * (F.G / 8) + bx / 8 : bx; }
    F.ws = args.ws; F.ctl = (unsigned*)(args.ws + WS_CTL); F.out = args.out;
#pragma unroll
    for (int i = 0; i < 21; ++i) F.in[i] = args.in[i];
    for (int u = F.tid; u < 512; u += NWAVES * 64) ((LAS unsigned*)(F.lds + MISC_OFF))[u] = 0u;
    __syncthreads();
    XcdBarrier bar = xcd_barrier_post((unsigned*)(F.ctl + CW_BAR) + args.li * XCD_BAR_WORDS, F.MISC + 8);
    const int lo = args.ph_lo, hi = args.ph_hi;
    const FV fv{F.ws, F.ctl, F.MISC, F.G, F.vcu};
#ifdef ONLY_PHASE
#define IN(k) ((k) == ONLY_PHASE)
#else
#define IN(k) (lo <= (k) && (k) < hi)
#endif
#ifdef TS_SEL
#define STAMP(k) do { if (blockIdx.x == 0 && threadIdx.x == 0) F.MISC[300 + (k)] = (unsigned)__builtin_amdgcn_s_memrealtime(); } while (0)
#else
#define STAMP(k) do { } while (0)
#endif
#define SEAM(k) do { if (IN(k) && IN((k) + 1)) xcd_barrier(bar); STAMP((k) + 1); } while (0)
#ifndef DBL_PHASE
#define DBL_PHASE -1
#endif
#define REP(k) for (int rep_ = 0; rep_ < ((k) == DBL_PHASE ? 2 : 1); ++rep_)
    STAMP(0);
    if (IN(0)) REP(0) { p0_prologue(F); } SEAM(0);
    if (IN(1)) REP(1) { SchedS1 S{fv}; pg8::EpiScaleBf16L E; pg8::gemm_phase(F.lds, S, E);
        { const int rounds = (65 * 11 + F.G - 1) / F.G; int first = 65 * 11 - (rounds - 1) * F.G; if (first >= F.G || first < 0) first = 0; p1_deferred(F, first); } } SEAM(1);
    if (IN(2)) REP(2) { s2_phase(F); } SEAM(2);
    if (IN(3)) REP(3) { SchedS3 S{fv, -1}; pg8::EpiS3 E{WSP(float, WS_SMALL + SM_RSTDKV), WSP(float, WS_SMALL + SM_SSQPE), WSP(float, WS_KR), F.in[IN_KHG], WSP(bf16_t, WS_KF), WSP(bf16_t, WS_VB), (LAS float*)(F.lds + PTAB_OFF)}; pg8::gemm_phase(F.lds, S, E);
#ifdef DBL3T
        { SchedS3 S2{fv, DBL3T}; pg8::gemm_phase(F.lds, S2, E); }
#endif
    }
    if (IN(3) && IN(5)) xcd_barrier(bar); STAMP(4); STAMP(5);
    if (IN(5)) REP(5) {
        const bf16_t* Q = WSP(bf16_t, WS_Q); const bf16_t* KF = WSP(bf16_t, WS_KF); const bf16_t* KV = WSP(bf16_t, WS_VB); bf16_t* MIX = WSP(bf16_t, WS_MIX); const float* gq = F.in[IN_QHG]; const float* rope = WSP(float, WS_ROPE);
        att::ConvCtx cv; cv.ci = 0; cv.cd = 0; cv.bi = 0; cv.bd = 0; cv.base_it = F.vcu; cv.stride = F.G; cv.n = (TI_EXP - F.vcu + F.G - 1) / F.G;
        cv.wg = F.in[IN_WGATE]; cv.wu = F.in[IN_WUP]; cv.wd = F.in[IN_WDOWN]; cv.fg = F.in[IN_FFNG]; cv.WGU = WSP(bf16_t, WS_WGU); cv.WDn = WSP(bf16_t, WS_WD);
        if (rep_ > 0) cv.n = 0;
#ifdef ATT_PROBE
        cv.pb[0] = cv.pb[1] = cv.pb[2] = cv.pb[3] = 0; { unsigned long long t_; asm volatile("s_memrealtime %0\n\ts_waitcnt lgkmcnt(0)" : "=s"(t_) :: "memory"); cv.pbl = (unsigned)t_; }
#endif
        for (int it = F.vcu; it < 768; it += F.G) { const int bh = it >> 4, s = it & 15;
            att::attn_unit(bh / NH, bh % NH, 31 - s, Q, KF, KV, MIX, gq, rope, cv, (LAS char*)F.lds);
            att::attn_unit(bh / NH, bh % NH, s, Q, KF, KV, MIX, gq, rope, cv, (LAS char*)F.lds); }
        while (cv.ci < cv.n) { const unsigned lds0 = (unsigned)(uintptr_t)(LAS char*)F.lds;
            (void)att::conv_dma_step(cv, lds0, F.wave, F.lane); asm volatile("s_waitcnt vmcnt(0)" ::: "memory");
            att::conv_proc_step(cv, (LAS char*)F.lds, F.wave, F.lane); att::conv_dma_end(cv);
            asm volatile("s_waitcnt vmcnt(0) lgkmcnt(0)\n\ts_barrier" ::: "memory"); }
#ifdef ATT_PROBE
        { unsigned long long t_; asm volatile("s_memrealtime %0\n\ts_waitcnt lgkmcnt(0)" : "=s"(t_) :: "memory"); cv.pb[3] += (unsigned)t_ - cv.pbl; }
        if (blockIdx.x == ATT_PROBE_BLK && F.wave == ATT_PROBE_WAVE && F.lane == 0) { const float tot = (float)(cv.pb[0] + cv.pb[1] + cv.pb[2] + cv.pb[3]);
            F.MISC[320] = __float_as_uint(ATT_PROBE == 9 ? tot * 0.01f : 250.f * (float)cv.pb[ATT_PROBE & 3] / tot); }
#endif
    } SEAM(5);
    if (IN(6)) REP(6) { SchedS6 S{fv}; pg8::EpiWout E{F.in[IN_X], WSP(bf16_t, WS_H1HI), WSP(bf16_t, WS_H1LO), WSP(float, WS_SSQ2)}; pg8::gemm_phase(F.lds, S, E); } SEAM(6);
    if (IN(7)) { s7_route(F); } SEAM(7);
    if (IN(8)) { s7c_slots(F); } SEAM(8);
    if (IN(9)) REP(9) { moe_tables(F); const MoeSplit ms = moe_split(fv); const pg8::EpiMoe1 E9{WSP(float, WS_SMALL + SM_RSTD2), (const float*)(F.ctl + CW_GATESLOT)};
        { SchedS8 S{fv, 0, F.vcu, F.G, ms.u9 < 2 * F.G ? ms.u9 : 2 * F.G}; pg8::gemm_phase(F.lds, S, E9); }
        if (ms.n9b > 0) { xcd_barrier(bar);
            if (F.vcu < ms.n9b) { SchedS8 S{fv, 2 * F.G, F.vcu, F.G, ms.u9}; pg8::gemm_phase(F.lds, S, E9); }
            else if (ms.E > 0) { SchedS9 S{fv, 0, F.vcu - ms.n9b, ms.idle, ms.E}; pg8::EpiScaleBf16L E; pg8::gemm_phase(F.lds, S, E); } }
    } SEAM(9);
    if (IN(10)) REP(10) { moe_tables(F); const MoeSplit ms = moe_split(fv); SchedS9 S{fv, ms.E, F.vcu, F.G, 0x7fffffff};
        { pg8::EpiScaleBf16L E; pg8::gemm_phase(F.lds, S, E); }
#ifdef DBLM
        xcd_barrier(bar);
        if (DBLM == 0) { SchedS9 S2{fv, 0, F.vcu, F.G, 1024}; pg8::EpiScaleBf16L E; pg8::gemm_phase(F.lds, S2, E); }
        if (DBLM == 1) { const int nf4 = 4 * (int)F.MISC[128]; SchedS8 S2{fv, nf4, F.vcu, F.G, nf4 + F.G}; const pg8::EpiMoe1 E9{WSP(float, WS_SMALL + SM_RSTD2), (const float*)(F.ctl + CW_GATESLOT)}; pg8::gemm_phase(F.lds, S2, E9); }
        if (DBLM == 2) { SchedS8 S2{fv, 0, F.vcu, F.G, F.G}; const pg8::EpiMoe1 E9{WSP(float, WS_SMALL + SM_RSTD2), (const float*)(F.ctl + CW_GATESLOT)}; pg8::gemm_phase(F.lds, S2, E9); }
#endif
    } SEAM(10);
    if (IN(11)) REP(11) { s10_combine(F); }
#ifdef ATT_PROBE
    __syncthreads();
    if (blockIdx.x == ATT_PROBE_BLK && threadIdx.x == 0) { asm volatile("s_waitcnt vmcnt(0)" ::: "memory"); F.out[0] += __uint_as_float(F.MISC[320]); }
#endif
#ifdef TS_SEL
    if (blockIdx.x == 0 && threadIdx.x == 0) { const unsigned t1 = (unsigned)__builtin_amdgcn_s_memrealtime(); F.MISC[312] = t1;
        const unsigned d = (TS_SEL == 99) ? (F.MISC[312] - F.MISC[300]) : (F.MISC[300 + TS_SEL + 1] - F.MISC[300 + TS_SEL]);
        asm volatile("s_waitcnt vmcnt(0)" ::: "memory"); F.out[0] += (float)d * (10.f / (float)TS_UNIT_NS); }
#endif
#undef IN
#undef SEAM
}

extern "C" void kernel_launch(void* const* d_in, const int* in_sizes, int n_in, void* d_out, int out_size, void* d_ws, size_t ws_size, hipStream_t stream) {
    static int grid = 0;
    if (grid == 0) {
        if (n_in != 21 || out_size != NREAL * DM || ws_size < WS_END) { fprintf(stderr, "kernel_launch: unexpected shapes (n_in %d out %d ws %zu)\n", n_in, out_size, ws_size); grid = -1; return; }
        int dev = 0, cus = 0, per_cu = 0;
        if (hipGetDevice(&dev) != hipSuccess || hipDeviceGetAttribute(&cus, hipDeviceAttributeMultiprocessorCount, dev) != hipSuccess) { grid = -1; return; }
        if (hipFuncSetAttribute((const void*)mk_fwd, hipFuncAttributeMaxDynamicSharedMemorySize, LDS_BYTES) != hipSuccess) { fprintf(stderr, "kernel_launch: hipFuncSetAttribute failed\n"); grid = -1; return; }
        if (hipOccupancyMaxActiveBlocksPerMultiprocessor(&per_cu, (const void*)mk_fwd, NWAVES * 64, LDS_BYTES) != hipSuccess || per_cu < 1) fprintf(stderr, "kernel_launch: occupancy query says %d\n", per_cu);
        (void)hipGetLastError();
        grid = cus;
    }
    if (grid < 0) return;
    (void)hipMemsetAsync((char*)d_ws + WS_CTL, 0, CTL_ZERO_BYTES, stream);
    Args a{};
    for (int i = 0; i < 21; ++i) a.in[i] = (const float*)d_in[i];
    a.out = (float*)d_out; a.ws = (unsigned char*)d_ws; a.ph_lo = 0; a.ph_hi = N_PHASES; a.li = 0; a.pad = 0;
    hipLaunchKernelGGL(mk_fwd, dim3(grid), dim3(NWAVES * 64), LDS_BYTES, stream, a);
}
```

```cpp
#include <hip/hip_runtime.h>
#include <hip/hip_bf16.h>
#include <cstdio>
#include <cstdint>

#define LAS __attribute__((address_space(3)))
#define GAS __attribute__((address_space(1)))
typedef unsigned short bf16_t;
typedef short bf16x8 __attribute__((ext_vector_type(8)));
typedef short s16x4 __attribute__((ext_vector_type(4)));
typedef float f32x4 __attribute__((ext_vector_type(4)));
typedef float f32x2 __attribute__((ext_vector_type(2)));
typedef float f32x16 __attribute__((ext_vector_type(16)));
typedef unsigned u32x4 __attribute__((ext_vector_type(4)));
typedef unsigned u32x2 __attribute__((ext_vector_type(2)));

constexpr int DM = 4096, NB = 2, SEQ = 8192, NMETA = 16, LSEQ = SEQ + NMETA  , NTOK = NB * LSEQ  , NREAL = NB * SEQ  ;
constexpr int MPAD = 16640;
constexpr int POOLW = 1024, QLR = 1024, KVLR = 512, ROPE = 64, INC = 2624, INCP = 2816;
constexpr int NH = 24, DQK = 192, DNOPE = 128, DV = 128, QW = NH * DQK  , KVW = NH * 256  ;
constexpr int NG = 8, NE = 64, DE = 512;
constexpr int NSLOT = 49152;
constexpr float EPS = 1e-6f;
constexpr float QSCALE = 0.07216878364870322f * 1.4426950408889634f;

constexpr size_t MiB = 1u << 20;
constexpr size_t WS_CTL = 0, CTL_ZERO_BYTES = 1 * MiB;
constexpr size_t WS_WIN = 1 * MiB;
constexpr size_t WS_WUQ = 23 * MiB;
constexpr size_t WS_WUKV = 32 * MiB;
constexpr size_t WS_WP = 38 * MiB;
constexpr size_t WS_WRT = 38 * MiB + 512 * 1024;
constexpr size_t WS_WO = 40 * MiB;
constexpr size_t WS_WGU = 72 * MiB;
constexpr size_t WS_WD = 584 * MiB;
constexpr size_t WS_ROPE = 840 * MiB;
constexpr size_t WS_SMALL = 843 * MiB;
constexpr size_t WS_XB = 846 * MiB;
constexpr size_t WS_PROJ = 976 * MiB;
constexpr size_t WS_DIFF = 1066 * MiB;
constexpr size_t WS_Q = 1099 * MiB;
constexpr size_t WS_KV = 1243 * MiB;
constexpr size_t WS_KF = 1438 * MiB;
constexpr size_t WS_MIX = 1585 * MiB;
constexpr size_t WS_VB = 1715 * MiB;
constexpr size_t WS_KR = 1813 * MiB;
constexpr size_t WS_END = 1818 * MiB;
constexpr size_t WS_H1HI = 846 * MiB;
constexpr size_t WS_H1LO = 974 * MiB;
constexpr size_t WS_SSQ2 = 1102 * MiB;
constexpr size_t WS_HID = 1106 * MiB;
constexpr size_t WS_Y = 1154 * MiB;
constexpr size_t SM_RSTD1 = 0, SM_RSTDQ = 128 * 1024, SM_RSTDKV = 256 * 1024, SM_RSTD2 = 384 * 1024, SM_ETOK = 512 * 1024, SM_RANK = 640 * 1024, SM_GTOK = 768 * 1024, SM_SLOT = 896 * 1024, SM_SSQPE = 1024 * 1024;
constexpr int CW_TMO = 0, CW_BAR = 4096, CW_CNT = 8192, CW_TOKSLOT = 16384, CW_GATESLOT = 65536;
static_assert((CW_GATESLOT + NSLOT) * 4 <= (int)CTL_ZERO_BYTES, "CTL");

constexpr int RING_BYTES = 131072;
constexpr int PTAB_OFF = 133120;
constexpr int CONV_OFF = 124928;
constexpr int MISC_OFF = 157696;
constexpr int LDS_BYTES = 159744;

#define RLX_AGENT __ATOMIC_RELAXED, __HIP_MEMORY_SCOPE_AGENT
#define LDS_WAIT() asm volatile("s_waitcnt lgkmcnt(0)" ::: "memory")
#define VM_WAIT() asm volatile("s_waitcnt vmcnt(0)" ::: "memory")

__device__ __forceinline__ unsigned cvt_pk_bf16(float lo, float hi) { unsigned r; asm volatile("v_cvt_pk_bf16_f32 %0, %1, %2" : "=v"(r) : "v"(lo), "v"(hi)); return r; }
__device__ __forceinline__ float bf_lo(unsigned w) { return __uint_as_float(w << 16); }
__device__ __forceinline__ float bf_hi(unsigned w) { return __uint_as_float(w & 0xffff0000u); }
__device__ __forceinline__ float wave_sum(float v) {
#pragma unroll
    for (int o = 1; o < 64; o <<= 1) v += __shfl_xor(v, o);
    return v;
}

#define XB_TMO      128
#define XB_XCNT(j)  (256  + 64 * (j))
#define XB_XSUB(j)  (1280 + 64 * (j))
#define XB_XGEN(j)  (2304 + 64 * (j))
#define XB_TOP      3328
#define XB_TOPGEN   3392
#define XCD_BAR_WORDS 3456
#define XB_SPIN_CAP (1u << 18)
__device__ __forceinline__ unsigned xb_ld(unsigned* p)              { return __hip_atomic_load(p, __ATOMIC_RELAXED, __HIP_MEMORY_SCOPE_AGENT); }
__device__ __forceinline__ unsigned xb_add(unsigned* p, unsigned v) { return __hip_atomic_fetch_add(p, v, __ATOMIC_RELAXED, __HIP_MEMORY_SCOPE_AGENT); }
__device__ __forceinline__ unsigned xb_xcc_id() { return (unsigned)__builtin_amdgcn_s_getreg((3 << 11) | 20) & 0xFu; }
#define XB_SPIN(cond, bar) do { unsigned _sp = 0; while (cond) { __builtin_amdgcn_s_sleep(1); \
    if ((++_sp & 255u) == 0u) { if (xb_ld(&(bar)[XB_TMO])) break; if (_sp > XB_SPIN_CAP) { atomicAdd(&(bar)[XB_TMO], 1u); break; } } } } while (0)
struct XcdBarrier { unsigned* bar; unsigned x; volatile LAS unsigned* st; };
__device__ __forceinline__ XcdBarrier xcd_barrier_post(unsigned* bar, volatile LAS unsigned* st) {
    XcdBarrier b; b.bar = bar; b.x = xb_xcc_id(); b.st = st;
    if (threadIdx.x == 0) (void)xb_add(&bar[XB_XCNT(b.x)], 1u);
    return b;
}
__device__ __forceinline__ void xcd_barrier_complete(unsigned* bar, unsigned x, unsigned& nloc, unsigned& nx) {
    const unsigned G = gridDim.x * gridDim.y * gridDim.z;
    unsigned sum, cnt, mine, sp = 0u;
    for (;;) {
        sum = 0u; cnt = 0u; mine = 0u;
#pragma unroll
        for (unsigned j = 0; j < 16; ++j) { const unsigned c = xb_ld(&bar[XB_XCNT(j)]); sum += c; cnt += (c > 0u) ? 1u : 0u; mine = (j == x) ? c : mine; }
        if (sum == G) break;
        __builtin_amdgcn_s_sleep(1);
        if ((++sp & 255u) == 0u) { if (xb_ld(&bar[XB_TMO])) break; if (sp > XB_SPIN_CAP) { atomicAdd(&bar[XB_TMO], 1u); break; } }
    }
    nloc = mine > 0u ? mine : 1u; nx = cnt > 0u ? cnt : 1u;
}
__device__ __forceinline__ void xcd_barrier(const XcdBarrier& b) {
    asm volatile("s_waitcnt vmcnt(0)" ::: "memory");
    __syncthreads();
    if (threadIdx.x == 0) {
        unsigned* bar = b.bar;
        __builtin_amdgcn_s_waitcnt(0);
        unsigned nloc = b.st[0], nx = b.st[1];
        if (nloc == 0u) { xcd_barrier_complete(bar, b.x, nloc, nx); b.st[0] = nloc; b.st[1] = nx; }
        const unsigned old = xb_add(&bar[XB_XSUB(b.x)], 1u);
        const unsigned gen = old / nloc;
        if (old + 1u == (gen + 1u) * nloc) {
            __builtin_amdgcn_fence(__ATOMIC_RELEASE, "agent");
            asm volatile("s_waitcnt vmcnt(0)" ::: "memory");
            const unsigned og = xb_add(&bar[XB_TOP], 1u);
            const unsigned tg = og / nx;
            if (og + 1u == (tg + 1u) * nx) xb_add(&bar[XB_TOPGEN], 1u);
            else XB_SPIN(xb_ld(&bar[XB_TOPGEN]) == tg, bar);
            __builtin_amdgcn_fence(__ATOMIC_ACQUIRE, "agent");
            xb_add(&bar[XB_XGEN(b.x)], 1u);
            asm volatile("s_waitcnt vmcnt(0)" ::: "memory");
        } else {
            XB_SPIN(xb_ld(&bar[XB_XGEN(b.x)]) == gen, bar);
            __builtin_amdgcn_fence(__ATOMIC_ACQUIRE, "agent");
            asm volatile("s_waitcnt vmcnt(0)" ::: "memory");
        }
    }
    __syncthreads();
}

namespace pg8 {
constexpr int BM = 256, BK = 64, HALF = 128, HTB = HALF * BK * 2, STAGE_BYTES = 8 * HTB, NXCD = 8, WGM = 8;
__host__ __device__ __forceinline__ int lds_byte(int r, int c) { const int st = (r >> 4) * 2 + (c >> 5), rr = r & 15, cc = c & 31, ob = rr * 64 + cc * 2; return st * 1024 + (ob ^ (((ob >> 9) & 1) << 5)); }
__host__ __device__ __forceinline__ void stage_rc(int b, int& R, int& C) { const int st = b / 1024, sb = b % 1024, swz = sb ^ (((sb >> 9) & 1) << 5); R = (st >> 1) * 16 + swz / 64; C = (st & 1) * 32 + (swz % 64) / 2; }
__host__ __device__ __forceinline__ int perm32(int rho) { const int n = rho >> 4, i = rho & 15; return 8 * (i >> 2) + 4 * n + (i & 3); }

__device__ __forceinline__ void tile_of(int L, int nM, int nN, int& pm, int& pn) {
    const int nwg = nM * nN; int wgid = L;
    { const int q = nwg / NXCD, r = nwg % NXCD, xcd = wgid % NXCD, off = wgid / NXCD; wgid = (xcd < r ? xcd * (q + 1) : r * (q + 1) + (xcd - r) * q) + off; }
    const int nig = WGM * nN, gid = wgid / nig, fm = gid * WGM, gsz = (nM - fm) < WGM ? (nM - fm) : WGM;
    pm = fm + ((wgid % nig) % gsz); pn = (wgid % nig) / gsz;
}

struct GUnit {
    const char* A;
    const char* B;
    unsigned lda, ldb;
    int nk;
    const int* gather;
    char* C; unsigned ldc;
    const float* rs;
    int i0, i1;
};

struct EpiScaleBf16 {
    static constexpr bool PERM = true, BMAP = false;
    __device__ __forceinline__ void operator()(const f32x4 (&acc)[2][2][4][2], const GUnit& u, int wr, int wc, int fr, int fq) const {
#pragma unroll
        for (int ai = 0; ai < 2; ++ai)
#pragma unroll
            for (int m = 0; m < 4; ++m) { const int r = ai * HALF + wr * 64 + m * 16 + fr; const float s = u.rs ? u.rs[r] : 1.f;
                char* rowp = u.C + (size_t)r * u.ldc + (wc * 32 + 8 * fq) * 2;
#pragma unroll
                for (int bj = 0; bj < 2; ++bj) { const f32x4 v0 = acc[ai][bj][m][0] * s, v1 = acc[ai][bj][m][1] * s;
                    u32x4 w; w.x = cvt_pk_bf16(v0[0], v0[1]); w.y = cvt_pk_bf16(v0[2], v0[3]); w.z = cvt_pk_bf16(v1[0], v1[1]); w.w = cvt_pk_bf16(v1[2], v1[3]);
                    *(u32x4*)(rowp + bj * HALF * 2) = w; } }
    }
};
struct EpiScaleBf16L {
    static constexpr bool PERM = true, BMAP = true;
    __device__ __forceinline__ void operator()(const f32x4 (&acc)[2][2][4][2], const GUnit& u, int wr, int wc, int fr, int fq) const {
#pragma unroll
        for (int ai = 0; ai < 2; ++ai) { if (ai == 1 && u.i1) break;
#pragma unroll
            for (int m = 0; m < 4; ++m) { const int r = ai * HALF + wr * 64 + m * 16 + fr;
                char* rowp = u.C + (size_t)r * u.ldc + (wc * 64 + 8 * fq) * 2;
#pragma unroll
                for (int bj = 0; bj < 2; ++bj) { const f32x4 v0 = acc[ai][bj][m][0], v1 = acc[ai][bj][m][1];
                    u32x4 w; w.x = cvt_pk_bf16(v0[0], v0[1]); w.y = cvt_pk_bf16(v0[2], v0[3]); w.z = cvt_pk_bf16(v1[0], v1[1]); w.w = cvt_pk_bf16(v1[2], v1[3]);
                    *(u32x4*)(rowp + bj * 64) = w; } } }
    }
};
struct EpiS3 {
    static constexpr bool PERM = true, BMAP = false;
    const float* rstdkv; const float* ssqpe; const float* kr; const float* gk; bf16_t* KF; bf16_t* VB; LAS float* P;
    __device__ __forceinline__ void operator()(const f32x4 (&acc)[2][2][4][2], const GUnit& u, int wr, int wc, int fr, int fq) const {
        if ((u.i1 >> 8) == 0) { EpiScaleBf16 e; e(acc, u, wr, wc, fr, fq); return; }
        const int h = u.i1 & 255; const size_t row0 = (size_t)u.i0;
#pragma unroll
        for (int ai = 0; ai < 2; ++ai)
#pragma unroll
            for (int m = 0; m < 4; ++m) { const int r = ai * HALF + wr * 64 + m * 16 + fr; float s = 0.f;
#pragma unroll
                for (int n = 0; n < 2; ++n) { const f32x4 v = acc[ai][0][m][n]; s += (v[0] * v[0] + v[1] * v[1]) + (v[2] * v[2] + v[3] * v[3]); }
                s += __shfl_xor(s, 16); s += __shfl_xor(s, 32);
                if (fq == 0) P[r * 4 + wc] = s; }
        asm volatile("s_waitcnt lgkmcnt(0)" ::: "memory"); __builtin_amdgcn_s_barrier(); asm volatile("" ::: "memory");
        const int c0 = wc * 32 + 8 * fq;
        const f32x4 g0 = *(const f32x4*)(gk + c0), g1 = *(const f32x4*)(gk + c0 + 4);
        float sp8[8];
#pragma unroll
        for (int g = 0; g < 8; ++g) sp8[g] = ssqpe[row0 + (g >> 2) * HALF + wr * 64 + (g & 3) * 16 + fr];
        const int tid2 = (wr * 4 + wc) * 64 + fq * 16 + fr, rr2 = tid2 >> 1, hf2 = tid2 & 1;
        const float spr = ssqpe[row0 + rr2]; f32x4 krv[8];
        { const float* src = kr + (row0 + rr2) * 64 + 32 * hf2;
#pragma unroll
          for (int q = 0; q < 8; ++q) krv[q] = *(const f32x4*)(src + 4 * q); }
#pragma unroll
        for (int ai = 0; ai < 2; ++ai)
#pragma unroll
            for (int m = 0; m < 4; ++m) { const int r = ai * HALF + wr * 64 + m * 16 + fr; const float rs = 1.f;
                const f32x4 pp = *(const LAS f32x4*)(P + r * 4);
                const float rh = rsqrtf((((pp[0] + pp[1]) + (pp[2] + pp[3])) * rs * rs + sp8[ai * 4 + m]) * (1.f / DQK) + EPS);
                const float a = rs * rh; const f32x4 k0 = acc[ai][0][m][0] * a * g0, k1 = acc[ai][0][m][1] * a * g1, v0 = acc[ai][1][m][0] * rs, v1 = acc[ai][1][m][1] * rs;
                u32x4 w; w.x = cvt_pk_bf16(k0[0], k0[1]); w.y = cvt_pk_bf16(k0[2], k0[3]); w.z = cvt_pk_bf16(k1[0], k1[1]); w.w = cvt_pk_bf16(k1[2], k1[3]);
                *(u32x4*)(KF + (row0 + r) * QW + h * DQK + c0) = w;
                w.x = cvt_pk_bf16(v0[0], v0[1]); w.y = cvt_pk_bf16(v0[2], v0[3]); w.z = cvt_pk_bf16(v1[0], v1[1]); w.w = cvt_pk_bf16(v1[2], v1[3]);
                *(u32x4*)(VB + (row0 + r) * (NH * DV) + h * DV + c0) = w; }
        { const f32x4 pp = *(const LAS f32x4*)(P + rr2 * 4);
          const float rh = rsqrtf((((pp[0] + pp[1]) + (pp[2] + pp[3])) + spr) * (1.f / DQK) + EPS);
          bf16_t* dst = KF + (row0 + rr2) * QW + h * DQK + DNOPE + 32 * hf2;
#pragma unroll
          for (int q = 0; q < 4; ++q) { const f32x4 a = krv[2 * q] * rh, b = krv[2 * q + 1] * rh;
              u32x4 w; w.x = cvt_pk_bf16(a[0], a[1]); w.y = cvt_pk_bf16(a[2], a[3]); w.z = cvt_pk_bf16(b[0], b[1]); w.w = cvt_pk_bf16(b[2], b[3]);
              *(u32x4*)(dst + 8 * q) = w; } }
    }
};
struct EpiNone { static constexpr bool PERM = true, BMAP = false; __device__ __forceinline__ void operator()(const f32x4 (&acc)[2][2][4][2], const GUnit& u, int wr, int wc, int fr, int fq) const { float x = acc[0][0][0][0][0] + acc[1][1][3][1][3]; asm volatile("" :: "v"(x)); } };
struct EpiProbeA {
    static constexpr bool PERM = true, BMAP = true; char* scr;
    __device__ __forceinline__ void operator()(const f32x4 (&acc)[2][2][4][2], const GUnit& u, int wr, int wc, int fr, int fq) const {
        GUnit v = u; v.C = scr + (size_t)blockIdx.x * 131072; v.ldc = 512; EpiScaleBf16L e; e(acc, v, wr, wc, fr, fq); }
};
struct EpiWout {
    static constexpr bool PERM = true, BMAP = false;
    const float* x; bf16_t* hi; bf16_t* lo; float* ssq;
    __device__ __forceinline__ void operator()(const f32x4 (&acc)[2][2][4][2], const GUnit& u, int wr, int wc, int fr, int fq) const {
        const int c0 = u.i1 * BM + wc * 32 + 8 * fq;
        const size_t rbase = (size_t)u.i0 + wr * 64 + fr;
        f32x4 xa[4], xb[4];
#define EW_LOAD(X_, g_) do { const size_t off_ = (rbase + ((g_) >> 2) * HALF + ((g_) & 3) * 16) * DM + c0; \
            X_[0] = *(const f32x4*)(x + off_); X_[1] = *(const f32x4*)(x + off_ + 4); X_[2] = *(const f32x4*)(x + off_ + HALF); X_[3] = *(const f32x4*)(x + off_ + HALF + 4); } while (0)
#define EW_PROC(X_, g_) do { const int ai_ = (g_) >> 2, m_ = (g_) & 3; const size_t row_ = rbase + ai_ * HALF + m_ * 16; float sq = 0.f; \
            _Pragma("unroll") for (int bj = 0; bj < 2; ++bj) { const size_t off = row_ * DM + c0 + bj * HALF; \
                const f32x4 v0 = acc[ai_][bj][m_][0] + X_[2 * bj], v1 = acc[ai_][bj][m_][1] + X_[2 * bj + 1]; \
                sq += (v0[0] * v0[0] + v0[1] * v0[1]) + (v0[2] * v0[2] + v0[3] * v0[3]) + (v1[0] * v1[0] + v1[1] * v1[1]) + (v1[2] * v1[2] + v1[3] * v1[3]); \
                u32x4 w; w.x = cvt_pk_bf16(v0[0], v0[1]); w.y = cvt_pk_bf16(v0[2], v0[3]); w.z = cvt_pk_bf16(v1[0], v1[1]); w.w = cvt_pk_bf16(v1[2], v1[3]); \
                *(u32x4*)(hi + off) = w; } \
            sq += __shfl_xor(sq, 16); sq += __shfl_xor(sq, 32); \
            if (fq == 0) ssq[row_ * 64 + u.i1 * 4 + wc] = sq; } while (0)
        EW_LOAD(xa, 0); EW_LOAD(xb, 1);
        EW_PROC(xa, 0); EW_LOAD(xa, 2); EW_PROC(xb, 1); EW_LOAD(xb, 3);
        EW_PROC(xa, 2); EW_LOAD(xa, 4); EW_PROC(xb, 3); EW_LOAD(xb, 5);
        EW_PROC(xa, 4); EW_LOAD(xa, 6); EW_PROC(xb, 5); EW_LOAD(xb, 7);
        EW_PROC(xa, 6); EW_PROC(xb, 7);
#undef EW_LOAD
#undef EW_PROC
    }
};
struct EpiMoe1 {
    static constexpr bool PERM = true, BMAP = false;
    const float* rstd2; const float* gate;
    __device__ __forceinline__ void operator()(const f32x4 (&acc)[2][2][4][2], const GUnit& u, int wr, int wc, int fr, int fq) const {
        float sc[8], gt[8];
#pragma unroll
        for (int g = 0; g < 8; ++g) { const int r = (g >> 2) * HALF + wr * 64 + (g & 3) * 16 + fr; sc[g] = __int_as_float(u.gather[r]); gt[g] = gate[u.i0 + r]; }
#pragma unroll
        for (int g = 0; g < 8; ++g) sc[g] = rstd2[__float_as_int(sc[g])];
#pragma unroll
        for (int ai = 0; ai < 2; ++ai) { if (ai == 1 && u.i1) break;
#pragma unroll
            for (int m = 0; m < 4; ++m) { const int r = ai * HALF + wr * 64 + m * 16 + fr; const float s = sc[ai * 4 + m], gg = gt[ai * 4 + m];
                float h[8];
#pragma unroll
                for (int n = 0; n < 2; ++n)
#pragma unroll
                    for (int j = 0; j < 4; ++j) { const float g = acc[ai][0][m][n][j] * s, up = acc[ai][1][m][n][j] * s;
                        h[n * 4 + j] = g * __builtin_amdgcn_rcpf(1.f + __builtin_amdgcn_exp2f(-1.4426950408889634f * g)) * up * gg; }
                u32x4 w; w.x = cvt_pk_bf16(h[0], h[1]); w.y = cvt_pk_bf16(h[2], h[3]); w.z = cvt_pk_bf16(h[4], h[5]); w.w = cvt_pk_bf16(h[6], h[7]);
                *(u32x4*)(u.C + (size_t)r * u.ldc + (wc * 32 + 8 * fq) * 2) = w; } }
    }
};

template <class Epi, class Sched>
__device__ __forceinline__ void gemm_phase(LAS unsigned char* lds, const Sched& S, const Epi& E) {
    const int tid = threadIdx.x, wid = __builtin_amdgcn_readfirstlane(tid >> 6), lane = tid & 63, wr = wid >> 2, wc = wid & 3, fr = lane & 15, fq = lane >> 4;
    const unsigned ldsw = (unsigned)wid * 1024u;
    const int aoff = lds_byte(wr * 64 + fr, fq * 8), boff = lds_byte(wc * 32 + fr, fq * 8);
#define PG8_SA(b, h) (((b) * 2 + (h)) * HTB)
#define PG8_SB(b, h) ((4 + (b) * 2 + (h)) * HTB)
#define PG8_STAGE(bufoff, gbase, voff) do { _Pragma("unroll") for (int _i = 0; _i < 2; ++_i) \
        __builtin_amdgcn_global_load_lds((const unsigned*)((const char*)(gbase) + (voff)[_i]), (LAS unsigned*)(lds + (bufoff) + ldsw + _i * 8192), 16, 0, 0); } while (0)
#define PG8_LDA(dst, b, h) do { _Pragma("unroll") for (int m = 0; m < 4; ++m) _Pragma("unroll") for (int k = 0; k < 2; ++k) dst[m][k] = *(const LAS bf16x8*)(lds + PG8_SA(b, h) + aoff + m * 2048 + k * 1024); } while (0)
#define PG8_LDB(dst, b, h) do { _Pragma("unroll") for (int n = 0; n < 2; ++n) _Pragma("unroll") for (int k = 0; k < 2; ++k) dst[n][k] = *(const LAS bf16x8*)(lds + PG8_SB(b, h) + boff + n * 2048 + k * 1024); } while (0)
#define PG8_MMA(ai, bj, At, Bt) do { __builtin_amdgcn_s_setprio(1); _Pragma("unroll") for (int m = 0; m < 4; ++m) _Pragma("unroll") for (int n = 0; n < 2; ++n) _Pragma("unroll") for (int k = 0; k < 2; ++k) \
        acc[ai][bj][m][n] = __builtin_amdgcn_mfma_f32_16x16x32_bf16(Bt[n][k], At[m][k], acc[ai][bj][m][n], 0, 0, 0); __builtin_amdgcn_s_setprio(0); } while (0)
#define PG8_WAIT_V(n) asm volatile("s_waitcnt vmcnt(" #n ")" ::: "memory")
#define PG8_WAIT_L(n) asm volatile("s_waitcnt lgkmcnt(" #n ")" ::: "memory")
#define PG8_BAR __builtin_amdgcn_s_barrier()
#define PG8_SCHED __builtin_amdgcn_sched_barrier(0)
#define PG8_OFFS(u, gi0, gi1) do { _Pragma("unroll") for (int _i = 0; _i < 2; ++_i) { int R_, C_; stage_rc(tid * 16 + _i * 8192, R_, C_); \
        const int Rb_ = Epi::BMAP ? (64 * (R_ >> 5) + perm32(R_ & 31)) : (Epi::PERM ? ((R_ & ~31) + perm32(R_ & 31)) : R_); int r0_ = R_, r1_ = HALF + R_; if (Sched::GATHER) { r0_ = gi0[_i]; r1_ = gi1[_i]; } \
        vA0[_i] = (unsigned)r0_ * (u).lda + (unsigned)C_ * 2u; vA1[_i] = (unsigned)r1_ * (u).lda + (unsigned)C_ * 2u; \
        vB[_i] = (unsigned)Rb_ * (u).ldb + (unsigned)C_ * 2u; } hsB = (unsigned)(Epi::BMAP ? 32 : HALF) * (u).ldb; } while (0)
#define PG8_GIDX(u, gi0, gi1) do { if (Sched::GATHER) { _Pragma("unroll") for (int _i = 0; _i < 2; ++_i) { int R_, C_; stage_rc(tid * 16 + _i * 8192, R_, C_); gi0[_i] = (u).gather[R_]; gi1[_i] = (u).gather[HALF + R_]; } } } while (0)
    GUnit cur, nxt; int ui = 0;
    if (!S.next(0, cur)) return;
    f32x4 acc[2][2][4][2];
#pragma unroll
    for (int a = 0; a < 2; ++a)
#pragma unroll
        for (int b = 0; b < 2; ++b)
#pragma unroll
            for (int m = 0; m < 4; ++m)
#pragma unroll
                for (int n = 0; n < 2; ++n) acc[a][b][m][n] = (f32x4){0.f, 0.f, 0.f, 0.f};
    bf16x8 At[4][2], B0[2][2], B1[2][2];
    unsigned vA0[2], vA1[2], vB[2]; unsigned hsB; int gi0[2] = {0, 0}, gi1[2] = {0, 0};
    PG8_GIDX(cur, gi0, gi1); PG8_OFFS(cur, gi0, gi1);
    const char* cA = cur.A; const char* cB = cur.B;
    const size_t kstep = (size_t)(BK * 2);
    PG8_STAGE(PG8_SB(0, 0), cB, vB); PG8_STAGE(PG8_SB(0, 1), cB + hsB, vB); PG8_STAGE(PG8_SA(0, 0), cA, vA0); PG8_STAGE(PG8_SA(0, 1), cA, vA1);
    if (wr == 1) PG8_BAR;
    PG8_WAIT_V(2); PG8_BAR;
    PG8_STAGE(PG8_SB(1, 0), cB + kstep, vB); PG8_STAGE(PG8_SA(1, 0), cA + kstep, vA0); PG8_STAGE(PG8_SB(1, 1), cB + hsB + kstep, vB);
    PG8_WAIT_V(6); PG8_BAR;
    for (;;) {
        const bool has_next = S.next(ui + 1, nxt);
        const char* nA = cA; const char* nBp = cB;
        if (has_next) { nA = nxt.A; nBp = nxt.B; PG8_GIDX(nxt, gi0, gi1); }
        const int nt = cur.nk;
        for (int t = 0; t < nt; t += 2) {
            const bool last = (t == nt - 2);
            const char* a1 = cA + (size_t)(t + 1) * kstep;
            const char* a2 = last ? nA : cA + (size_t)(t + 2) * kstep; const char* b2 = last ? nBp : cB + (size_t)(t + 2) * kstep;
            const char* a3 = a2 + kstep; const char* b3 = b2 + kstep;
            PG8_LDB(B0, 0, 0); PG8_LDB(B1, 0, 1); PG8_SCHED; PG8_LDA(At, 0, 0); PG8_STAGE(PG8_SA(1, 1), a1, vA1);
            if (last && has_next) { PG8_OFFS(nxt, gi0, gi1); }
            PG8_WAIT_V(8); PG8_WAIT_L(0); PG8_BAR; PG8_MMA(0, 0, At, B0); PG8_MMA(0, 1, At, B1); PG8_BAR; PG8_SCHED;
            PG8_LDA(At, 0, 1); PG8_STAGE(PG8_SB(0, 0), b2, vB); PG8_STAGE(PG8_SB(0, 1), b2 + hsB, vB); PG8_STAGE(PG8_SA(0, 0), a2, vA0);
            PG8_WAIT_V(8); PG8_WAIT_L(0); PG8_BAR; if (!Sched::HALF || !cur.i1) { PG8_MMA(1, 0, At, B0); PG8_MMA(1, 1, At, B1); } PG8_BAR; PG8_SCHED;
            PG8_LDB(B0, 1, 0); PG8_LDB(B1, 1, 1); PG8_SCHED; PG8_LDA(At, 1, 0); PG8_STAGE(PG8_SA(0, 1), a2, vA1);
            PG8_WAIT_V(8); PG8_WAIT_L(0); PG8_BAR; PG8_MMA(0, 0, At, B0); PG8_MMA(0, 1, At, B1); PG8_BAR; PG8_SCHED;
            PG8_LDA(At, 1, 1); PG8_STAGE(PG8_SB(1, 0), b3, vB); PG8_STAGE(PG8_SB(1, 1), b3 + hsB, vB); PG8_STAGE(PG8_SA(1, 0), a3, vA0);
            PG8_WAIT_V(8); PG8_WAIT_L(0); PG8_BAR; if (!Sched::HALF || !cur.i1) { PG8_MMA(1, 0, At, B0); PG8_MMA(1, 1, At, B1); } PG8_BAR; PG8_SCHED;
        }
        if (wr == 0) PG8_BAR;
        { int fr_ = fr, fq_ = fq; asm volatile("" : "+v"(fr_), "+v"(fq_)); E(acc, cur, wr, wc, fr_, fq_); }
        if (!has_next) break;
#pragma unroll
        for (int a = 0; a < 2; ++a)
#pragma unroll
            for (int b = 0; b < 2; ++b)
#pragma unroll
                for (int m = 0; m < 4; ++m)
#pragma unroll
                    for (int n = 0; n < 2; ++n) acc[a][b][m][n] = (f32x4){0.f, 0.f, 0.f, 0.f};
        cur = nxt; cA = nA; cB = nBp; ++ui;
        if (wr == 1) PG8_BAR;
    }
    PG8_WAIT_V(0);
    PG8_BAR;
#undef PG8_SA
#undef PG8_SB
#undef PG8_STAGE
#undef PG8_LDA
#undef PG8_LDB
#undef PG8_MMA
#undef PG8_WAIT_V
#undef PG8_WAIT_L
#undef PG8_BAR
#undef PG8_SCHED
#undef PG8_OFFS
#undef PG8_GIDX
}
}
namespace att {
constexpr int NW = 8, QBLK = 32, KVBLK = 64, QB = 256;
constexpr int KT_BYTES = 64 * 384, VT_BYTES = 64 * 256;
constexpr int LDS_K = 0, LDS_V = 3 * KT_BYTES, LDS_WS = LDS_V + 3 * VT_BYTES, LDS_TOTAL = LDS_WS + NW * 256;
static_assert(LDS_TOTAL == CONV_OFF, "LDS map");
constexpr unsigned KROW = QW * 2, VROW = NH * DV * 2;
constexpr float THR = 8.f;
#define SBAR() __builtin_amdgcn_sched_barrier(0)
#ifdef ATT_PROBE
#define PBT(k) do { unsigned long long t_; asm volatile("s_memrealtime %0\n\ts_waitcnt lgkmcnt(0)" : "=s"(t_) :: "memory"); const unsigned tl_ = (unsigned)t_; cv.pb[k] += tl_ - cv.pbl; cv.pbl = tl_; } while (0)
#else
#define PBT(k) do { } while (0)
#endif
__device__ __forceinline__ int crow(int r, int hi) { return (r & 3) + 8 * (r >> 2) + 4 * hi; }
__device__ __forceinline__ void glds16(const void* gsrc, unsigned lds_dst) { unsigned keep;
    asm volatile("s_mov_b32 %0, m0\n\ts_mov_b32 m0, %2\n\ts_nop 0\n\tglobal_load_lds_dwordx4 %1, off\n\ts_mov_b32 m0, %0" : "=&s"(keep) : "v"(gsrc), "s"(lds_dst) : "memory"); }
__device__ __forceinline__ void glds16_nt(const void* gsrc, unsigned lds_dst) { unsigned keep;
    asm volatile("s_mov_b32 %0, m0\n\ts_mov_b32 m0, %2\n\ts_nop 0\n\tglobal_load_lds_dwordx4 %1, off nt\n\ts_mov_b32 m0, %0" : "=&s"(keep) : "v"(gsrc), "s"(lds_dst) : "memory"); }
__device__ __forceinline__ void glds16s(const void* base, unsigned voff, unsigned lds_dst) {
    asm volatile("s_mov_b32 m0, %2\n\ts_nop 0\n\tglobal_load_lds_dwordx4 %1, %0" :: "s"(base), "v"(voff), "s"(lds_dst) : "memory", "m0"); }
__device__ __forceinline__ void glds16s_nt(const void* base, unsigned voff, unsigned lds_dst) {
    asm volatile("s_mov_b32 m0, %2\n\ts_nop 0\n\tglobal_load_lds_dwordx4 %1, %0 nt" :: "s"(base), "v"(voff), "s"(lds_dst) : "memory", "m0"); }
#ifdef ATT_PROBE
#define WAIT_BAR(N) do { asm volatile("s_waitcnt vmcnt(" #N ") lgkmcnt(0)" ::: "memory"); PBT(2); asm volatile("s_barrier" ::: "memory"); } while (0)
#else
#define WAIT_BAR(N) asm volatile("s_waitcnt vmcnt(" #N ") lgkmcnt(0)\n\ts_barrier" ::: "memory")
#endif
__device__ __forceinline__ int v_rd_base(int lane) { return ((lane & 3) << 3) | (((lane >> 2) & 3) << 6) | (((lane >> 4) & 1) << 5) | (((lane >> 5) & 1) << 8); }
constexpr int v_rd_off(int d0, int ks, int half) { return d0 * 512 + ks * 4096 + half * 2048; }

__device__ __forceinline__ void mask_tile(f32x16& p0, f32x16& p1, int dq) {
    const float NEG = -__builtin_inff();
#pragma unroll
    for (int r = 0; r < 16; ++r) { const int c = (r & 3) + 8 * (r >> 2);
        if (dq - c < 0) p0[r] = NEG;
        if (dq - c - 32 < 0) p1[r] = NEG; }
}
__device__ __forceinline__ void partialSM(f32x16& p0, f32x16& p1, float& m_reg, float& mn, float& alpha) {
    float pmax = p0[0];
#pragma unroll
    for (int r = 1; r < 16; ++r) pmax = fmaxf(pmax, p0[r]);
#pragma unroll
    for (int r = 0; r < 16; ++r) pmax = fmaxf(pmax, p1[r]);
    { auto rr = __builtin_amdgcn_permlane32_swap(__float_as_uint(pmax), __float_as_uint(pmax), false, false);
      pmax = fmaxf(__uint_as_float(rr[0]), __uint_as_float(rr[1])); }
    if (__builtin_expect(__all(pmax - m_reg <= THR), 1)) { mn = m_reg; alpha = 1.f; }
    else { mn = fmaxf(m_reg, pmax); alpha = __builtin_amdgcn_exp2f(m_reg - mn); m_reg = mn; }
#pragma unroll
    for (int r = 0; r < 16; ++r) { p0[r] = p0[r] - mn; p1[r] = p1[r] - mn; }
#pragma unroll
    for (int r = 0; r < 16; ++r) p0[r] = __builtin_amdgcn_exp2f(p0[r]);
}
__device__ __forceinline__ void finishSM(f32x16& p0, f32x16& p1, float alpha, float& l_reg, bf16x8& pa0, bf16x8& pa1, bf16x8& pa2, bf16x8& pa3) {
#pragma unroll
    for (int r = 0; r < 16; ++r) p1[r] = __builtin_amdgcn_exp2f(p1[r]);
    float ps = 0;
#pragma unroll
    for (int r = 0; r < 16; ++r) ps += p0[r];
#pragma unroll
    for (int r = 0; r < 16; ++r) ps += p1[r];
    { auto rr = __builtin_amdgcn_permlane32_swap(__float_as_uint(ps), __float_as_uint(ps), false, false);
      ps = __uint_as_float(rr[0]) + __uint_as_float(rr[1]); }
    l_reg = l_reg * alpha + ps;
#define PK4(P, B_, OUT) do { unsigned a0 = cvt_pk_bf16(P[B_+0], P[B_+1]), a1 = cvt_pk_bf16(P[B_+2], P[B_+3]);                          \
        unsigned b0 = cvt_pk_bf16(P[B_+4], P[B_+5]), b1 = cvt_pk_bf16(P[B_+6], P[B_+7]);                                             \
        auto r0 = __builtin_amdgcn_permlane32_swap(a0, b0, false, false); auto r1 = __builtin_amdgcn_permlane32_swap(a1, b1, false, false); \
        u32x4 w = {r0[0], r1[0], r0[1], r1[1]}; OUT = __builtin_bit_cast(bf16x8, w); } while (0)
    PK4(p0, 0, pa0); PK4(p0, 8, pa1); PK4(p1, 0, pa2); PK4(p1, 8, pa3);
#undef PK4
}
__device__ __forceinline__ void qkt(f32x16& p0, f32x16& p1, const LAS char* const (&kb)[4], const bf16x8 (&qr)[12]) {
    p0 = f32x16{}; p1 = f32x16{};
#pragma unroll
    for (int d0 = 0; d0 < 12; ++d0) { const LAS char* a = kb[d0 & 3] + (d0 >> 2) * 128;
        const bf16x8 b0 = *(const LAS bf16x8*)(a);
        const bf16x8 b1 = *(const LAS bf16x8*)(a + 32 * 384);
        p0 = __builtin_amdgcn_mfma_f32_32x32x16_bf16(b0, qr[d0], p0, 0, 0, 0);
        p1 = __builtin_amdgcn_mfma_f32_32x32x16_bf16(b1, qr[d0], p1, 0, 0, 0); }
}
template <int HALF_> __device__ __forceinline__ void pv_tile(f32x16* o, int vb0, bf16x8 pa0, bf16x8 pa1, bf16x8 pa2, bf16x8 pa3) {
#define TRRD(dst, off) asm volatile("ds_read_b64_tr_b16 %0, %1 offset:%2" : "=&v"(dst) : "v"(vb0), "i"(off) : "memory")
#define PV_D0(d0) do { s16x4 l0, l1, l2, l3, h0, h1, h2, h3; constexpr int b_ = v_rd_off(d0, 0, 0); \
        TRRD(l0, b_); TRRD(h0, b_ + 2048); TRRD(l1, b_ + 4096); TRRD(h1, b_ + 6144); TRRD(l2, b_ + 8192); TRRD(h2, b_ + 10240); TRRD(l3, b_ + 12288); TRRD(h3, b_ + 14336); \
        asm volatile("s_waitcnt lgkmcnt(0)" ::: "memory"); SBAR(); \
        o[d0] = __builtin_amdgcn_mfma_f32_32x32x16_bf16(pa0, (bf16x8){l0[0], l0[1], l0[2], l0[3], h0[0], h0[1], h0[2], h0[3]}, o[d0], 0, 0, 0);   \
        o[d0] = __builtin_amdgcn_mfma_f32_32x32x16_bf16(pa1, (bf16x8){l1[0], l1[1], l1[2], l1[3], h1[0], h1[1], h1[2], h1[3]}, o[d0], 0, 0, 0);   \
        o[d0] = __builtin_amdgcn_mfma_f32_32x32x16_bf16(pa2, (bf16x8){l2[0], l2[1], l2[2], l2[3], h2[0], h2[1], h2[2], h2[3]}, o[d0], 0, 0, 0);   \
        o[d0] = __builtin_amdgcn_mfma_f32_32x32x16_bf16(pa3, (bf16x8){l3[0], l3[1], l3[2], l3[3], h3[0], h3[1], h3[2], h3[3]}, o[d0], 0, 0, 0); } while (0)
    if (HALF_ == 0) { PV_D0(0); PV_D0(1); } else { PV_D0(2); PV_D0(3); }
#undef PV_D0
#undef TRRD
}

struct ConvCtx {
    int ci, cd, n, base_it, stride;
    int bi, bd;
#ifdef ATT_PROBE
    unsigned pb[4], pbl;
#endif
    const float* wg; const float* wu; const float* wd; const float* fg; bf16_t* WGU; bf16_t* WDn;
};
struct ConvTile { const float* W; int ldw, k0, n0; bf16_t* WT; int drow, ldt; bool gain; };
__device__ __forceinline__ void conv_decode(const ConvCtx& c, int i, ConvTile& t) {
    constexpr int TG = 64 * 64 * 8;
    int r = c.base_it + i * c.stride;
    if (r < 2 * TG) { const bool up = r >= TG; if (up) r -= TG; const int e = r >> 9, q = r & 511, kb = q >> 3, nb = q & 7; const int n0 = 64 * nb;
        t.W = (up ? c.wu : c.wg) + (size_t)e * DM * DE; t.ldw = DE; t.k0 = 64 * kb; t.n0 = n0; t.WT = c.WGU + (size_t)e * 1024 * DM; t.drow = (n0 >> 7) * 256 + (up ? 128 : 0) + (n0 & 127); t.ldt = DM; t.gain = true; }
    else { r -= 2 * TG; const int e = r >> 9, q = r & 511, kb = q >> 6, nb = q & 63;
        t.W = c.wd + (size_t)e * DE * DM; t.ldw = DM; t.k0 = 64 * kb; t.n0 = 64 * nb; t.WT = c.WDn + (size_t)e * DM * DE; t.drow = 64 * nb; t.ldt = DE; t.gain = false; }
}
__device__ __forceinline__ void conv_process(const ConvCtx& c, int i, int buf, LAS char* shm, int wid, int lane) {
    ConvTile t; conv_decode(c, i, t);
    const LAS float* T = (const LAS float*)(shm + CONV_OFF + buf * 16384) + wid * 8 * 64 + lane;
    float v[8];
#pragma unroll
    for (int j = 0; j < 8; ++j) v[j] = T[j * 64];
    if (t.gain) { const __attribute__((address_space(4))) float* g = (const __attribute__((address_space(4))) float*)(c.fg + t.k0 + 8 * wid);
#pragma unroll
        for (int j = 0; j < 8; ++j) v[j] *= g[j]; }
    u32x4 o; o.x = cvt_pk_bf16(v[0], v[1]); o.y = cvt_pk_bf16(v[2], v[3]); o.z = cvt_pk_bf16(v[4], v[5]); o.w = cvt_pk_bf16(v[6], v[7]);
    *(u32x4*)((char*)(t.WT + (size_t)t.drow * t.ldt + t.k0 + 8 * wid) + (unsigned)lane * (unsigned)t.ldt * 2u) = o;
}
__device__ __forceinline__ void conv_dma(const ConvCtx& c, int i, int buf, unsigned lds0, int wid, int lane) {
    ConvTile t; conv_decode(c, i, t);
    const char* g = (const char*)(t.W + (size_t)(t.k0 + 8 * wid) * t.ldw + t.n0);
    const unsigned lo = (unsigned)(lane >> 4) * (unsigned)t.ldw * 4u + (unsigned)(lane & 15) * 16u;
    const unsigned dst = lds0 + CONV_OFF + buf * 16384 + wid * 2048;
    glds16_nt(g + lo, (unsigned)__builtin_amdgcn_readfirstlane(dst));
    glds16_nt(g + (size_t)t.ldw * 16 + lo, (unsigned)__builtin_amdgcn_readfirstlane(dst + 1024));
}
__device__ __forceinline__ void conv_proc_step(ConvCtx& c, LAS char* shm, int wid, int lane) {
    if (c.ci < c.n && c.ci < c.cd) { conv_process(c, c.ci, c.bi, shm, wid, lane); ++c.ci; c.bi ^= 1; }
}
__device__ __forceinline__ bool conv_dma_begin(const ConvCtx& c, ConvTile& t) { const bool go = c.cd < c.n; if (go) conv_decode(c, c.cd, t); return go; }
__device__ __forceinline__ void conv_dma1(const ConvCtx& c, const ConvTile& t, int piece, unsigned lds0, int wid, int lane) {
    const char* g = (const char*)(t.W + (size_t)(t.k0 + 8 * wid + 4 * piece) * t.ldw + t.n0);
    const unsigned lo = (unsigned)(lane >> 4) * (unsigned)t.ldw * 4u + (unsigned)(lane & 15) * 16u;
    glds16s_nt(g, lo, (unsigned)__builtin_amdgcn_readfirstlane(lds0 + CONV_OFF + c.bd * 16384 + wid * 2048 + piece * 1024));
}
__device__ __forceinline__ void conv_dma_end(ConvCtx& c) { ++c.cd; c.bd ^= 1; }
__device__ __forceinline__ bool conv_dma_step(ConvCtx& c, unsigned lds0, int wid, int lane) {
    const bool go = c.cd < c.n;
    if (go) conv_dma(c, c.cd, c.bd, lds0, wid, lane);
    return go;
}

template <bool FASTSM> __device__ __forceinline__ void attn_unit(int b, int h, int qb, const bf16_t* Q, const bf16_t* KF, const bf16_t* VBp, bf16_t* MIX, const float* gq, const float* rope, ConvCtx& cv, LAS char* shm) {
    int tid = threadIdx.x; asm volatile("" : "+v"(tid));
    const int lane = tid & 63, r32 = lane & 31, hi = lane >> 5; const int wid = __builtin_amdgcn_readfirstlane(tid >> 6);
    const int NT = 4 * qb + 5;
    const char* Kg = (const char*)KF + ((size_t)(b * LSEQ) * QW + h * DQK) * 2;
    const char* Vg = (const char*)VBp + ((size_t)(b * LSEQ) * (NH * DV) + h * DV) * 2;
    const char* Qg = (const char*)Q + ((size_t)(b * SEQ + qb * QB + wid * QBLK + r32) * QW + h * DQK) * 2;
    const unsigned lds0 = (unsigned)(uintptr_t)shm;
    bf16x8 qr[12];
    { u32x4 raw[12];
#pragma unroll
      for (int d0 = 0; d0 < 12; ++d0) raw[d0] = *(const u32x4*)(Qg + (d0 * 16 + hi * 8) * 2);
      const int tpos = NMETA + qb * QB + wid * QBLK + r32; const float* rp = rope + (size_t)tpos * 64 + 8 * hi;
      float ss = 0.f;
#pragma unroll
      for (int d0 = 0; d0 < 12; ++d0)
#pragma unroll
          for (int j = 0; j < 4; ++j) { const float x = bf_lo(raw[d0][j]), y = bf_hi(raw[d0][j]); ss += x * x + y * y; }
      { auto rr = __builtin_amdgcn_permlane32_swap(__float_as_uint(ss), __float_as_uint(ss), false, false); ss = __uint_as_float(rr[0]) + __uint_as_float(rr[1]); }
      const float rq = rsqrtf(ss * (1.f / DQK) + EPS) * QSCALE;
#pragma unroll
      for (int d0 = 0; d0 < 8; ++d0) { const f32x4 g0 = *(const f32x4*)(gq + d0 * 16 + hi * 8), g1 = *(const f32x4*)(gq + d0 * 16 + hi * 8 + 4); u32x4 w;
          w.x = cvt_pk_bf16(bf_lo(raw[d0][0]) * rq * g0[0], bf_hi(raw[d0][0]) * rq * g0[1]); w.y = cvt_pk_bf16(bf_lo(raw[d0][1]) * rq * g0[2], bf_hi(raw[d0][1]) * rq * g0[3]);
          w.z = cvt_pk_bf16(bf_lo(raw[d0][2]) * rq * g1[0], bf_hi(raw[d0][2]) * rq * g1[1]); w.w = cvt_pk_bf16(bf_lo(raw[d0][3]) * rq * g1[2], bf_hi(raw[d0][3]) * rq * g1[3]);
          qr[d0] = __builtin_bit_cast(bf16x8, w); }
#pragma unroll
      for (int dd = 0; dd < 2; ++dd) {
          float x1[8], x2[8], cs[8], sn[8];
#pragma unroll
          for (int q = 0; q < 2; ++q) { const f32x4 ga = *(const f32x4*)(gq + 128 + 16 * dd + 8 * hi + 4 * q), gb = *(const f32x4*)(gq + 160 + 16 * dd + 8 * hi + 4 * q);
              const f32x4 cc = *(const f32x4*)(rp + 16 * dd + 4 * q), sq = *(const f32x4*)(rp + 32 + 16 * dd + 4 * q);
#pragma unroll
              for (int e = 0; e < 4; ++e) { const int j = 4 * q + e; const unsigned wa = raw[8 + dd][j >> 1], wb = raw[10 + dd][j >> 1];
                  x1[j] = ((j & 1) ? bf_hi(wa) : bf_lo(wa)) * rq * ga[e]; x2[j] = ((j & 1) ? bf_hi(wb) : bf_lo(wb)) * rq * gb[e]; cs[j] = cc[e]; sn[j] = sq[e]; } }
          u32x4 w1, w2;
#pragma unroll
          for (int q = 0; q < 4; ++q) { w1[q] = cvt_pk_bf16(x1[2 * q] * cs[2 * q] - x2[2 * q] * sn[2 * q], x1[2 * q + 1] * cs[2 * q + 1] - x2[2 * q + 1] * sn[2 * q + 1]);
              w2[q] = cvt_pk_bf16(x1[2 * q] * sn[2 * q] + x2[2 * q] * cs[2 * q], x1[2 * q + 1] * sn[2 * q + 1] + x2[2 * q + 1] * cs[2 * q + 1]); }
          qr[8 + dd] = __builtin_bit_cast(bf16x8, w1); qr[10 + dd] = __builtin_bit_cast(bf16x8, w2); }
    }
    unsigned kof[3], vof[2];
#pragma unroll
    for (int j = 0; j < 3; ++j) { const int q = (wid * 3 + j) * 64 + lane, row = q / 24, chp = q - row * 24; const int ch = (chp & ~7) | ((chp & 7) ^ ((row >> 1) & 7));
        kof[j] = (unsigned)row * KROW + (unsigned)ch * 16u; }
#pragma unroll
    for (int j = 0; j < 2; ++j) { const int q = (wid * 2 + j) * 64 + lane, s = q >> 5; const int kk = (s >> 2) * 8 + ((q & 31) >> 2), c = (s & 3) * 32 + (q & 3) * 8;
        const int k = (kk & ~0xC) | ((kk & 4) << 1) | ((kk & 8) >> 1);
        vof[j] = (unsigned)k * VROW + (unsigned)c * 2u; }
    const unsigned kdst = lds0 + LDS_K + wid * 3072, vdst = lds0 + LDS_V + wid * 2048;
#define DMA_K(t, slot) do { const char* g_ = Kg + (size_t)(t) * (KVBLK * KROW); _Pragma("unroll") for (int j_ = 0; j_ < 3; ++j_) glds16(g_ + kof[j_], (unsigned)__builtin_amdgcn_readfirstlane(kdst + (slot) * KT_BYTES + j_ * 1024)); } while (0)
#define DMA_V(t, slot) do { const char* g_ = Vg + (size_t)(t) * (KVBLK * VROW); _Pragma("unroll") for (int j_ = 0; j_ < 2; ++j_) glds16(g_ + vof[j_], (unsigned)__builtin_amdgcn_readfirstlane(vdst + (slot) * VT_BYTES + j_ * 1024)); } while (0)
#define DMA_K1(t, slot, j_) glds16s(Kg + (size_t)(t) * (KVBLK * KROW), kof[j_], (unsigned)__builtin_amdgcn_readfirstlane(kdst + (slot) * KT_BYTES + (j_) * 1024))
#define DMA_V1(t, slot, j_) glds16s(Vg + (size_t)(t) * (KVBLK * VROW), vof[j_], (unsigned)__builtin_amdgcn_readfirstlane(vdst + (slot) * VT_BYTES + (j_) * 1024))
    DMA_K(0, 0); DMA_K(1, 1); DMA_V(0, 1);
    const LAS char* shm3 = (const LAS char*)shm;
    const int key7 = (r32 >> 1) & 7;
    const LAS char* kb0[4];
#pragma unroll
    for (int dd = 0; dd < 4; ++dd) kb0[dd] = shm3 + LDS_K + r32 * 384 + 16 * ((2 * dd + hi) ^ key7);
    const int vb0 = (int)(lds0 + LDS_V) + v_rd_base(lane);
    LAS float* ws = (LAS float*)(shm + LDS_WS) + wid * 64; LAS float* li_l = ws; LAS float* al_l = ws + 32;
    float m_reg = -1e30f, l_reg = 0.f; f32x16 o[4] = {};
    const int qlo = NMETA + qb * QB + wid * QBLK;
    const int qm = qlo + r32 - 4 * hi;
#define RESC(a) do { if (__any((a) < 1.f)) { if (hi == 0) al_l[r32] = (a); asm volatile("s_waitcnt lgkmcnt(0)" ::: "memory");              \
                     _Pragma("unroll") for (int d_ = 0; d_ < 4; ++d_) _Pragma("unroll") for (int r = 0; r < 16; ++r) o[d_][r] *= al_l[crow(r, hi)]; } } while (0)
#define MASKT(P0_, P1_, t) do { const int kb_ = (t) * KVBLK; if (kb_ + KVBLK - 1 > qlo) mask_tile(P0_, P1_, qm - kb_); } while (0)
    const bool g1 = wid >= 4, hk = true;
    f32x16 p0, p1; float alpha; bf16x8 pa0, pa1, pa2, pa3;
    int sK = 0, sKn = 1, sKnn = 2;
    int sVp = 0, sVm = 1, sV = 2;
    bool gc = false; ConvTile cdma_;
#define ROT() do { int t_ = sK; sK = sKn; sKn = sKnn; sKnn = t_; t_ = sVp; sVp = sVm; sVm = sV; sV = t_; } while (0)
#define IV_BEGIN() do { gc = conv_dma_begin(cv, cdma_); } while (0)
#define IV_END() do { if (gc) asm volatile("s_waitcnt vmcnt(7)" ::: "memory"); else asm volatile("s_waitcnt vmcnt(5)" ::: "memory"); PBT(2);                             \
        conv_proc_step(cv, shm, wid, lane); conv_dma_end(cv); asm volatile("s_waitcnt lgkmcnt(0)\n\ts_barrier" ::: "memory"); ROT(); } while (0)
#define TKC(I) (((I) + 2 < NT) ? (I) + 2 : NT - 1)
#define TVC(I) (((I) + 1 < NT) ? (I) + 1 : NT - 1)
#define HOOKS_ALL(I) do { const int tk_ = TKC(I), tv_ = TVC(I); DMA_V1(tv_, sV, 0); DMA_V1(tv_, sV, 1); DMA_K1(tk_, sKnn, 0); DMA_K1(tk_, sKnn, 1); DMA_K1(tk_, sKnn, 2);   \
        if (gc) { conv_dma1(cv, cdma_, 0, lds0, wid, lane); conv_dma1(cv, cdma_, 1, lds0, wid, lane); } } while (0)
#define LDK(dst, base, off) asm volatile("ds_read_b128 %0, %1 offset:%2" : "=&v"(dst) : "v"(base), "i"(off) : "memory")
#define LDV(dst, off) asm volatile("ds_read_b64_tr_b16 %0, %1 offset:%2" : "=&v"(dst) : "v"(vbs_), "i"(off) : "memory")
#define LW2(n, a, b) asm volatile("s_waitcnt lgkmcnt(" #n ")" : "+v"(a), "+v"(b) :: "memory")
#define LW4(n, a, b, c, d) asm volatile("s_waitcnt lgkmcnt(" #n ")" : "+v"(a), "+v"(b), "+v"(c), "+v"(d) :: "memory")
#define RDK(d0, s) do { LDK(kf[s][0], kq_[(d0) & 3], ((d0) >> 2) * 128); LDK(kf[s][1], kq_[(d0) & 3], ((d0) >> 2) * 128 + 32 * 384); } while (0)
#define RDV(j, s) do { LDV(vl[s][0], v_rd_off((j) >> 1, 2 * ((j) & 1), 0)); LDV(vh[s][0], v_rd_off((j) >> 1, 2 * ((j) & 1), 1)); LDV(vl[s][1], v_rd_off((j) >> 1, 2 * ((j) & 1) + 1, 0)); LDV(vh[s][1], v_rd_off((j) >> 1, 2 * ((j) & 1) + 1, 1)); } while (0)
#define MMK(d0, s, n) do { LW2(n, kf[s][0], kf[s][1]); p0 = __builtin_amdgcn_mfma_f32_32x32x16_bf16(kf[s][0], qr[d0], p0, 0, 0, 0); p1 = __builtin_amdgcn_mfma_f32_32x32x16_bf16(kf[s][1], qr[d0], p1, 0, 0, 0); } while (0)
#define VOP(s, k) ((bf16x8){vl[s][k][0], vl[s][k][1], vl[s][k][2], vl[s][k][3], vh[s][k][0], vh[s][k][1], vh[s][k][2], vh[s][k][3]})
#define MMV(j, s, n) do { LW4(n, vl[s][0], vh[s][0], vl[s][1], vh[s][1]);                                                                                                   \
        o[(j) >> 1] = __builtin_amdgcn_mfma_f32_32x32x16_bf16(((j) & 1) ? pa2 : pa0, VOP(s, 0), o[(j) >> 1], 0, 0, 0);                                                       \
        o[(j) >> 1] = __builtin_amdgcn_mfma_f32_32x32x16_bf16(((j) & 1) ? pa3 : pa1, VOP(s, 1), o[(j) >> 1], 0, 0, 0); } while (0)
#ifdef NO_SETPRIO
#define SETPRIO_M(x) do { } while (0)
#else
#define SETPRIO_M(x) __builtin_amdgcn_s_setprio(x)
#endif
#define MCLUSTER(I, HK_, PV_) do {                                                                                                                                          \
        const unsigned kq_[4] = {(unsigned)(uintptr_t)kb0[0] + sK * KT_BYTES, (unsigned)(uintptr_t)kb0[1] + sK * KT_BYTES, (unsigned)(uintptr_t)kb0[2] + sK * KT_BYTES, (unsigned)(uintptr_t)kb0[3] + sK * KT_BYTES}; \
        const int vbs_ = vb0 + sVp * VT_BYTES; const int tk_ = TKC(I), tv_ = TVC(I);                                                                                                       \
        bf16x8 kf[4][2]; s16x4 vl[4][2], vh[4][2];                                                                                                                           \
        SETPRIO_M(1);                                                                                                                                                        \
        p0 = f32x16{}; p1 = f32x16{};                                                                                                                                        \
        RDK(0, 0); RDK(1, 1); RDK(2, 2);                                                                                                                                     \
        RDK(3, 3); MMK(0, 0, 6);                                                                                                                                             \
        RDK(4, 0); MMK(1, 1, 6); if (HK_) { DMA_V1(tv_, sV, 0); }                                                                                                            \
        RDK(5, 1); MMK(2, 2, 6); if (HK_) { DMA_V1(tv_, sV, 1); }                                                                                                            \
        RDK(6, 2); MMK(3, 3, 6); if (HK_) { DMA_K1(tk_, sKnn, 0); }                                                                                                          \
        RDK(7, 3); MMK(4, 0, 6); if (HK_) { DMA_K1(tk_, sKnn, 1); }                                                                                                          \
        RDK(8, 0); MMK(5, 1, 6); if (HK_) { DMA_K1(tk_, sKnn, 2); }                                                                                                          \
        RDK(9, 1); MMK(6, 2, 6); if (HK_) { if (gc) conv_dma1(cv, cdma_, 0, lds0, wid, lane); }                                                                              \
        RDK(10, 2); MMK(7, 3, 6); if (HK_) { if (gc) conv_dma1(cv, cdma_, 1, lds0, wid, lane); }                                                                             \
        RDK(11, 3); MMK(8, 0, 6);                                                                                                                                            \
        if (PV_) {                                                                                                                                                           \
            RDV(0, 0); MMK(9, 1, 8);                                                                                                                                         \
            RDV(1, 1); MMK(10, 2, 10);                                                                                                                                       \
            RDV(2, 2); MMK(11, 3, 12);                                                                                                                                       \
            RDV(3, 3); MMV(0, 0, 12);                                                                                                                                        \
            RDV(4, 0); MMV(1, 1, 12);                                                                                                                                        \
            RDV(5, 1); MMV(2, 2, 12);                                                                                                                                        \
            RDV(6, 2); MMV(3, 3, 12);                                                                                                                                        \
            RDV(7, 3); MMV(4, 0, 12);                                                                                                                                        \
            MMV(5, 1, 8);                                                                                                                                                    \
            MMV(6, 2, 4);                                                                                                                                                    \
            MMV(7, 3, 0);                                                                                                                                                    \
        } else { MMK(9, 1, 4); MMK(10, 2, 2); MMK(11, 3, 0); }                                                                                                               \
        SETPRIO_M(0); } while (0)
#define MCLUSTER_PV(I, HK_) do {                                                                                                                                            \
        const int vbs_ = vb0 + sVp * VT_BYTES; const int tk_ = TKC(I), tv_ = TVC(I);                                                                                         \
        s16x4 vl[4][2], vh[4][2];                                                                                                                                            \
        SETPRIO_M(1);                                                                                                                                                        \
        RDV(0, 0); RDV(1, 1); RDV(2, 2);                                                                                                                                     \
        RDV(3, 3); MMV(0, 0, 12); if (HK_) { DMA_V1(tv_, sV, 0); }                                                                                                           \
        RDV(4, 0); MMV(1, 1, 12); if (HK_) { DMA_V1(tv_, sV, 1); }                                                                                                           \
        RDV(5, 1); MMV(2, 2, 12); if (HK_) { DMA_K1(tk_, sKnn, 0); }                                                                                                         \
        RDV(6, 2); MMV(3, 3, 12); if (HK_) { DMA_K1(tk_, sKnn, 1); }                                                                                                         \
        RDV(7, 3); MMV(4, 0, 12); if (HK_) { DMA_K1(tk_, sKnn, 2); }                                                                                                         \
        MMV(5, 1, 8); if (HK_) { if (gc) conv_dma1(cv, cdma_, 0, lds0, wid, lane); }                                                                                         \
        MMV(6, 2, 4); if (HK_) { if (gc) conv_dma1(cv, cdma_, 1, lds0, wid, lane); }                                                                                         \
        MMV(7, 3, 0);                                                                                                                                                        \
        SETPRIO_M(0); } while (0)
#define VCLUSTER(I, HV_, IH_) do {                                                                                                                                         \
        MASKT(p0, p1, (I));                                                                                                                                                  \
        if (FASTSM) {     \
            _Pragma("unroll") for (int r = 0; r < 16; ++r) p0[r] = __builtin_amdgcn_exp2f(p0[r]);                                                                            \
            _Pragma("unroll") for (int r = 0; r < 16; ++r) p1[r] = __builtin_amdgcn_exp2f(p1[r]);                                                                            \
        } else {                                                                   \
            float pm0 = p0[0], pm1 = p0[1], pm2 = p0[2], pm3 = p0[3];                                                                                                        \
            _Pragma("unroll") for (int r = 4; r < 16; r += 4) { pm0 = fmaxf(pm0, p0[r]); pm1 = fmaxf(pm1, p0[r + 1]); pm2 = fmaxf(pm2, p0[r + 2]); pm3 = fmaxf(pm3, p0[r + 3]); } \
            _Pragma("unroll") for (int r = 0; r < 16; r += 4) { pm0 = fmaxf(pm0, p1[r]); pm1 = fmaxf(pm1, p1[r + 1]); pm2 = fmaxf(pm2, p1[r + 2]); pm3 = fmaxf(pm3, p1[r + 3]); } \
            float pmax = fmaxf(fmaxf(pm0, pm1), fmaxf(pm2, pm3));                                                                                                            \
            { auto rr = __builtin_amdgcn_permlane32_swap(__float_as_uint(pmax), __float_as_uint(pmax), false, false); pmax = fmaxf(__uint_as_float(rr[0]), __uint_as_float(rr[1])); } \
            float mn_;                                                                                                                                                       \
            if (__builtin_expect(__all(pmax - m_reg <= THR), 1)) { mn_ = m_reg; alpha = 1.f; }                                                                               \
            else { mn_ = fmaxf(m_reg, pmax); alpha = __builtin_amdgcn_exp2f(m_reg - mn_); m_reg = mn_; }                                                                     \
            _Pragma("unroll") for (int r = 0; r < 16; ++r) p0[r] = __builtin_amdgcn_exp2f(p0[r] - mn_);                                                                      \
            _Pragma("unroll") for (int r = 0; r < 16; ++r) p1[r] = __builtin_amdgcn_exp2f(p1[r] - mn_);                                                                      \
            l_reg *= alpha; RESC(alpha);                                                                                                                                     \
        }                                                                                                                                                                    \
        float ps0 = p0[0] + p1[0], ps1 = p0[1] + p1[1], ps2 = p0[2] + p1[2], ps3 = p0[3] + p1[3];                                                                            \
        _Pragma("unroll") for (int r = 4; r < 16; r += 4) { ps0 += p0[r] + p1[r]; ps1 += p0[r + 1] + p1[r + 1]; ps2 += p0[r + 2] + p1[r + 2]; ps3 += p0[r + 3] + p1[r + 3]; } \
        float ps = (ps0 + ps1) + (ps2 + ps3);                                                                                                                                \
        { auto rr = __builtin_amdgcn_permlane32_swap(__float_as_uint(ps), __float_as_uint(ps), false, false); ps = __uint_as_float(rr[0]) + __uint_as_float(rr[1]); }       \
        l_reg += ps;                                                                                                                                                         \
        PK4(p0, 0, pa0); PK4(p0, 8, pa1);                                                                                                                                    \
        PK4(p1, 0, pa2); PK4(p1, 8, pa3); } while (0)
#define PK4(P, B_, OUT) do { unsigned a0 = cvt_pk_bf16(P[B_+0], P[B_+1]), a1 = cvt_pk_bf16(P[B_+2], P[B_+3]);                          \
        unsigned b0 = cvt_pk_bf16(P[B_+4], P[B_+5]), b1 = cvt_pk_bf16(P[B_+6], P[B_+7]);                                             \
        auto r0 = __builtin_amdgcn_permlane32_swap(a0, b0, false, false); auto r1 = __builtin_amdgcn_permlane32_swap(a1, b1, false, false); \
        u32x4 w = {r0[0], r1[0], r0[1], r1[1]}; OUT = __builtin_bit_cast(bf16x8, w); } while (0)
    WAIT_BAR(0);
    IV_BEGIN(); HOOKS_ALL(0);
    MCLUSTER(0, false, false);
    if (g1) { IV_END(); IV_BEGIN(); }
    VCLUSTER(0, false, 1);
    if (!g1) { IV_END(); }
    PBT(3);
    const int Tw = (qlo + QBLK - 1) >> 6;
    int t = 1;
    for (; t <= Tw && t < NT; ++t) {
        if (hk) IV_BEGIN();
        MCLUSTER(t, hk, true); PBT(0);
        bool hv = false;
        if (g1) { IV_END(); PBT(3); if (t + 1 < NT) { IV_BEGIN(); } }
        VCLUSTER(t, hv, t + 1); PBT(1);
        if (!g1) { IV_END(); PBT(3); }
    }
    for (; t < NT; ++t) {
        if (hk) IV_BEGIN();
        if (t - 1 == Tw) { MCLUSTER_PV(t, hk); } else { HOOKS_ALL(t); }
        IV_END();
    }
    if (NT - 1 <= Tw) { const int vbs_ = vb0 + sVp * VT_BYTES; s16x4 vl[4][2], vh[4][2];
      RDV(0, 0); RDV(1, 1); RDV(2, 2);
      RDV(3, 3); MMV(0, 0, 12);
      RDV(4, 0); MMV(1, 1, 12);
      RDV(5, 1); MMV(2, 2, 12);
      RDV(6, 2); MMV(3, 3, 12);
      RDV(7, 3); MMV(4, 0, 12);
      MMV(5, 1, 8); MMV(6, 2, 4); MMV(7, 3, 0); }
    if (hi == 0) li_l[r32] = l_reg; asm volatile("s_waitcnt lgkmcnt(0)" ::: "memory");
    float rli[16];
#pragma unroll
    for (int r = 0; r < 16; ++r) rli[r] = __builtin_amdgcn_rcpf(li_l[crow(r, hi)]);
    bf16_t* Ow = MIX + (size_t)(b * LSEQ + NMETA + qb * QB + wid * QBLK) * DM + POOLW + h * DV;
#pragma unroll
    for (int r = 0; r < 16; ++r) { const int orow = crow(r, hi);
#pragma unroll
        for (int d0 = 0; d0 < 4; ++d0) { const float v = o[d0][r] * rli[r]; const float vn = __shfl_xor(v, 1);
            if ((r32 & 1) == 0) *(unsigned*)(Ow + (size_t)orow * DM + d0 * 32 + r32) = cvt_pk_bf16(v, vn); } }
    asm volatile("s_waitcnt lgkmcnt(0)\n\ts_barrier" ::: "memory");
#undef DMA_K
#undef DMA_V
#undef RESC
#undef MASKT
#undef ROT
#undef IV_BEGIN
#undef IV_END
#undef TKC
#undef TVC
#undef HOOKS_ALL
#undef LDK
#undef LDV
#undef LW2
#undef LW4
#undef RDK
#undef RDV
#undef MMK
#undef VOP
#undef MMV
#undef MCLUSTER
#undef MCLUSTER_PV
#undef VCLUSTER
#undef PK4
}
#undef SBAR
#undef WAIT_BAR
}
constexpr int NWAVES = 8;
struct Frame {
    LAS unsigned char* lds;
    volatile LAS unsigned* MISC;
    unsigned* ctl;
    int tid, lane, wave, vcu, G;
    const float* in[21]; float* out; unsigned char* ws;
};
enum { IN_X = 0, IN_META, IN_MIXG, IN_WIN, IN_QLG, IN_WUQ, IN_KVLG, IN_WUKV, IN_QHG, IN_KHG, IN_WPOOL, IN_PSCALE, IN_WOUT, IN_FFNG, IN_WGROUP, IN_BGROUP, IN_WEXP, IN_BEXP, IN_WGATE, IN_WUP, IN_WDOWN };
#define WSP(T, off) ((T*)(F.ws + (off)))

struct TrItem { const float* W; int ldw, k0, n0; bf16_t* WT; int drow, ldt; const float* sk; const float* sn; };
__device__ __forceinline__ void tr_load(f32x4 (&v)[16], const TrItem& t, int lane) {
    const int s = lane >> 4, cq = lane & 15;
#pragma unroll
    for (int i = 0; i < 16; ++i) { const int row = 8 * (i >> 1) + 2 * s + (i & 1); v[i] = *(const f32x4*)(t.W + (size_t)(t.k0 + row) * t.ldw + t.n0 + 4 * cq); }
}
__device__ __forceinline__ void tr_store(const f32x4 (&v)[16], const TrItem& t, LAS unsigned* T, int lane) {
    const int s = lane >> 4, cq = lane & 15;
    f32x4 gn = {1.f, 1.f, 1.f, 1.f}; if (t.sn) gn = *(const f32x4*)(t.sn + t.n0 + 4 * cq);
#pragma unroll
    for (int m = 0; m < 8; ++m) { f32x2 g = {1.f, 1.f}; if (t.sk) g = *(const f32x2*)(t.sk + t.k0 + 8 * m + 2 * s);
#pragma unroll
        for (int c = 0; c < 4; ++c) T[(4 * cq + c) * 33 + 4 * m + s] = cvt_pk_bf16(v[2 * m][c] * g.x * gn[c], v[2 * m + 1][c] * g.y * gn[c]); }
    LDS_WAIT(); asm volatile("" ::: "memory");
    const int q = lane & 7, nr = lane >> 3;
#pragma unroll
    for (int j = 0; j < 8; ++j) { const int n = nr + 8 * j; const LAS unsigned* r = T + n * 33 + 4 * q; u32x4 o; o.x = r[0]; o.y = r[1]; o.z = r[2]; o.w = r[3];
        *(u32x4*)(t.WT + (size_t)(t.drow + n) * t.ldt + t.k0 + 8 * q) = o; }
    LDS_WAIT(); asm volatile("" ::: "memory");
}
constexpr int TI_IN = 64 * 41, TI_UQ = 16 * 72, TI_UKV = 8 * 96, TI_P = 4 * 16, TI_O = 64 * 64, TI_SMALL = TI_IN + TI_UQ + TI_UKV + TI_P + TI_O;
constexpr int TI_G = 64 * 64 * 8, TI_D = 64 * 8 * 64, TI_EXP = 2 * TI_G + TI_D, TI_ALL = TI_SMALL + TI_EXP;
__device__ __forceinline__ void tr_decode(const Frame& F, int it, TrItem& t) {
    int r = it; t.sk = nullptr; t.sn = nullptr;
    if (r < TI_IN) { const int kb = r / 41, nb = r % 41; t.W = F.in[IN_WIN]; t.ldw = INC; t.k0 = 64 * kb; t.n0 = 64 * nb; t.WT = WSP(bf16_t, WS_WIN); t.drow = 64 * nb; t.ldt = DM; t.sk = F.in[IN_MIXG]; return; } r -= TI_IN;
    if (r < TI_UQ) { const int kb = r / 72, nb = r % 72; t.W = F.in[IN_WUQ]; t.ldw = QW; t.k0 = 64 * kb; t.n0 = 64 * nb; t.WT = WSP(bf16_t, WS_WUQ); t.drow = 64 * nb; t.ldt = QLR; t.sk = F.in[IN_QLG]; return; } r -= TI_UQ;
    if (r < TI_UKV) { const int kb = r / 96, nb = r % 96; t.W = F.in[IN_WUKV]; t.ldw = KVW; t.k0 = 64 * kb; t.n0 = 64 * nb; t.WT = WSP(bf16_t, WS_WUKV); t.drow = 64 * nb; t.ldt = KVLR; t.sk = F.in[IN_KVLG]; return; } r -= TI_UKV;
    if (r < TI_P) { const int g = r >> 4, q = r & 15, kb = q >> 2, nb = q & 3; t.W = F.in[IN_WPOOL] + (size_t)g * 65536; t.ldw = 256; t.k0 = 64 * kb; t.n0 = 64 * nb; t.WT = WSP(bf16_t, WS_WP) + (size_t)g * 65536; t.drow = 64 * nb; t.ldt = 256;
        t.sn = F.in[IN_PSCALE] + g * 256; return; } r -= TI_P;
    if (r < TI_O) { const int kb = r >> 6, nb = r & 63; t.W = F.in[IN_WOUT]; t.ldw = DM; t.k0 = 64 * kb; t.n0 = 64 * nb; t.WT = WSP(bf16_t, WS_WO); t.drow = 64 * nb; t.ldt = DM; return; } r -= TI_O;
    if (r < 2 * TI_G) { const bool up = r >= TI_G; if (up) r -= TI_G; const int e = r >> 9, q = r & 511, kb = q >> 3, nb = q & 7; const int n0 = 64 * nb;
        t.W = (up ? F.in[IN_WUP] : F.in[IN_WGATE]) + (size_t)e * DM * DE; t.ldw = DE; t.k0 = 64 * kb; t.n0 = n0; t.WT = WSP(bf16_t, WS_WGU) + (size_t)e * 1024 * DM; t.drow = (n0 >> 7) * 256 + (up ? 128 : 0) + (n0 & 127); t.ldt = DM;
        t.sk = F.in[IN_FFNG]; return; } r -= 2 * TI_G;
    { const int e = r >> 9, q = r & 511, kb = q >> 6, nb = q & 63; t.W = F.in[IN_WDOWN] + (size_t)e * DE * DM; t.ldw = DM; t.k0 = 64 * kb; t.n0 = 64 * nb; t.WT = WSP(bf16_t, WS_WD) + (size_t)e * DM * DE; t.drow = 64 * nb; t.ldt = DE; }
}
__device__ __forceinline__ void tr_range(Frame& F, int lo, int hi) {
    LAS unsigned* T = (LAS unsigned*)(F.lds + F.wave * 16384);
    const int gw = F.vcu * NWAVES + F.wave, NGW = F.G * NWAVES, lane = F.lane;
    int it = lo + gw; if (it >= hi) return;
    TrItem ta, tb; f32x4 va[16], vb[16];
    tr_decode(F, it, ta); tr_load(va, ta, lane);
    for (;;) {
        const int i1 = it + NGW; const bool h1 = i1 < hi;
        if (h1) { tr_decode(F, i1, tb); tr_load(vb, tb, lane); }
        tr_store(va, ta, T, lane);
        if (!h1) break;
        const int i2 = i1 + NGW; const bool h2 = i2 < hi;
        if (h2) { tr_decode(F, i2, ta); tr_load(va, ta, lane); }
        tr_store(vb, tb, T, lane);
        if (!h2) break;
        it = i2;
    }
}
__device__ __forceinline__ void p0_prologue(Frame& F) {
    const int gw = F.vcu * NWAVES + F.wave, NGW = F.G * NWAVES, lane = F.lane;
    const int gt = gw * 64 + lane, NGT = NGW * 64;
    tr_range(F, 0, TI_IN);
    { float* rstd1 = WSP(float, WS_SMALL + SM_RSTD1); bf16_t* XB = WSP(bf16_t, WS_XB);
      auto rowptr = [&](int row) -> const f32x4* { const int b = row / LSEQ, t = row % LSEQ;
          const float* h = t < NMETA ? F.in[IN_META] + (size_t)t * DM : F.in[IN_X] + ((size_t)b * SEQ + (t - NMETA)) * DM; return (const f32x4*)h + lane; };
      f32x4 va[16], vb[16];
      int row = gw - (TI_IN > NGW ? TI_IN - NGW : 0); if (row < 0) row += NGW;
      if (row < NTOK) { const f32x4* xr = rowptr(row);
#pragma unroll
          for (int j = 0; j < 16; ++j) va[j] = xr[64 * j]; }
      for (; row < MPAD; row += 2 * NGW) {
          const int r1 = row + NGW;
          if (r1 < NTOK) { const f32x4* xr = rowptr(r1);
#pragma unroll
              for (int j = 0; j < 16; ++j) vb[j] = xr[64 * j]; }
#define XB_ROW(V_, ROW_) do { unsigned long long* o8 = (unsigned long long*)(XB + (size_t)(ROW_) * DM) + lane;                       \
          if ((ROW_) >= NTOK) { _Pragma("unroll") for (int j = 0; j < 16; ++j) o8[64 * j] = 0ull; if (lane == 0) rstd1[(ROW_)] = 0.f; }       \
          else { float s = 0.f; _Pragma("unroll") for (int j = 0; j < 16; ++j) s += (V_[j].x * V_[j].x + V_[j].y * V_[j].y) + (V_[j].z * V_[j].z + V_[j].w * V_[j].w); \
              s = wave_sum(s); const float rs = rsqrtf(s * (1.f / DM) + EPS); if (lane == 0) rstd1[(ROW_)] = rs;                     \
              _Pragma("unroll") for (int j = 0; j < 16; ++j) o8[64 * j] = (unsigned long long)cvt_pk_bf16(V_[j].x * rs, V_[j].y * rs) | ((unsigned long long)cvt_pk_bf16(V_[j].z * rs, V_[j].w * rs) << 32); } } while (0)
          XB_ROW(va, row);
          const int r2 = r1 + NGW;
          if (r2 < NTOK) { const f32x4* xr = rowptr(r2);
#pragma unroll
              for (int j = 0; j < 16; ++j) va[j] = xr[64 * j]; }
          if (r1 < MPAD) XB_ROW(vb, r1);
#undef XB_ROW
      } }
}

__device__ __forceinline__ void p1_deferred(Frame& F, int first) {
    const int nw = (F.G - first) * NWAVES; if (nw <= 0 || (int)blockIdx.x < first) return;
    const int gw = ((int)blockIdx.x - first) * NWAVES + F.wave, NGW = nw, lane = F.lane;
    const int gt = gw * 64 + lane, NGT = NGW * 64;
    { LAS unsigned* T = (LAS unsigned*)(F.lds + F.wave * 16384);
      TrItem ta; f32x4 va[16];
      for (int it = TI_IN + gw; it < TI_SMALL; it += NGW) { tr_decode(F, it, ta); tr_load(va, ta, lane); tr_store(va, ta, T, lane); } }
    { bf16_t* hi = WSP(bf16_t, WS_WRT); bf16_t* lo = hi + 96 * DM;
      for (int i = gt; i < 96 * DM; i += NGT) { const int j = i / DM, k = i % DM; float v = 0.f;
          if (j < 8) v = F.in[IN_WGROUP][(size_t)k * NG + j] * F.in[IN_FFNG][k]; else if (j < 72) v = F.in[IN_WEXP][(size_t)k * NE + (j - 8)] * F.in[IN_FFNG][k];
          const unsigned h = cvt_pk_bf16(v, 0.f) & 0xffffu; hi[i] = (bf16_t)h; lo[i] = (bf16_t)(cvt_pk_bf16(v - bf_lo(h), 0.f) & 0xffffu); } }
    { float* rt = WSP(float, WS_ROPE);
      for (int i = gt; i < LSEQ * 32; i += NGT) { const int t = i >> 5, f = i & 31; const float inv = 1.0f / powf(10000.0f, (float)(2 * f) / (float)ROPE); const float ang = (float)t * inv;
          rt[t * 64 + f] = cosf(ang); rt[t * 64 + 32 + f] = sinf(ang); } }
}
template <int W> __device__ __forceinline__ void pool_cols(const bf16_t* PROJ, bf16_t* DIFF, int row0, int t0, int c) {
    float v0[31], v1[31];
#pragma unroll
    for (int i = 0; i < 31; ++i) { const int dt = i - 15; unsigned w = 0u; if (t0 + dt >= 0) w = *(const unsigned*)(PROJ + (size_t)(row0 + dt) * INCP + c); v0[i] = bf_lo(w); v1[i] = bf_hi(w); }
#pragma unroll
    for (int i = 0; i < 16; ++i) { float s0 = 0.f, s1 = 0.f;
#pragma unroll
        for (int j = 0; j < W; ++j) { s0 += v0[15 + i - j]; s1 += v1[15 + i - j]; }
        const int t = t0 + i; const float inv = 1.f / (float)((t + 1 < W) ? t + 1 : W);
        *(unsigned*)(DIFF + (size_t)(row0 + i) * POOLW + c) = cvt_pk_bf16(s0 * inv - v0[15 + i], s1 * inv - v1[15 + i]); }
}
__device__ __forceinline__ void s2_phase(Frame& F) {
    const bf16_t* PROJ = WSP(bf16_t, WS_PROJ); bf16_t* DIFF = WSP(bf16_t, WS_DIFF);
    float* rstdq = WSP(float, WS_SMALL + SM_RSTDQ); float* rstdkv = WSP(float, WS_SMALL + SM_RSTDKV); float* ssqpe = WSP(float, WS_SMALL + SM_SSQPE); float* kr = WSP(float, WS_KR);
    const float* rope = WSP(float, WS_ROPE);
    for (int tile = F.vcu; tile < MPAD / 16; tile += F.G) {
        const int row0 = tile * 16, t0 = row0 % LSEQ;
        const int c = 2 * F.tid, gi = F.wave >> 1;
        if (gi == 0) pool_cols<2>(PROJ, DIFF, row0, t0, c); else if (gi == 1) pool_cols<4>(PROJ, DIFF, row0, t0, c); else if (gi == 2) pool_cols<8>(PROJ, DIFF, row0, t0, c); else pool_cols<16>(PROJ, DIFF, row0, t0, c);
#pragma unroll
        for (int rr = 0; rr < 2; ++rr) { const int row = row0 + 2 * F.wave + rr; const bf16_t* p = PROJ + (size_t)row * INCP;
            const u32x4 a = *(const u32x4*)(p + POOLW + 8 * F.lane), b = *(const u32x4*)(p + POOLW + 512 + 8 * F.lane), k = *(const u32x4*)(p + POOLW + QLR + 8 * F.lane);
            float sq = 0.f, sk = 0.f;
#pragma unroll
            for (int j = 0; j < 4; ++j) { float x;
                x = bf_lo(a[j]); sq += x * x; x = bf_hi(a[j]); sq += x * x; x = bf_lo(b[j]); sq += x * x; x = bf_hi(b[j]); sq += x * x;
                x = bf_lo(k[j]); sk += x * x; x = bf_hi(k[j]); sk += x * x; }
            sq = wave_sum(sq); sk = wave_sum(sk);
            const int cl = F.lane & 7; const u32x4 kp = *(const u32x4*)(p + POOLW + QLR + KVLR + 8 * cl); const int t = row % LSEQ;
            float x[8], sp = 0.f;
#pragma unroll
            for (int j = 0; j < 4; ++j) { x[2 * j] = bf_lo(kp[j]); x[2 * j + 1] = bf_hi(kp[j]); }
#pragma unroll
            for (int j = 0; j < 8; ++j) { sp += x[j] * x[j]; x[j] *= F.in[IN_KHG][DNOPE + 8 * cl + j]; }
            sp += __shfl_xor(sp, 1); sp += __shfl_xor(sp, 2); sp += __shfl_xor(sp, 4);
            const float* rp = rope + (size_t)t * 64 + 8 * (cl & 3); float o[8];
#pragma unroll
            for (int j = 0; j < 8; ++j) { const float other = __shfl_xor(x[j], 4); const float cs = rp[j], sn = rp[32 + j];
                o[j] = (cl >= 4) ? other * sn + x[j] * cs : x[j] * cs - other * sn; }
            if (F.lane < 8) { *(f32x4*)(kr + (size_t)row * 64 + 8 * cl) = (f32x4){o[0], o[1], o[2], o[3]}; *(f32x4*)(kr + (size_t)row * 64 + 8 * cl + 4) = (f32x4){o[4], o[5], o[6], o[7]}; }
            { const float rq = rsqrtf(sq * (1.f / QLR) + EPS), rk = rsqrtf(sk * (1.f / KVLR) + EPS);
              u32x4 na, nb, nk;
#pragma unroll
              for (int j = 0; j < 4; ++j) { na[j] = cvt_pk_bf16(bf_lo(a[j]) * rq, bf_hi(a[j]) * rq); nb[j] = cvt_pk_bf16(bf_lo(b[j]) * rq, bf_hi(b[j]) * rq); nk[j] = cvt_pk_bf16(bf_lo(k[j]) * rk, bf_hi(k[j]) * rk); }
              bf16_t* pw = (bf16_t*)p; *(u32x4*)(pw + POOLW + 8 * F.lane) = na; *(u32x4*)(pw + POOLW + 512 + 8 * F.lane) = nb; *(u32x4*)(pw + POOLW + QLR + 8 * F.lane) = nk; }
            if (F.lane == 0) ssqpe[row] = sp; }
    }
}

__device__ __forceinline__ void s7_route(Frame& F) {
    const bf16_t* H1HI = WSP(bf16_t, WS_H1HI); const bf16_t* H1LO = WSP(bf16_t, WS_H1LO); const bf16_t* WHI = WSP(bf16_t, WS_WRT); const bf16_t* WLO = WHI + 96 * DM;
    const float* SSQ2 = WSP(float, WS_SSQ2); float* RSTD2 = WSP(float, WS_SMALL + SM_RSTD2);
    int* ETOK = WSP(int, WS_SMALL + SM_ETOK); int* RANK = WSP(int, WS_SMALL + SM_RANK); float* GTOK = WSP(float, WS_SMALL + SM_GTOK);
    LAS float* red = (LAS float*)F.lds;
    LAS int* cntl = (LAS int*)(F.lds + 4 * 64 * 97 * 4);
    LAS float* bias_l = (LAS float*)(cntl + 128);
    const int lane = F.lane, r32 = lane & 31, hi = lane >> 5, rh = F.wave & 1, kq = F.wave >> 1;
    for (int u = F.vcu; u < NREAL / 64; u += F.G) {
        const int t0 = u * 64;
        if (F.tid < 128) cntl[F.tid] = 0;
        if (F.tid < 72) bias_l[F.tid] = F.tid < 8 ? F.in[IN_BGROUP][F.tid] : F.in[IN_BEXP][F.tid - 8];
        f32x16 acc[3] = {};
        { constexpr int RK = 128, RSTR = RK * 2 + 16;
          LAS char* stA = (LAS char*)F.lds; LAS char* stB = stA + 2 * 64 * RSTR;
          const char* gA = (const char*)(H1HI + (size_t)t0 * DM); const char* gB = (const char*)WHI;
          u32x4 ra0[2], rb0[3], ra1[2], rb1[3], ra2[2], rb2[3], ra3[2], rb3[3];
          const int prow = F.tid >> 4, pc16 = (F.tid & 15) * 16;
#define RT_G(RA, RB, kc) do { _Pragma("unroll") for (int i = 0; i < 2; ++i) RA[i] = *(const u32x4*)(gA + (size_t)(prow + 32 * i) * (DM * 2) + (kc) * (RK * 2) + pc16); \
              _Pragma("unroll") for (int i = 0; i < 3; ++i) RB[i] = *(const u32x4*)(gB + (size_t)(prow + 32 * i) * (DM * 2) + (kc) * (RK * 2) + pc16); } while (0)
#define RT_S(RA, RB, buf) do { _Pragma("unroll") for (int i = 0; i < 2; ++i) *(LAS u32x4*)(stA + (buf) * 64 * RSTR + (prow + 32 * i) * RSTR + pc16) = RA[i]; \
              _Pragma("unroll") for (int i = 0; i < 3; ++i) *(LAS u32x4*)(stB + (buf) * 96 * RSTR + (prow + 32 * i) * RSTR + pc16) = RB[i]; } while (0)
#define RT_C(buf) do { _Pragma("unroll") for (int ksl = 0; ksl < 2; ++ksl) { const int ko = (2 * kq + ksl) * 32 + hi * 16; \
              const bf16x8 a_h = *(const LAS bf16x8*)(stA + (buf) * 64 * RSTR + (32 * rh + r32) * RSTR + ko); \
              _Pragma("unroll") for (int c = 0; c < 3; ++c) { const bf16x8 b_h = *(const LAS bf16x8*)(stB + (buf) * 96 * RSTR + (32 * c + r32) * RSTR + ko); \
                  acc[c] = __builtin_amdgcn_mfma_f32_32x32x16_bf16(a_h, b_h, acc[c], 0, 0, 0); } } } while (0)
          RT_G(ra0, rb0, 0); RT_G(ra1, rb1, 1); RT_G(ra2, rb2, 2); RT_G(ra3, rb3, 3); RT_S(ra0, rb0, 0); __syncthreads();
#pragma nounroll
          for (int kc = 0; kc < 32; kc += 4) {
              if (kc + 4 < 32) RT_G(ra0, rb0, kc + 4);
              RT_C(0); RT_S(ra1, rb1, 1); __syncthreads();
              if (kc + 5 < 32) RT_G(ra1, rb1, kc + 5);
              RT_C(1); RT_S(ra2, rb2, 0); __syncthreads();
              if (kc + 6 < 32) RT_G(ra2, rb2, kc + 6);
              RT_C(0); RT_S(ra3, rb3, 1); __syncthreads();
              if (kc + 7 < 32) RT_G(ra3, rb3, kc + 7);
              RT_C(1); if (kc + 4 < 32) RT_S(ra0, rb0, 0); __syncthreads();
          }
#undef RT_G
#undef RT_S
#undef RT_C
        }
#pragma unroll
        for (int c = 0; c < 3; ++c)
#pragma unroll
            for (int r = 0; r < 16; ++r) red[(kq * 64 + 32 * rh + att::crow(r, hi)) * 97 + 32 * c + r32] = acc[c][r];
        __syncthreads();
        int e0 = 0, e1 = 0, lr0 = 0, lr1 = 0; float g0 = 0.f, g1 = 0.f;
        { const int tt = F.tid & 63, part = F.tid >> 6, t = t0 + tt;
          const f32x4* sp = (const f32x4*)(SSQ2 + (size_t)t * 64); f32x4 acc4 = sp[0];
#pragma unroll
          for (int j = 1; j < 16; ++j) acc4 += sp[j];
          const float rs = rsqrtf(((acc4[0] + acc4[1]) + (acc4[2] + acc4[3])) * (1.f / DM) + EPS);
          if (part == 0) RSTD2[t] = rs;
          float lv[9];
#pragma unroll
          for (int q = 0; q < 9; ++q) { const int j = part * 9 + q;
              const float v = (red[(0 * 64 + tt) * 97 + j] + red[(1 * 64 + tt) * 97 + j]) + (red[(2 * 64 + tt) * 97 + j] + red[(3 * 64 + tt) * 97 + j]);
              lv[q] = v * rs + bias_l[j]; }
          __syncthreads();
#pragma unroll
          for (int q = 0; q < 9; ++q) red[tt * 97 + part * 9 + q] = lv[q]; }
        __syncthreads();
        if (F.tid < 64) {
            const int tt = F.tid;
            LAS float* lg = red + tt * 97;
            int gi = 0; float gm = lg[0];
            for (int j = 1; j < 8; ++j) { const float v = lg[j]; if (v > gm) { gm = v; gi = j; } }
            float den = 0.f; for (int j = 0; j < 8; ++j) den += __expf(lg[j] - gm);
            const float gp = 1.f / den;
            const LAS float* el = lg + 8 + gi * 8;
            int i0 = 0; float m0 = el[0];
            for (int j = 1; j < 8; ++j) { const float v = el[j]; if (v > m0) { m0 = v; i0 = j; } }
            int i1 = -1; float m1 = -__builtin_inff();
            for (int j = 0; j < 8; ++j) { const float v = el[j]; if (j != i0 && v > m1) { m1 = v; i1 = j; } }
            const float w1 = 1.f / (1.f + __expf(m0 - m1)), w0 = 1.f - w1;
            e0 = gi * 8 + i0; e1 = gi * 8 + i1; g0 = gp * w0; g1 = gp * w1;
            lr0 = __hip_atomic_fetch_add(cntl + e0, 1, __ATOMIC_RELAXED, __HIP_MEMORY_SCOPE_WORKGROUP); lr1 = __hip_atomic_fetch_add(cntl + e1, 1, __ATOMIC_RELAXED, __HIP_MEMORY_SCOPE_WORKGROUP);
        }
        __syncthreads();
        if (F.tid < 64) { const int n = cntl[F.tid]; cntl[64 + F.tid] = n > 0 ? (int)__hip_atomic_fetch_add(F.ctl + CW_CNT + F.tid, (unsigned)n, RLX_AGENT) : 0; }
        __syncthreads();
        if (F.tid < 64) { const int t = t0 + F.tid;
            ETOK[2 * t] = e0; ETOK[2 * t + 1] = e1; RANK[2 * t] = cntl[64 + e0] + lr0; RANK[2 * t + 1] = cntl[64 + e1] + lr1; GTOK[2 * t] = g0; GTOK[2 * t + 1] = g1; }
        __syncthreads();
    }
}
__device__ __forceinline__ void moe_tables(Frame& F) {
    __syncthreads();
    if (F.tid < NE) {
        const int e = F.tid; const unsigned nb = (__hip_atomic_load(F.ctl + CW_CNT + e, RLX_AGENT) + 127u) >> 7;
        unsigned a = nb, nf = nb >> 1, nh = nb & 1u;
#pragma unroll
        for (int d = 1; d < 64; d <<= 1) { const unsigned ta = __shfl_up(a, d), tf = __shfl_up(nf, d), th = __shfl_up(nh, d); if (e >= d) { a += ta; nf += tf; nh += th; } }
        F.MISC[64 + e] = a - nb; F.MISC[136 + e] = nf - (nb >> 1); if (nb & 1u) F.MISC[208 + (nh - 1u)] = (unsigned)e;
        if (e == NE - 1) { F.MISC[136 + NE] = nf; F.MISC[128] = nf; F.MISC[129] = nh; } }
    __syncthreads();
}
__device__ __forceinline__ void s7c_slots(Frame& F) {
    const int* ETOK = WSP(int, WS_SMALL + SM_ETOK); const int* RANK = WSP(int, WS_SMALL + SM_RANK); const float* GTOK = WSP(float, WS_SMALL + SM_GTOK); int* SLOT = WSP(int, WS_SMALL + SM_SLOT);
    moe_tables(F);
    for (int u = F.vcu; u < NREAL / 64; u += F.G) {
        if (F.tid < 128) { const int i = 2 * (u * 64) + F.tid; const int e = ETOK[i]; const int slot = (int)F.MISC[64 + e] * 128 + RANK[i];
            F.ctl[CW_TOKSLOT + slot] = (unsigned)(i >> 1); ((float*)F.ctl)[CW_GATESLOT + slot] = GTOK[i]; SLOT[i] = slot; }
    }
}
__device__ __forceinline__ void s10_combine(Frame& F) {
    int lane = __builtin_amdgcn_mbcnt_hi(~0u, __builtin_amdgcn_mbcnt_lo(~0u, 0u)); const int gw = F.vcu * NWAVES + F.wave, NGW = F.G * NWAVES;
    const bf16_t* H1HI = WSP(bf16_t, WS_H1HI); const bf16_t* H1LO = WSP(bf16_t, WS_H1LO); const bf16_t* Y = WSP(bf16_t, WS_Y); const int* SLOT = WSP(int, WS_SMALL + SM_SLOT);
    for (int t = gw; t < NREAL; t += NGW) {
        const int s0 = SLOT[2 * t], s1 = SLOT[2 * t + 1];
#pragma unroll 4
        for (int j = 0; j < 8; ++j) { const int col = (j * 64 + lane) * 8;
            const u32x4 a = *(const u32x4*)(H1HI + (size_t)t * DM + col), b = {0u, 0u, 0u, 0u}, y0 = *(const u32x4*)(Y + (size_t)s0 * DM + col), y1 = *(const u32x4*)(Y + (size_t)s1 * DM + col);
            f32x4 o0, o1;
#pragma unroll
            for (int q = 0; q < 2; ++q) { o0[2 * q] = (bf_lo(a[q]) + bf_lo(b[q])) + bf_lo(y0[q]) + bf_lo(y1[q]); o0[2 * q + 1] = (bf_hi(a[q]) + bf_hi(b[q])) + bf_hi(y0[q]) + bf_hi(y1[q]);
                o1[2 * q] = (bf_lo(a[2 + q]) + bf_lo(b[2 + q])) + bf_lo(y0[2 + q]) + bf_lo(y1[2 + q]); o1[2 * q + 1] = (bf_hi(a[2 + q]) + bf_hi(b[2 + q])) + bf_hi(y0[2 + q]) + bf_hi(y1[2 + q]); }
            *(f32x4*)(F.out + (size_t)t * DM + col) = o0; *(f32x4*)(F.out + (size_t)t * DM + col + 4) = o1; }
    }
}

struct FV { unsigned char* ws; unsigned* ctl; volatile LAS unsigned* MISC; int G, vcu; };
struct SchedS1 {
    static constexpr bool GATHER = false, HALF = false; FV f;
    __device__ __forceinline__ bool next(int i, pg8::GUnit& u) const {
        const int L = i * f.G + (int)blockIdx.x; if (L >= 65 * 11) return false;
        int pm, pn; pg8::tile_of(L, 65, 11, pm, pn);
        u.A = (const char*)(f.ws + WS_XB) + (size_t)pm * 256 * DM * 2; u.lda = DM * 2; u.B = (const char*)(f.ws + WS_WIN) + (size_t)pn * 256 * DM * 2; u.ldb = DM * 2; u.nk = DM / 64; u.gather = nullptr;
        u.C = (char*)(f.ws + WS_PROJ) + ((size_t)pm * 256 * INCP + pn * 256) * 2; u.ldc = INCP * 2; u.rs = nullptr; u.i0 = 0; u.i1 = 0; return true; }
};
struct SchedS3 {
    static constexpr bool GATHER = false, HALF = false; FV f; int only;
    __device__ __forceinline__ bool next(int i, pg8::GUnit& u) const {
        const int c = (int)blockIdx.x, G = f.G; int pm, pn; u.gather = nullptr; u.i0 = 0; u.i1 = 0;
        const int nq = c < 64 * 18 ? (64 * 18 - c + G - 1) / G : 0; int nkv = c < 65 * 24 ? (65 * 24 - c + G - 1) / G : 0, np = c < 65 * 4 ? (65 * 4 - c + G - 1) / G : 0;
        const bool bal = G == 256, grpA = c < 128;
        if (bal) { nkv = 5 + (grpA ? (c < 24 ? 1 : 0) : 2); np = grpA ? (c >= 24 ? 2 : 1) : (c - 128 < 65 * 4 - 232 ? 1 : 0); }
        const int m = nq < nkv ? nq : nkv; int type, j;
        if (only >= 0) { type = only; j = i; if (j >= (only == 0 ? nq : only == 1 ? nkv : np)) return false; }
        else if (i < 2 * m) { j = i >> 1; type = (i & 1) ^ ((c >> 3) & 1); }
        else { int r = i - 2 * m; if (r < nq - m) { type = 0; j = m + r; } else { r -= nq - m; if (r < nkv - m) { type = 1; j = m + r; } else { r -= nkv - m; if (r < np) { type = 2; j = r; } else return false; } } }
        int L = j * G + c + (type == 1 ? 64 * 18 : type == 2 ? 64 * 18 + 65 * 24 : 0);
        if (bal && type == 1 && j >= 5) L = 64 * 18 + (grpA ? 1536 + c : 1280 + (c - 128) + 128 * (j - 5));
        if (bal && type == 2) L = 64 * 18 + 65 * 24 + (grpA ? (c >= 24 ? 2 * (c - 24) + j : 208 + c) : 232 + (c - 128));
        if (L < 64 * 18) { pg8::tile_of(L, 64, 18, pm, pn); const int b = pm >> 5, r0 = b * LSEQ + NMETA + (pm & 31) * 256;
            u.A = (const char*)(f.ws + WS_PROJ) + ((size_t)r0 * INCP + POOLW) * 2; u.lda = INCP * 2; u.B = (const char*)(f.ws + WS_WUQ) + (size_t)pn * 256 * QLR * 2; u.ldb = QLR * 2; u.nk = QLR / 64;
            u.C = (char*)(f.ws + WS_Q) + ((size_t)pm * 256 * QW + pn * 256) * 2; u.ldc = QW * 2; u.rs = nullptr; return true; }
        L -= 64 * 18;
        if (L < 65 * 24) { pg8::tile_of(L, 65, 24, pm, pn);
            u.A = (const char*)(f.ws + WS_PROJ) + ((size_t)pm * 256 * INCP + POOLW + QLR) * 2; u.lda = INCP * 2; u.B = (const char*)(f.ws + WS_WUKV) + (size_t)pn * 256 * KVLR * 2; u.ldb = KVLR * 2; u.nk = KVLR / 64;
            u.C = nullptr; u.ldc = 0; u.rs = nullptr; u.i0 = pm * 256; u.i1 = 256 + pn; return true; }
        L -= 65 * 24;
        if (L < 65 * 4) { pm = L >> 2; pn = L & 3;
            u.A = (const char*)(f.ws + WS_DIFF) + ((size_t)pm * 256 * POOLW + pn * 256) * 2; u.lda = POOLW * 2; u.B = (const char*)(f.ws + WS_WP) + (size_t)pn * 65536 * 2; u.ldb = 256 * 2; u.nk = 4;
            u.C = (char*)(f.ws + WS_MIX) + ((size_t)pm * 256 * DM + pn * 256) * 2; u.ldc = DM * 2; u.rs = nullptr; return true; }
        return false; }
};
struct SchedS6 {
    static constexpr bool GATHER = false, HALF = false; FV f;
    __device__ __forceinline__ bool next(int i, pg8::GUnit& u) const {
        const int L = i * f.G + (int)blockIdx.x; if (L >= 64 * 16) return false;
        int pm, pn; pg8::tile_of(L, 64, 16, pm, pn); const int b = pm >> 5, r0 = b * LSEQ + NMETA + (pm & 31) * 256;
        u.A = (const char*)(f.ws + WS_MIX) + (size_t)r0 * DM * 2; u.lda = DM * 2; u.B = (const char*)(f.ws + WS_WO) + (size_t)pn * 256 * DM * 2; u.ldb = DM * 2; u.nk = DM / 64; u.gather = nullptr;
        u.C = nullptr; u.ldc = 0; u.rs = nullptr; u.i0 = pm * 256; u.i1 = pn; return true; }
};
__device__ __forceinline__ bool moe_unit(const FV& f, int L, int lct, int& e, int& slot0, int& ct, int& half) {
    const int nf = (int)f.MISC[128], nh = (int)f.MISC[129]; ct = L & ((1 << lct) - 1); int g = L >> lct;
    if (g < nf) { e = 0;
#pragma unroll
        for (int s = 32; s > 0; s >>= 1) { const int c = e + s; if ((int)f.MISC[136 + c] <= g) e = c; }
        slot0 = (int)f.MISC[64 + e] * 128 + (g - (int)f.MISC[136 + e]) * 256; half = 0; return true; }
    g -= nf; if (g >= nh) return false;
    e = (int)f.MISC[208 + g]; slot0 = (int)f.MISC[64 + e] * 128 + ((int)f.MISC[136 + e + 1] - (int)f.MISC[136 + e]) * 256; half = 1; return true;
}
struct MoeSplit { int u9, n9b, idle, E; };
__device__ __forceinline__ MoeSplit moe_split(const FV& f) {
    const int nt = (int)f.MISC[128] + (int)f.MISC[129]; MoeSplit m; m.u9 = 4 * nt; m.n9b = m.u9 - 2 * f.G; if (m.n9b < 0) m.n9b = 0;
    m.idle = f.G - m.n9b; if (m.idle < 0) m.idle = 0; if (m.n9b == 0) m.idle = 0;
    const int avail = 16 * (nt < f.G / 2 ? nt : f.G / 2); m.E = m.idle * 4 < avail ? m.idle * 4 : avail; return m;
}
struct SchedS8 {
    static constexpr bool GATHER = true, HALF = true; FV f; int base, rank, stride, limit;
    __device__ __forceinline__ bool next(int i, pg8::GUnit& u) const {
        const int L = base + i * stride + rank; if (L >= limit) return false;
        int e, slot0, ct, half; if (!moe_unit(f, L, 2, e, slot0, ct, half)) return false;
        u.A = (const char*)(f.ws + WS_H1HI); u.lda = DM * 2; u.gather = (const int*)(f.ctl + CW_TOKSLOT) + slot0;
        u.B = (const char*)(f.ws + WS_WGU) + ((size_t)e * 1024 + ct * 256) * DM * 2; u.ldb = DM * 2; u.nk = DM / 64;
        u.C = (char*)(f.ws + WS_HID) + ((size_t)slot0 * DE + ct * 128) * 2; u.ldc = DE * 2; u.rs = nullptr; u.i0 = slot0; u.i1 = half; return true; }
};
struct SchedS9 {
    static constexpr bool GATHER = false, HALF = true; FV f; int base, rank, stride, limit;
    __device__ __forceinline__ bool next(int i, pg8::GUnit& u) const {
        const int L = base + i * stride + rank; if (L >= limit) return false;
        int e, slot0, ct, half; if (!moe_unit(f, L, 4, e, slot0, ct, half)) return false;
        u.A = (const char*)(f.ws + WS_HID) + (size_t)slot0 * DE * 2; u.lda = DE * 2; u.gather = nullptr;
        u.B = (const char*)(f.ws + WS_WD) + ((size_t)e * DM + ct * 256) * DE * 2; u.ldb = DE * 2; u.nk = DE / 64;
        u.C = (char*)(f.ws + WS_Y) + ((size_t)slot0 * DM + ct * 256) * 2; u.ldc = DM * 2; u.rs = nullptr; u.i0 = slot0; u.i1 = half; return true; }
};

struct Args { const float* in[21]; float* out; unsigned char* ws; int ph_lo, ph_hi, li, pad; };
constexpr int N_PHASES = 12;
__global__ void __launch_bounds__(NWAVES * 64, 2) mk_fwd(Args args) {
    extern __shared__ __attribute__((aligned(16))) unsigned char lds_raw[];
    Frame F;
    F.lds = (LAS unsigned char*)lds_raw;
    F.MISC = (volatile LAS unsigned*)(F.lds + MISC_OFF);
    F.tid = threadIdx.x; F.lane = F.tid & 63; F.wave = __builtin_amdgcn_readfirstlane(F.tid >> 6);
    F.G = gridDim.x; { const int bx = blockIdx.x; F.vcu = (F.G % 8 == 0) ? (bx % 8) * (F.G / 8) + bx / 8 : bx; }
    F.ws = args.ws; F.ctl = (unsigned*)(args.ws + WS_CTL); F.out = args.out;
#pragma unroll
    for (int i = 0; i < 21; ++i) F.in[i] = args.in[i];
    for (int u = F.tid; u < 512; u += NWAVES * 64) ((LAS unsigned*)(F.lds + MISC_OFF))[u] = 0u;
    __syncthreads();
    XcdBarrier bar = xcd_barrier_post((unsigned*)(F.ctl + CW_BAR) + args.li * XCD_BAR_WORDS, F.MISC + 8);
    const int lo = args.ph_lo, hi = args.ph_hi;
    const FV fv{F.ws, F.ctl, F.MISC, F.G, F.vcu};
#ifdef ONLY_PHASE
#define IN(k) ((k) == ONLY_PHASE)
#else
#define IN(k) (lo <= (k) && (k) < hi)
#endif
#ifdef TS_SEL
#define STAMP(k) do { if (blockIdx.x == 0 && threadIdx.x == 0) F.MISC[300 + (k)] = (unsigned)__builtin_amdgcn_s_memrealtime(); } while (0)
#else
#define STAMP(k) do { } while (0)
#endif
#define SEAM(k) do { if (IN(k) && IN((k) + 1)) xcd_barrier(bar); STAMP((k) + 1); } while (0)
#ifndef DBL_PHASE
#define DBL_PHASE -1
#endif
#define REP(k) for (int rep_ = 0; rep_ < ((k) == DBL_PHASE ? 2 : 1); ++rep_)
    STAMP(0);
    if (IN(0)) REP(0) { p0_prologue(F); } SEAM(0);
    if (IN(1)) REP(1) { SchedS1 S{fv}; pg8::EpiScaleBf16L E; pg8::gemm_phase(F.lds, S, E);
        { const int rounds = (65 * 11 + F.G - 1) / F.G; int first = 65 * 11 - (rounds - 1) * F.G; if (first >= F.G || first < 0) first = 0; p1_deferred(F, first); } } SEAM(1);
    if (IN(2)) REP(2) { s2_phase(F); } SEAM(2);
    if (IN(3)) REP(3) { SchedS3 S{fv, -1}; pg8::EpiS3 E{WSP(float, WS_SMALL + SM_RSTDKV), WSP(float, WS_SMALL + SM_SSQPE), WSP(float, WS_KR), F.in[IN_KHG], WSP(bf16_t, WS_KF), WSP(bf16_t, WS_VB), (LAS float*)(F.lds + PTAB_OFF)}; pg8::gemm_phase(F.lds, S, E);
#ifdef DBL3T
        { SchedS3 S2{fv, DBL3T}; pg8::gemm_phase(F.lds, S2, E); }
#endif
    }
    if (IN(3) && IN(5)) xcd_barrier(bar); STAMP(4); STAMP(5);
    if (IN(5)) REP(5) {
        const bf16_t* Q = WSP(bf16_t, WS_Q); const bf16_t* KF = WSP(bf16_t, WS_KF); const bf16_t* KV = WSP(bf16_t, WS_VB); bf16_t* MIX = WSP(bf16_t, WS_MIX); const float* gq = F.in[IN_QHG]; const float* rope = WSP(float, WS_ROPE);
        att::ConvCtx cv; cv.ci = 0; cv.cd = 0; cv.bi = 0; cv.bd = 0; cv.base_it = F.vcu; cv.stride = F.G; cv.n = (TI_EXP - F.vcu + F.G - 1) / F.G;
        cv.wg = F.in[IN_WGATE]; cv.wu = F.in[IN_WUP]; cv.wd = F.in[IN_WDOWN]; cv.fg = F.in[IN_FFNG]; cv.WGU = WSP(bf16_t, WS_WGU); cv.WDn = WSP(bf16_t, WS_WD);
        if (rep_ > 0) cv.n = 0;
#ifdef ATT_PROBE
        cv.pb[0] = cv.pb[1] = cv.pb[2] = cv.pb[3] = 0; { unsigned long long t_; asm volatile("s_memrealtime %0\n\ts_waitcnt lgkmcnt(0)" : "=s"(t_) :: "memory"); cv.pbl = (unsigned)t_; }
#endif
        bool fastsm; { float mq = 0.f, mk = 0.f;
#pragma unroll
            for (int j = 0; j < 3; ++j) { mq = fmaxf(mq, fabsf(gq[F.lane + 64 * j])); mk = fmaxf(mk, fabsf(F.in[IN_KHG][F.lane + 64 * j])); }
#pragma unroll
            for (int d = 32; d > 0; d >>= 1) { mq = fmaxf(mq, __shfl_xor(mq, d)); mk = fmaxf(mk, __shfl_xor(mk, d)); }
            fastsm = __builtin_amdgcn_readfirstlane(__float_as_uint(19.99f * mq * mk)) <= __float_as_uint(60.f); }
        if (fastsm) { for (int it = F.vcu; it < 768; it += F.G) { const int bh = it >> 4, s = it & 15;
            att::attn_unit<true>(bh / NH, bh % NH, 31 - s, Q, KF, KV, MIX, gq, rope, cv, (LAS char*)F.lds);
            att::attn_unit<true>(bh / NH, bh % NH, s, Q, KF, KV, MIX, gq, rope, cv, (LAS char*)F.lds); } }
        else { for (int it = F.vcu; it < 768; it += F.G) { const int bh = it >> 4, s = it & 15;
            att::attn_unit<false>(bh / NH, bh % NH, 31 - s, Q, KF, KV, MIX, gq, rope, cv, (LAS char*)F.lds);
            att::attn_unit<false>(bh / NH, bh % NH, s, Q, KF, KV, MIX, gq, rope, cv, (LAS char*)F.lds); } }
        while (cv.ci < cv.n) { const unsigned lds0 = (unsigned)(uintptr_t)(LAS char*)F.lds;
            (void)att::conv_dma_step(cv, lds0, F.wave, F.lane); asm volatile("s_waitcnt vmcnt(0)" ::: "memory");
            att::conv_proc_step(cv, (LAS char*)F.lds, F.wave, F.lane); att::conv_dma_end(cv);
            asm volatile("s_waitcnt vmcnt(0) lgkmcnt(0)\n\ts_barrier" ::: "memory"); }
#ifdef ATT_PROBE
        { unsigned long long t_; asm volatile("s_memrealtime %0\n\ts_waitcnt lgkmcnt(0)" : "=s"(t_) :: "memory"); cv.pb[3] += (unsigned)t_ - cv.pbl; }
        if (blockIdx.x == ATT_PROBE_BLK && F.wave == ATT_PROBE_WAVE && F.lane == 0) { const float tot = (float)(cv.pb[0] + cv.pb[1] + cv.pb[2] + cv.pb[3]);
            F.MISC[320] = __float_as_uint(ATT_PROBE == 9 ? tot * 0.01f : 250.f * (float)cv.pb[ATT_PROBE & 3] / tot); }
#endif
    } SEAM(5);
    if (IN(6)) REP(6) { SchedS6 S{fv}; pg8::EpiWout E{F.in[IN_X], WSP(bf16_t, WS_H1HI), WSP(bf16_t, WS_H1LO), WSP(float, WS_SSQ2)}; pg8::gemm_phase(F.lds, S, E); } SEAM(6);
    if (IN(7)) { s7_route(F); } SEAM(7);
    if (IN(8)) { s7c_slots(F); } SEAM(8);
    if (IN(9)) REP(9) { moe_tables(F); const MoeSplit ms = moe_split(fv); const pg8::EpiMoe1 E9{WSP(float, WS_SMALL + SM_RSTD2), (const float*)(F.ctl + CW_GATESLOT)};
        { SchedS8 S{fv, 0, F.vcu, F.G, ms.u9 < 2 * F.G ? ms.u9 : 2 * F.G}; pg8::gemm_phase(F.lds, S, E9); }
        if (ms.n9b > 0) { xcd_barrier(bar);
            if (F.vcu < ms.n9b) { SchedS8 S{fv, 2 * F.G, F.vcu, F.G, ms.u9}; pg8::gemm_phase(F.lds, S, E9); }
            else if (ms.E > 0) { SchedS9 S{fv, 0, F.vcu - ms.n9b, ms.idle, ms.E}; pg8::EpiScaleBf16L E; pg8::gemm_phase(F.lds, S, E); } }
    } SEAM(9);
    if (IN(10)) REP(10) { moe_tables(F); const MoeSplit ms = moe_split(fv); SchedS9 S{fv, ms.E, F.vcu, F.G, 0x7fffffff};
        { pg8::EpiScaleBf16L E; pg8::gemm_phase(F.lds, S, E); }
#ifdef DBLM
        xcd_barrier(bar);
        if (DBLM == 0) { SchedS9 S2{fv, 0, F.vcu, F.G, 1024}; pg8::EpiScaleBf16L E; pg8::gemm_phase(F.lds, S2, E); }
        if (DBLM == 1) { const int nf4 = 4 * (int)F.MISC[128]; SchedS8 S2{fv, nf4, F.vcu, F.G, nf4 + F.G}; const pg8::EpiMoe1 E9{WSP(float, WS_SMALL + SM_RSTD2), (const float*)(F.ctl + CW_GATESLOT)}; pg8::gemm_phase(F.lds, S2, E9); }
        if (DBLM == 2) { SchedS8 S2{fv, 0, F.vcu, F.G, F.G}; const pg8::EpiMoe1 E9{WSP(float, WS_SMALL + SM_RSTD2), (const float*)(F.ctl + CW_GATESLOT)}; pg8::gemm_phase(F.lds, S2, E9); }
#endif
    } SEAM(10);
    if (IN(11)) REP(11) { s10_combine(F); }
#ifdef ATT_PROBE
    __syncthreads();
    if (blockIdx.x == ATT_PROBE_BLK && threadIdx.x == 0) { asm volatile("s_waitcnt vmcnt(0)" ::: "memory"); F.out[0] += __uint_as_float(F.MISC[320]); }
#endif
#ifdef TS_SEL
    if (blockIdx.x == 0 && threadIdx.x == 0) { const unsigned t1 = (unsigned)__builtin_amdgcn_s_memrealtime(); F.MISC[312] = t1;
        const unsigned d = (TS_SEL == 99) ? (F.MISC[312] - F.MISC[300]) : (F.MISC[300 + TS_SEL + 1] - F.MISC[300 + TS_SEL]);
        asm volatile("s_waitcnt vmcnt(0)" ::: "memory"); F.out[0] += (float)d * (10.f / (float)TS_UNIT_NS); }
#endif
#undef IN
#undef SEAM
}

extern "C" void kernel_launch(void* const* d_in, const int* in_sizes, int n_in, void* d_out, int out_size, void* d_ws, size_t ws_size, hipStream_t stream) {
    static int grid = 0;
    if (grid == 0) {
        if (n_in != 21 || out_size != NREAL * DM || ws_size < WS_END) { fprintf(stderr, "kernel_launch: unexpected shapes (n_in %d out %d ws %zu)\n", n_in, out_size, ws_size); grid = -1; return; }
        int dev = 0, cus = 0, per_cu = 0;
        if (hipGetDevice(&dev) != hipSuccess || hipDeviceGetAttribute(&cus, hipDeviceAttributeMultiprocessorCount, dev) != hipSuccess) { grid = -1; return; }
        if (hipFuncSetAttribute((const void*)mk_fwd, hipFuncAttributeMaxDynamicSharedMemorySize, LDS_BYTES) != hipSuccess) { fprintf(stderr, "kernel_launch: hipFuncSetAttribute failed\n"); grid = -1; return; }
        if (hipOccupancyMaxActiveBlocksPerMultiprocessor(&per_cu, (const void*)mk_fwd, NWAVES * 64, LDS_BYTES) != hipSuccess || per_cu < 1) fprintf(stderr, "kernel_launch: occupancy query says %d\n", per_cu);
        (void)hipGetLastError();
        grid = cus;
    }
    if (grid < 0) return;
    (void)hipMemsetAsync((char*)d_ws + WS_CTL, 0, CTL_ZERO_BYTES, stream);
    Args a{};
    for (int i = 0; i < 21; ++i) a.in[i] = (const float*)d_in[i];
    a.out = (float*)d_out; a.ws = (unsigned char*)d_ws; a.ph_lo = 0; a.ph_hi = N_PHASES; a.li = 0; a.pad = 0;
    hipLaunchKernelGGL(mk_fwd, dim3(grid), dim3(NWAVES * 64), LDS_BYTES, stream, a);
}
```
